# Optimizing an MI355X kernel written in HIP

```python
import jax
import jax.numpy as jnp
from jax import lax
import numpy as np

D_MODEL = 1024
BATCH = 8
SEQ = 2048
DEPTH = 1

CTX_LEN = 256
GRID_W = 64
EPS = 1e-6
ATT_HEADS = 8
ATT_KV_HEADS = 2
ATT_GROUP = ATT_HEADS // ATT_KV_HEADS
HEAD_DIM = 64
WINDOW = 128
ATT_BLOCK = 128
ROPE_BASE = 10000.0
AXIS_ROT = HEAD_DIM // 2
GLA_HEADS = 4
GLA_DK = 64
GLA_DV = 128
GLA_RANK = 16
GLA_TAU = 16.0
GLA_CHUNK = 64
N_EXPERTS = 32
TOP_K = 4
D_FF = D_MODEL
SWIGLU_ALPHA = 1.702
SWIGLU_LIMIT = 7.0
MOE_BLOCK = 256

ATT_W = ATT_HEADS * HEAD_DIM
ATT_KV_W = ATT_KV_HEADS * HEAD_DIM
GLA_K_W = GLA_HEADS * GLA_DK
GLA_V_W = GLA_HEADS * GLA_DV
IN_SPLITS = (ATT_W, ATT_KV_W, ATT_KV_W, GLA_K_W, GLA_K_W, GLA_V_W, GLA_V_W, GLA_RANK, GLA_RANK, D_MODEL, D_MODEL)
C_IN = sum(IN_SPLITS)

kernel_name = 'hybrid_swa_gla_moe_dit_layer'


def rms_norm(x, g):
    xf = x.astype(jnp.float32)
    y = xf * lax.rsqrt(jnp.mean(xf * xf, axis=-1, keepdims=True) + EPS)
    return (y * g.astype(jnp.float32)).astype(x.dtype)


def axial_rope_angles(n_tok):
    rows = n_tok // GRID_W
    row = jnp.repeat(jnp.arange(rows, dtype=jnp.float32), GRID_W)
    col = jnp.tile(jnp.arange(GRID_W, dtype=jnp.float32), rows)
    inv = ROPE_BASE ** (-jnp.arange(0, AXIS_ROT, 2, dtype=jnp.float32) / AXIS_ROT)
    return row[:, None] * inv, col[:, None] * inv


def rotate_pairs(x, ang):
    m = x.shape[-1] // 2
    cos = jnp.cos(ang)[:, None, :].astype(x.dtype)
    sin = jnp.sin(ang)[:, None, :].astype(x.dtype)
    x1, x2 = x[..., :m], x[..., m:]
    return jnp.concatenate([x1 * cos - x2 * sin, x2 * cos + x1 * sin], axis=-1)


def axial_rope(x, ang_r, ang_c):
    return jnp.concatenate([rotate_pairs(x[..., :AXIS_ROT], ang_r),
                            rotate_pairs(x[..., AXIS_ROT:], ang_c)], axis=-1)


def mixer_inputs(h, w_in, q_norm, k_norm, w_alpha_f, b_alpha_f, w_alpha_b, b_alpha_b):
    B, T, _ = h.shape
    split_at = np.cumsum(IN_SPLITS)[:-1].tolist()
    aq, ak, av, gq, gk, gv, gr, lr_f, lr_b, ga, gg = jnp.split(h @ w_in, split_at, axis=-1)
    aq = rms_norm(aq.reshape(B, T, ATT_HEADS, HEAD_DIM), q_norm)
    ak = rms_norm(ak.reshape(B, T, ATT_KV_HEADS, HEAD_DIM), k_norm)
    av = av.reshape(B, T, ATT_KV_HEADS, HEAD_DIM)
    gq = gq.reshape(B, T, GLA_HEADS, GLA_DK) * (GLA_DK ** -0.5)
    gk = gk.reshape(B, T, GLA_HEADS, GLA_DK)
    gv = gv.reshape(B, T, GLA_HEADS, GLA_DV)
    la_f = jax.nn.log_sigmoid((lr_f @ w_alpha_f + b_alpha_f).astype(jnp.float32)) / GLA_TAU
    la_b = jax.nn.log_sigmoid((lr_b @ w_alpha_b + b_alpha_b).astype(jnp.float32)) / GLA_TAU
    la_f = la_f.reshape(B, T, GLA_HEADS, GLA_DK)
    la_b = la_b.reshape(B, T, GLA_HEADS, GLA_DK)
    return (aq, ak, av, gq, gk, gv, gr, la_f, la_b, ga, gg)


def windowed_attention(q, k, v, kc, vc, sink):
    B, T = q.shape[:2]
    Lc = kc.shape[1]
    nb = T // ATT_BLOCK
    nl = 3 * ATT_BLOCK
    scale = HEAD_DIM ** -0.5
    qb = q.reshape(B, nb, ATT_BLOCK, ATT_KV_HEADS, ATT_GROUP, HEAD_DIM)
    pad = ((0, 0), (ATT_BLOCK, ATT_BLOCK), (0, 0), (0, 0))
    kp = jnp.pad(k, pad).reshape(B, nb + 2, ATT_BLOCK, ATT_KV_HEADS, HEAD_DIM)
    vp = jnp.pad(v, pad).reshape(B, nb + 2, ATT_BLOCK, ATT_KV_HEADS, HEAD_DIM)
    kw = jnp.concatenate([kp[:, :-2], kp[:, 1:-1], kp[:, 2:]], axis=2)
    vw = jnp.concatenate([vp[:, :-2], vp[:, 1:-1], vp[:, 2:]], axis=2)
    qi = jnp.arange(ATT_BLOCK)[:, None]
    kj = jnp.arange(nl)[None, :]
    rel = kj - ATT_BLOCK - qi
    kpos = jnp.arange(nb)[:, None, None] * ATT_BLOCK - ATT_BLOCK + kj[None]
    mask = (jnp.abs(rel) <= WINDOW)[None] & (kpos >= 0) & (kpos < T)
    s_loc = jnp.einsum('bnqkgd,bnskd->bnkgqs', qb, kw).astype(jnp.float32) * scale
    s_loc = jnp.where(mask[None, :, None, None], s_loc, -jnp.inf)
    s_ctx = jnp.einsum('bnqkgd,bckd->bnkgqc', qb, kc).astype(jnp.float32) * scale
    s_sink = jnp.broadcast_to(sink.reshape(ATT_KV_HEADS, ATT_GROUP)[None, None, :, :, None, None].astype(jnp.float32),
                              s_loc.shape[:-1] + (1,))
    p = jax.nn.softmax(jnp.concatenate([s_loc, s_ctx, s_sink], axis=-1), axis=-1).astype(q.dtype)
    o = (jnp.einsum('bnkgqs,bnskd->bnqkgd', p[..., :nl], vw)
         + jnp.einsum('bnkgqc,bckd->bnqkgd', p[..., nl:nl + Lc], vc))
    return o.reshape(B, T, ATT_W)


def context_attention(qc, kc, vc, sink):
    B, Lc = qc.shape[:2]
    qg = qc.reshape(B, Lc, ATT_KV_HEADS, ATT_GROUP, HEAD_DIM)
    s = jnp.einsum('bqkgd,bckd->bkgqc', qg, kc).astype(jnp.float32) * (HEAD_DIM ** -0.5)
    s_sink = jnp.broadcast_to(sink.reshape(ATT_KV_HEADS, ATT_GROUP)[None, :, :, None, None].astype(jnp.float32),
                              s.shape[:-1] + (1,))
    p = jax.nn.softmax(jnp.concatenate([s, s_sink], axis=-1), axis=-1)[..., :Lc].astype(qc.dtype)
    return jnp.einsum('bkgqc,bckd->bqkgd', p, vc).reshape(B, Lc, ATT_W)


def gla_chunk_scan(q, k, v, log_a, s0):
    B, T, H, dk = q.shape
    dv = v.shape[-1]
    nc = T // GLA_CHUNK

    def chunks(a):
        return a.reshape(B, nc, GLA_CHUNK, H, a.shape[-1]).transpose(1, 0, 3, 2, 4)

    causal = jnp.tril(jnp.ones((GLA_CHUNK, GLA_CHUNK), bool))

    def step(S, inp):
        qc, kc, vc, gc = inp
        b = jnp.cumsum(gc.astype(jnp.float32), axis=2)
        o_inter = jnp.einsum('bhcd,bhde->bhce', qc * jnp.exp(b), S)
        decay = jnp.exp(jnp.where(causal[:, :, None], b[:, :, :, None, :] - b[:, :, None, :, :], -jnp.inf))
        a = jnp.einsum('bhid,bhjd,bhijd->bhij', qc, kc, decay)
        o = o_inter + jnp.einsum('bhij,bhje->bhie', a, vc)
        b_last = b[:, :, -1:, :]
        S = jnp.exp(b_last[:, :, 0, :])[..., None] * S + jnp.einsum('bhjd,bhje->bhde', kc * jnp.exp(b_last - b), vc)
        return S, o

    S, o = lax.scan(step, s0, (chunks(q), chunks(k), chunks(v), chunks(log_a)))
    o = o.transpose(1, 0, 3, 2, 4).reshape(B, T, H, dv)
    return o.astype(v.dtype), S


def bidirectional_gla(q, k, v, la_f, la_b, qc, kc, vc, la_fc, la_bc):
    B = q.shape[0]
    s0 = jnp.zeros((B, GLA_HEADS, GLA_DK, GLA_DV), jnp.float32)
    fl = lambda a: jnp.flip(a, axis=1)
    oc_f, s_f = gla_chunk_scan(qc, kc, vc, la_fc, s0)
    oc_b, s_b = gla_chunk_scan(fl(qc), fl(kc), fl(vc), fl(la_bc), s0)
    o_f, _ = gla_chunk_scan(q, k, v, la_f, s_f)
    o_b, _ = gla_chunk_scan(fl(q), fl(k), fl(v), fl(la_b), s_b)
    return o_f + fl(o_b), oc_f + fl(oc_b)


def merge_branches(attn_o, gla_o, gr, ga, gg, gla_norm, w_branch_attn, w_branch_gla, w_out):
    B, T = gr.shape[:2]
    o = rms_norm(gla_o, gla_norm) * jax.nn.silu(gr.reshape(B, T, GLA_HEADS, GLA_DV))
    y = (jax.nn.sigmoid(ga) * (attn_o @ w_branch_attn)
         + jax.nn.sigmoid(gg) * (o.reshape(B, T, GLA_V_W) @ w_branch_gla))
    return y @ w_out


def moe_ffn(h, w_router, b_router, w1, b1, w2, b2):
    shp = h.shape
    xt = h.reshape(-1, D_MODEL)
    n = xt.shape[0]
    logits = (xt @ w_router + b_router).astype(jnp.float32)
    top_v, top_i = lax.top_k(logits, TOP_K)
    wts = jax.nn.softmax(top_v, axis=-1).astype(h.dtype)
    e_flat = top_i.reshape(-1)
    order = jnp.argsort(e_flat)
    e_sorted = e_flat[order]
    tok_sorted = order // TOP_K
    w_sorted = wts.reshape(-1)[order]
    counts = jnp.bincount(e_flat, length=N_EXPERTS)
    padded = (counts + MOE_BLOCK - 1) // MOE_BLOCK * MOE_BLOCK
    pad_end = jnp.cumsum(padded)
    pad_start = pad_end - padded
    start = jnp.cumsum(counts) - counts
    dest = pad_start[e_sorted] + jnp.arange(n * TOP_K) - start[e_sorted]
    cap = (n * TOP_K + N_EXPERTS * (MOE_BLOCK - 1)) // MOE_BLOCK * MOE_BLOCK
    n_blk = cap // MOE_BLOCK
    buf_tok = jnp.zeros((cap,), jnp.int32).at[dest].set(tok_sorted.astype(jnp.int32))
    blk_e = jnp.minimum(jnp.searchsorted(pad_end, jnp.arange(n_blk) * MOE_BLOCK, side='right'), N_EXPERTS - 1)
    xs = xt[buf_tok].reshape(n_blk, MOE_BLOCK, D_MODEL)

    def expert_block(args):
        xb, e = args
        gu = xb @ w1[e] + b1[e]
        gate = jnp.minimum(gu[:, :D_FF], SWIGLU_LIMIT)
        up = jnp.clip(gu[:, D_FF:], -SWIGLU_LIMIT, SWIGLU_LIMIT)
        act = gate * jax.nn.sigmoid(SWIGLU_ALPHA * gate) * (up + 1)
        return act @ w2[e] + b2[e]

    ys = lax.map(expert_block, (xs, blk_e)).reshape(cap, D_MODEL)
    y = jnp.zeros_like(xt).at[tok_sorted].add(ys[dest] * w_sorted[:, None])
    return y.reshape(shp)


def setup_inputs(seed: int = 0) -> dict:
    key = jax.random.key(seed)
    ks = jax.random.split(key, 26)
    D = D_MODEL

    def nrm(k, shape, scale):
        return jax.random.normal(k, shape, jnp.float32) * scale

    return {
        'x': nrm(ks[0], (BATCH, SEQ, D), 1.0),
        'c': nrm(ks[1], (BATCH, D), 1.0),
        'ctx': nrm(ks[2], (BATCH, CTX_LEN, D), 1.0),
        'c_ctx': nrm(ks[3], (D,), 1.0),
        'w_mod': nrm(ks[4], (DEPTH, D, 6 * D), 0.5 * D ** -0.5),
        'b_mod': nrm(ks[5], (DEPTH, 6 * D), 0.02),
        'norm1': 1.0 + nrm(ks[6], (DEPTH, D), 0.02),
        'norm2': 1.0 + nrm(ks[7], (DEPTH, D), 0.02),
        'w_in': nrm(ks[8], (DEPTH, D, C_IN), D ** -0.5),
        'q_norm': 1.0 + nrm(ks[9], (DEPTH, HEAD_DIM), 0.02),
        'k_norm': 1.0 + nrm(ks[10], (DEPTH, HEAD_DIM), 0.02),
        'attn_sink': nrm(ks[11], (DEPTH, ATT_HEADS), 0.5),
        'w_alpha_f': nrm(ks[12], (DEPTH, GLA_RANK, GLA_K_W), GLA_RANK ** -0.5),
        'b_alpha_f': nrm(ks[13], (DEPTH, GLA_K_W), 0.1),
        'w_alpha_b': nrm(ks[14], (DEPTH, GLA_RANK, GLA_K_W), GLA_RANK ** -0.5),
        'b_alpha_b': nrm(ks[15], (DEPTH, GLA_K_W), 0.1),
        'gla_norm': 1.0 + nrm(ks[16], (DEPTH, GLA_DV), 0.02),
        'w_branch_attn': nrm(ks[17], (DEPTH, ATT_W, D), ATT_W ** -0.5),
        'w_branch_gla': nrm(ks[18], (DEPTH, GLA_V_W, D), GLA_V_W ** -0.5),
        'w_out': nrm(ks[19], (DEPTH, D, D), D ** -0.5),
        'w_router': nrm(ks[20], (DEPTH, D, N_EXPERTS), D ** -0.5),
        'b_router': nrm(ks[21], (DEPTH, N_EXPERTS), 0.01),
        'w_exp_in': nrm(ks[22], (DEPTH, N_EXPERTS, D, 2 * D_FF), D ** -0.5),
        'b_exp_in': nrm(ks[23], (DEPTH, N_EXPERTS, 2 * D_FF), 0.02),
        'w_exp_out': nrm(ks[24], (DEPTH, N_EXPERTS, D_FF, D), D_FF ** -0.5),
        'b_exp_out': nrm(ks[25], (DEPTH, N_EXPERTS, D), 0.02),
    }


def reference(x, c, ctx, c_ctx, w_mod, b_mod, norm1, norm2, w_in, q_norm, k_norm, attn_sink,
              w_alpha_f, b_alpha_f, w_alpha_b, b_alpha_b, gla_norm, w_branch_attn, w_branch_gla,
              w_out, w_router, b_router, w_exp_in, b_exp_in, w_exp_out, b_exp_out):
    ang_r, ang_c = axial_rope_angles(x.shape[1])
    for l in range(DEPTH):
        mod = (jax.nn.silu(c) @ w_mod[l] + b_mod[l])[:, None, :]
        mod_c = jax.nn.silu(c_ctx) @ w_mod[l] + b_mod[l]
        sh1, sc1, gt1, sh2, sc2, gt2 = jnp.split(mod, 6, axis=-1)
        csh1, csc1, cgt1, csh2, csc2, cgt2 = jnp.split(mod_c, 6, axis=-1)
        h = rms_norm(x, norm1[l]) * (1 + sc1) + sh1
        hc = rms_norm(ctx, norm1[l]) * (1 + csc1) + csh1
        proj_w = (w_in[l], q_norm[l], k_norm[l], w_alpha_f[l], b_alpha_f[l], w_alpha_b[l], b_alpha_b[l])
        aq, ak, av, gq, gk, gv, gr, laf, lab, ga, gg = mixer_inputs(h, *proj_w)
        caq, cak, cav, cgq, cgk, cgv, cgr, claf, clab, cga, cgg = mixer_inputs(hc, *proj_w)
        aq = axial_rope(aq, ang_r, ang_c)
        ak = axial_rope(ak, ang_r, ang_c)
        attn_o = windowed_attention(aq, ak, av, cak, cav, attn_sink[l])
        gla_o, gla_oc = bidirectional_gla(gq, gk, gv, laf, lab, cgq, cgk, cgv, claf, clab)
        merge_w = (gla_norm[l], w_branch_attn[l], w_branch_gla[l], w_out[l])
        moe_w = (w_router[l], b_router[l], w_exp_in[l], b_exp_in[l], w_exp_out[l], b_exp_out[l])
        x_next = x + gt1 * merge_branches(attn_o, gla_o, gr, ga, gg, *merge_w)
        h2 = rms_norm(x_next, norm2[l]) * (1 + sc2) + sh2
        x_next = x_next + gt2 * moe_ffn(h2, *moe_w)
        if l + 1 < DEPTH:
            attn_oc = context_attention(caq, cak, cav, attn_sink[l])
            ctx = ctx + cgt1 * merge_branches(attn_oc, gla_oc, cgr, cga, cgg, *merge_w)
            hc2 = rms_norm(ctx, norm2[l]) * (1 + csc2) + csh2
            ctx = ctx + cgt2 * moe_ffn(hc2, *moe_w)
        x = x_next
    return x
```

```cpp
#include <hip/hip_runtime.h>
#include <cstdio>
#include <cstdint>

#define DI __device__ __forceinline__
#define GAS __attribute__((address_space(1)))
#define LAS __attribute__((address_space(3)))
typedef unsigned short bf16_t;
typedef short bf16x8 __attribute__((ext_vector_type(8)));
typedef float f32x4 __attribute__((ext_vector_type(4)));
typedef float f32x2 __attribute__((ext_vector_type(2)));
typedef unsigned u32x4 __attribute__((ext_vector_type(4)));
typedef unsigned u32x2 __attribute__((ext_vector_type(2)));
typedef __bf16 bf16x2_t __attribute__((ext_vector_type(2)));
typedef int i32x8 __attribute__((ext_vector_type(8)));
typedef int i32x4 __attribute__((ext_vector_type(4)));


constexpr int D = 1024, NB = 8, T = 2048, LC = 256;
constexpr int M = NB * T;
constexpr int MC = NB * LC;
constexpr int MT = M + MC;
constexpr int NIN = 4864;
constexpr int CIN = 4384;
constexpr int NE = 32, TOPK = 4, DFF = 1024;
constexpr float EPS = 1e-6f;
constexpr float LOG2E = 1.4426950408889634f;
constexpr float QSCALE = 0.125f * LOG2E;
constexpr int LISTCAP = 16384;
constexpr int ACT_ROWS = 73728;

constexpr size_t al64k(size_t x) { return (x + 65535) & ~(size_t)65535; }
constexpr size_t O_CTL = 0;
constexpr size_t O_MOD = 1u << 20;
constexpr size_t CTL_ZERO_BYTES = (1u << 20) + 9 * 6144 * 4;
constexpr size_t O_ROPE = O_MOD + al64k(9 * 6144 * 4);
constexpr size_t O_WTS = O_ROPE + al64k(2 * 64 * 16 * 4);
constexpr size_t O_LIST = O_WTS + al64k(65536 * 4);
constexpr size_t O_WL = O_LIST + al64k((size_t)NE * LISTCAP * 4);
constexpr size_t O_WIN = O_WL + al64k((size_t)NE * LISTCAP * 4);
constexpr size_t O_WBA = O_WIN + al64k((size_t)NIN * 1024 * 2);
constexpr size_t O_WBG = O_WBA + al64k(1024 * 1024 * 2);
constexpr size_t O_WOUT = O_WBG + al64k(1024 * 512 * 2);
constexpr size_t O_W1 = O_WOUT + al64k(1024 * 1024 * 2);
constexpr size_t O_W2 = O_W1 + al64k((size_t)NE * 2048 * 1024 * 2);
constexpr size_t O_HN = O_W2 + al64k((size_t)NE * 1024 * 1024 * 2);
constexpr size_t O_Q = O_HN + al64k((size_t)MT * 1024 * 2);
constexpr size_t O_K = O_Q + al64k((size_t)M * 512 * 2);
constexpr size_t O_V = O_K + al64k((size_t)MT * 128 * 2);
constexpr size_t O_GQ = O_V + al64k((size_t)MT * 128 * 2);
constexpr size_t O_GK = O_GQ + al64k((size_t)M * 256 * 2);
constexpr size_t O_GV = O_GK + al64k((size_t)MT * 256 * 2);
constexpr size_t O_LAF = O_GV + al64k((size_t)MT * 512 * 2);
constexpr size_t O_LAB = O_LAF + al64k((size_t)MT * 256 * 4);
constexpr size_t O_GR = O_LAB + al64k((size_t)MT * 256 * 4);
constexpr size_t O_GA = O_GR + al64k((size_t)M * 512 * 2);
constexpr size_t O_GG = O_GA + al64k((size_t)M * 1024 * 2);
constexpr size_t O_AO = O_GG + al64k((size_t)M * 1024 * 2);
constexpr size_t O_UB = O_AO + al64k((size_t)M * 1024 * 2);
constexpr size_t O_DV = O_UB + al64k((size_t)64 * 36 * 128 * 64 * 2);
constexpr size_t O_ST = O_DV + al64k((size_t)64 * 36 * 64 * 4);
constexpr size_t O_OG = O_ST + al64k((size_t)64 * 32 * 128 * 64 * 2);
constexpr size_t O_X1 = O_OG + al64k((size_t)M * 512 * 2);
constexpr size_t O_Y = O_X1 + al64k((size_t)M * 1024 * 4);
constexpr size_t O_H2 = O_Y + al64k((size_t)M * 1024 * 2);
constexpr size_t O_ACT = O_H2 + al64k((size_t)M * 1024 * 2);
constexpr size_t O_YS = O_ACT + al64k((size_t)ACT_ROWS * 1024 * 2);
constexpr size_t WS_END = O_YS + al64k((size_t)65536 * 1024 * 2);
static_assert(WS_END <= (size_t)1 << 30, "workspace map exceeds 1 GiB");
constexpr int CW_TMO = 0;
constexpr int CW_BAR = 4096;
constexpr int CW_CNT = 16384;
constexpr int CW_MODF = 20480;
constexpr int MOD_ITEMS = 192;

constexpr int RING_BYTES = 131072;
constexpr int XTRA_OFF = RING_BYTES, XTRA_BYTES = 16384;
constexpr int MISC_OFF = XTRA_OFF + XTRA_BYTES;
constexpr int LDS_BYTES = MISC_OFF + 256;
static_assert(LDS_BYTES <= 163840, "LDS");

DI float bf2f(bf16_t h) { return __uint_as_float((unsigned)h << 16); }
DI unsigned pk2(float lo, float hi) { f32x2 v = {lo, hi}; bf16x2_t b = __builtin_convertvector(v, bf16x2_t); return __builtin_bit_cast(unsigned, b); }
DI bf16_t f2bf(float f) { return (bf16_t)(pk2(f, 0.f) & 0xffffu); }
DI float bflo(unsigned w) { return __uint_as_float(w << 16); }
DI float bfhi(unsigned w) { return __uint_as_float(w & 0xffff0000u); }
DI float sigmoidf_(float x) { return 1.f / (1.f + __expf(-x)); }
DI float clamp8(float x) { return __builtin_amdgcn_fmed3f(x, -448.f, 448.f); }
DI unsigned pk4_fp8(float a, float b, float c, float d) { int w = 0; w = __builtin_amdgcn_cvt_pk_fp8_f32(clamp8(a), clamp8(b), w, false); w = __builtin_amdgcn_cvt_pk_fp8_f32(clamp8(c), clamp8(d), w, true); return (unsigned)w; }
constexpr float W8_SCALE = 32.f, ACT8_SCALE = 4.f, YS8_SCALE = 16.f, MIX8_SCALE = 4.f;
#define DPP_ADD(v, ctrl, rmask) ((v) + __builtin_bit_cast(float, __builtin_amdgcn_update_dpp(0, __builtin_bit_cast(int, (v)), (ctrl), (rmask), 0xf, true)))
DI float wave_sum_dpp(float v) {
    v = DPP_ADD(v, 0xB1, 0xf); v = DPP_ADD(v, 0x4E, 0xf); v = DPP_ADD(v, 0x141, 0xf); v = DPP_ADD(v, 0x140, 0xf);
    v = DPP_ADD(v, 0x142, 0xa); v = DPP_ADD(v, 0x143, 0xc);
    return __builtin_bit_cast(float, __builtin_amdgcn_readlane(__builtin_bit_cast(int, v), 63));
}
DI float max_nc(float a, float b) { float r; asm("v_max_f32_e32 %0, %1, %2" : "=v"(r) : "v"(a), "v"(b)); return r; }
DI float max3_nc(float a, float b, float c) { float r; asm("v_max3_f32 %0, %1, %2, %3" : "=v"(r) : "v"(a), "v"(b), "v"(c)); return r; }
DI float xmax16(float m) { const auto r = __builtin_amdgcn_permlane16_swap(__float_as_uint(m), __float_as_uint(m), false, false); return max_nc(__uint_as_float(r[0]), __uint_as_float(r[1])); }
DI float xmax32(float m) { const auto r = __builtin_amdgcn_permlane32_swap(__float_as_uint(m), __float_as_uint(m), false, false); return max_nc(__uint_as_float(r[0]), __uint_as_float(r[1])); }
DI float xadd16(float m) { const auto r = __builtin_amdgcn_permlane16_swap(__float_as_uint(m), __float_as_uint(m), false, false); return __uint_as_float(r[0]) + __uint_as_float(r[1]); }
DI float xadd32(float m) { const auto r = __builtin_amdgcn_permlane32_swap(__float_as_uint(m), __float_as_uint(m), false, false); return __uint_as_float(r[0]) + __uint_as_float(r[1]); }
#define LDS_WAIT() asm volatile("s_waitcnt lgkmcnt(0)" ::: "memory")
#define LDS_BAR() asm volatile("s_waitcnt lgkmcnt(0)\n\ts_barrier" ::: "memory")
#define VM_WAIT() asm volatile("s_waitcnt vmcnt(0)" ::: "memory")

#define XB_TMO      128
#define XB_XCNT(j)  (256  + 64 * (j))
#define XB_XSUB(j)  (1280 + 64 * (j))
#define XB_XGEN(j)  (2304 + 64 * (j))
#define XB_TOP      3328
#define XB_TOPGEN   3392
#define XCD_BAR_WORDS 3456
#define XB_SPIN_CAP (1u << 18)
DI unsigned xb_ld(unsigned* p)              { return __hip_atomic_load(p, __ATOMIC_RELAXED, __HIP_MEMORY_SCOPE_AGENT); }
DI unsigned xb_add(unsigned* p, unsigned v) { return __hip_atomic_fetch_add(p, v, __ATOMIC_RELAXED, __HIP_MEMORY_SCOPE_AGENT); }
DI unsigned xb_xcc_id() { return (unsigned)__builtin_amdgcn_s_getreg((3 << 11) | 20) & 0xFu; }
#define XB_SPIN(cond, bar) do { unsigned _sp = 0; while (cond) { __builtin_amdgcn_s_sleep(1); \
    if ((++_sp & 255u) == 0u) { if (xb_ld(&(bar)[XB_TMO])) break; if (_sp > XB_SPIN_CAP) { atomicAdd(&(bar)[XB_TMO], 1u); break; } } } } while (0)
struct XcdBarrier { unsigned* bar; unsigned x; volatile LAS unsigned* st; };
DI XcdBarrier xcd_barrier_post(unsigned* bar, volatile LAS unsigned* st) {
    XcdBarrier b; b.bar = bar; b.x = xb_xcc_id(); b.st = st;
    if (threadIdx.x == 0) (void)xb_add(&bar[XB_XCNT(b.x)], 1u);
    return b;
}
DI void xcd_barrier_complete(unsigned* bar, unsigned x, unsigned& nloc, unsigned& nx) {
    const unsigned G = gridDim.x * gridDim.y * gridDim.z;
    unsigned sum, cnt, mine, sp = 0u;
    for (;;) {
        sum = 0u; cnt = 0u; mine = 0u;
#pragma unroll
        for (unsigned j = 0; j < 16; ++j) { const unsigned c = xb_ld(&bar[XB_XCNT(j)]); sum += c; cnt += (c > 0u) ? 1u : 0u; mine = (j == x) ? c : mine; }
        if (sum == G) break;
        __builtin_amdgcn_s_sleep(1);
        if ((++sp & 255u) == 0u) { if (xb_ld(&bar[XB_TMO])) break; if (sp > XB_SPIN_CAP) { atomicAdd(&bar[XB_TMO], 1u); break; } }
    }
    nloc = mine > 0u ? mine : 1u; nx = cnt > 0u ? cnt : 1u;
}
DI void xcd_barrier(const XcdBarrier& b) {
    asm volatile("s_waitcnt vmcnt(0)" ::: "memory");
    __syncthreads();
    if (threadIdx.x == 0) {
        unsigned* bar = b.bar;
        __builtin_amdgcn_s_waitcnt(0);
        unsigned nloc = b.st[0], nx = b.st[1];
        if (nloc == 0u) { xcd_barrier_complete(bar, b.x, nloc, nx); b.st[0] = nloc; b.st[1] = nx; }
        const unsigned old = xb_add(&bar[XB_XSUB(b.x)], 1u);
        const unsigned gen = old / nloc;
        if (old + 1u == (gen + 1u) * nloc) {
            __builtin_amdgcn_fence(__ATOMIC_RELEASE, "agent");
            asm volatile("s_waitcnt vmcnt(0)" ::: "memory");
            const unsigned og = xb_add(&bar[XB_TOP], 1u);
            const unsigned tg = og / nx;
            if (og + 1u == (tg + 1u) * nx) xb_add(&bar[XB_TOPGEN], 1u);
            else XB_SPIN(xb_ld(&bar[XB_TOPGEN]) == tg, bar);
            __builtin_amdgcn_fence(__ATOMIC_ACQUIRE, "agent");
            xb_add(&bar[XB_XGEN(b.x)], 1u);
            asm volatile("s_waitcnt vmcnt(0)" ::: "memory");
        } else {
            XB_SPIN(xb_ld(&bar[XB_XGEN(b.x)]) == gen, bar);
            __builtin_amdgcn_fence(__ATOMIC_ACQUIRE, "agent");
            asm volatile("s_waitcnt vmcnt(0)" ::: "memory");
        }
    }
    __syncthreads();
}

namespace pg8 {
constexpr int BM = 256, BK = 64, HALF = 128, HTB = HALF * BK * 2, STAGE_BYTES = 8 * HTB, NXCD = 8, WGM = 8;
__host__ __device__ __forceinline__ int lds_byte(int r, int c) { const int st = (r >> 4) * 2 + (c >> 5), rr = r & 15, cc = c & 31, ob = rr * 64 + cc * 2; return st * 1024 + (ob ^ (((ob >> 9) & 1) << 5)); }
__host__ __device__ __forceinline__ void stage_rc(int b, int& R, int& C) { const int st = b / 1024, sb = b % 1024, swz = sb ^ (((sb >> 9) & 1) << 5); R = (st >> 1) * 16 + swz / 64; C = (st & 1) * 32 + (swz % 64) / 2; }
struct Unit { int pm, pn, e, tl, cnt; };
DI void tile_order(int L, int nM, int nN, int& pm, int& pn) {
    const int nwg = nM * nN; int wgid = L;
    { const int q = nwg / NXCD, r = nwg % NXCD, xcd = wgid % NXCD, off = wgid / NXCD; wgid = (xcd < r ? xcd * (q + 1) : r * (q + 1) + (xcd - r) * q) + off; }
    const int nig = WGM * nN, gid = wgid / nig, fm = gid * WGM, gsz = (nM - fm) < WGM ? (nM - fm) : WGM;
    pm = fm + ((wgid % nig) % gsz); pn = (wgid % nig) / gsz;
}
template <class Epi, class Sched, bool ALIGN_EPI, bool FP8 = false>
DI void gemm_phase(LAS unsigned char* lds, const int K, const Sched& S, const Epi& E) {
    const int tid = threadIdx.x, wid = __builtin_amdgcn_readfirstlane(tid >> 6), lane = tid & 63, wr = wid >> 2, wc = wid & 3, fr = lane & 15, fq = lane >> 4;
    const int rowb = FP8 ? K : 2 * K;
    const int nt = rowb / 128;
    int Rr[2], Cc[2]; unsigned voffB[2];
#pragma unroll
    for (int i = 0; i < 2; ++i) { int R, C; stage_rc(tid * 16 + i * 8192, R, C); Rr[i] = R; Cc[i] = C; voffB[i] = (unsigned)(R * rowb + C * 2); }
    const size_t kstep = (size_t)(BK * 2);
    const size_t hstep = (size_t)HALF * rowb;
    const unsigned ldsw = (unsigned)wid * 1024u;
    const int aoff = lds_byte(wr * 64 + fr, fq * 8), boff = lds_byte(wc * 32 + fr, fq * 8);
#define PG8_SA(b, h) (((b) * 2 + (h)) * HTB)
#define PG8_SB(b, h) ((4 + (b) * 2 + (h)) * HTB)
#define PG8_STAGE(bufoff, gbase, voff) do { _Pragma("unroll") for (int _i = 0; _i < 2; ++_i) \
        __builtin_amdgcn_global_load_lds((const unsigned*)((const char*)(gbase) + (voff)[_i]), (LAS unsigned*)(lds + (bufoff) + ldsw + _i * 8192), 16, 0, 0); } while (0)
#define PG8_LD2(base) __builtin_shufflevector(*(const LAS i32x4*)(base), *(const LAS i32x4*)((base) + 1024), 0, 1, 2, 3, 4, 5, 6, 7)
#define PG8_LDA(dst, b, h) do { if constexpr (FP8) { _Pragma("unroll") for (int m = 0; m < 4; ++m) dst##8[m] = PG8_LD2(lds + PG8_SA(b, h) + aoff + m * 2048); } \
        else { _Pragma("unroll") for (int m = 0; m < 4; ++m) _Pragma("unroll") for (int k = 0; k < 2; ++k) dst[m][k] = *(const LAS bf16x8*)(lds + PG8_SA(b, h) + aoff + m * 2048 + k * 1024); } } while (0)
#define PG8_LDB(dst, b, h) do { if constexpr (FP8) { _Pragma("unroll") for (int n = 0; n < 2; ++n) dst##8[n] = PG8_LD2(lds + PG8_SB(b, h) + boff + n * 2048); } \
        else { _Pragma("unroll") for (int n = 0; n < 2; ++n) _Pragma("unroll") for (int k = 0; k < 2; ++k) dst[n][k] = *(const LAS bf16x8*)(lds + PG8_SB(b, h) + boff + n * 2048 + k * 1024); } } while (0)
#define PG8_CAT(x) __builtin_shufflevector(__builtin_bit_cast(i32x4, (x)[0]), __builtin_bit_cast(i32x4, (x)[1]), 0, 1, 2, 3, 4, 5, 6, 7)
#define PG8_MMA(ai, bj, At, Bt) do { __builtin_amdgcn_s_setprio(1); \
        if constexpr (FP8) { _Pragma("unroll") for (int m = 0; m < 4; ++m) _Pragma("unroll") for (int n = 0; n < 2; ++n) \
            asm volatile("v_mfma_scale_f32_16x16x128_f8f6f4 %0, %1, %2, %0, %3, %3 op_sel_hi:[0,0,0]" : "+v"(acc[ai][bj][m][n]) : "v"(Bt##8[n]), "v"(At##8[m]), "v"(sc8)); } \
        else { _Pragma("unroll") for (int m = 0; m < 4; ++m) _Pragma("unroll") for (int n = 0; n < 2; ++n) _Pragma("unroll") for (int k = 0; k < 2; ++k) \
            acc[ai][bj][m][n] = __builtin_amdgcn_mfma_f32_16x16x32_bf16(Bt[n][k], At[m][k], acc[ai][bj][m][n], 0, 0, 0); } \
        __builtin_amdgcn_s_setprio(0); } while (0)
#define PG8_WAIT_V(n) asm volatile("s_waitcnt vmcnt(" #n ")" ::: "memory")
#define PG8_WAIT_L(n) asm volatile("s_waitcnt lgkmcnt(" #n ")" ::: "memory")
#define PG8_WAIT_VX() do { if constexpr (Epi::RELAX == 8) { if (t == 0 && relax) PG8_WAIT_V(16); else PG8_WAIT_V(8); } else PG8_WAIT_V(8); } while (0)
#define PG8_BAR __builtin_amdgcn_s_barrier()
#define PG8_SCHED __builtin_amdgcn_sched_barrier(0)
    Unit cur, nxt; int ui = 0, relax = 0;
    if (!S.next(0, cur)) return;
    f32x4 acc[2][2][4][2];
#pragma unroll
    for (int a = 0; a < 2; ++a)
#pragma unroll
        for (int b = 0; b < 2; ++b)
#pragma unroll
            for (int m = 0; m < 4; ++m)
#pragma unroll
                for (int n = 0; n < 2; ++n) acc[a][b][m][n] = (f32x4){0.f, 0.f, 0.f, 0.f};
    const int sc8 = 0x7f7f7f7f;
    bf16x8 At[4][2], B0[2][2], B1[2][2]; i32x8 At8[4], B08[2], B18[2];
    unsigned oc0[2], oc1[2], on0[2], on1[2];
    S.a_offs(cur, Rr, Cc, rowb, oc0, oc1);
    const char* cA = S.a_base(cur); const char* cB = S.b_base(cur);
    PG8_STAGE(PG8_SB(0, 0), cB, voffB); PG8_STAGE(PG8_SB(0, 1), cB + hstep, voffB); PG8_STAGE(PG8_SA(0, 0), cA, oc0); PG8_STAGE(PG8_SA(0, 1), cA, oc1);
    if (wr == 1) PG8_BAR;
    PG8_WAIT_V(2); PG8_BAR;
    PG8_STAGE(PG8_SB(1, 0), cB + kstep, voffB); PG8_STAGE(PG8_SA(1, 0), cA + kstep, oc0); PG8_STAGE(PG8_SB(1, 1), cB + hstep + kstep, voffB);
    PG8_WAIT_V(6); PG8_BAR;
    for (;;) {
        const bool has_next = S.next(ui + 1, nxt);
        const char* nA = cA; const char* nB = cB;
        on0[0] = oc0[0]; on0[1] = oc0[1]; on1[0] = oc1[0]; on1[1] = oc1[1];
        if (has_next) { nA = S.a_base(nxt); nB = S.b_base(nxt); S.a_offs(nxt, Rr, Cc, rowb, on0, on1); }
        for (int t = 0; t < nt; t += 2) {
            if constexpr (Epi::MIDK != 0) { if (t == Epi::MIDK) E.mid(acc, cur, wr, wc, fr, fq); }
            const bool last = (t == nt - 2);
            const char* a1 = cA + (size_t)(t + 1) * kstep;
            const char* a2 = last ? nA : cA + (size_t)(t + 2) * kstep; const char* b2 = last ? nB : cB + (size_t)(t + 2) * kstep;
            const char* a3 = a2 + kstep; const char* b3 = b2 + kstep;
            PG8_LDB(B0, 0, 0); PG8_LDB(B1, 0, 1); PG8_SCHED; PG8_LDA(At, 0, 0); PG8_STAGE(PG8_SA(1, 1), a1, oc1);
            PG8_WAIT_VX(); PG8_WAIT_L(0); PG8_BAR; PG8_MMA(0, 0, At, B0); PG8_MMA(0, 1, At, B1); PG8_BAR; PG8_SCHED;
            PG8_LDA(At, 0, 1); PG8_STAGE(PG8_SB(0, 0), b2, voffB); PG8_STAGE(PG8_SB(0, 1), b2 + hstep, voffB); if (last) { PG8_STAGE(PG8_SA(0, 0), a2, on0); } else { PG8_STAGE(PG8_SA(0, 0), a2, oc0); }
            PG8_WAIT_VX(); PG8_WAIT_L(0); PG8_BAR; PG8_MMA(1, 0, At, B0); PG8_MMA(1, 1, At, B1); PG8_BAR; PG8_SCHED;
            PG8_LDB(B0, 1, 0); PG8_LDB(B1, 1, 1); PG8_SCHED; PG8_LDA(At, 1, 0); if (last) { PG8_STAGE(PG8_SA(0, 1), a2, on1); } else { PG8_STAGE(PG8_SA(0, 1), a2, oc1); }
            PG8_WAIT_V(8); PG8_WAIT_L(0); PG8_BAR; PG8_MMA(0, 0, At, B0); PG8_MMA(0, 1, At, B1); PG8_BAR; PG8_SCHED;
            PG8_LDA(At, 1, 1); PG8_STAGE(PG8_SB(1, 0), b3, voffB); PG8_STAGE(PG8_SB(1, 1), b3 + hstep, voffB); if (last) { PG8_STAGE(PG8_SA(1, 0), a3, on0); } else { PG8_STAGE(PG8_SA(1, 0), a3, oc0); }
            PG8_WAIT_V(8); PG8_WAIT_L(0); PG8_BAR; PG8_MMA(1, 0, At, B0); PG8_MMA(1, 1, At, B1); PG8_BAR; PG8_SCHED;
        }
        if constexpr (ALIGN_EPI) { if (wr == 0) PG8_BAR; }
        if constexpr (FP8) asm volatile("s_nop 15\n\ts_nop 15" ::: "memory");
        E(acc, cur, wr, wc, fr, fq); relax = 1;
        if (!has_next) break;
#pragma unroll
        for (int a = 0; a < 2; ++a)
#pragma unroll
            for (int b = 0; b < 2; ++b)
#pragma unroll
                for (int m = 0; m < 4; ++m)
#pragma unroll
                    for (int n = 0; n < 2; ++n) acc[a][b][m][n] = (f32x4){0.f, 0.f, 0.f, 0.f};
        cur = nxt; cA = nA; cB = nB; ++ui;
        oc0[0] = on0[0]; oc0[1] = on0[1]; oc1[0] = on1[0]; oc1[1] = on1[1];
        if constexpr (ALIGN_EPI) { if (wr == 1) PG8_BAR; }
    }
    PG8_WAIT_V(0);
    if constexpr (!ALIGN_EPI) { if (wr == 0) PG8_BAR; }
    PG8_BAR;
#undef PG8_SA
#undef PG8_SB
#undef PG8_STAGE
#undef PG8_LDA
#undef PG8_LDB
#undef PG8_MMA
#undef PG8_CAT
#undef PG8_LD2
#undef PG8_WAIT_V
#undef PG8_WAIT_L
#undef PG8_WAIT_VX
#undef PG8_BAR
#undef PG8_SCHED
}
}
using pg8::Unit;

DI int slot_std8(int L) { return (L & 0xE0) | (((L >> 2) & 1) << 4) | (((L >> 3) & 3) << 2) | (L & 3); }
DI int slot_head(int hh, int d) { return 128 * (d >> 5) + 32 * hh + (d & 31); }

struct SchedBase {
    DI void offs_plain(const int (&Rr)[2], const int (&Cc)[2], int rowb, unsigned (&o0)[2], unsigned (&o1)[2]) const {
#pragma unroll
        for (int i = 0; i < 2; ++i) { o0[i] = (unsigned)(Rr[i] * rowb + Cc[i] * 2); o1[i] = (unsigned)((Rr[i] + 128) * rowb + Cc[i] * 2); }
    }
};
struct InProjSched : SchedBase {
    int G, c; const char* A; const char* Bt;
    DI bool next(int i, Unit& u) const {
        const int L = i * G + c; if (L >= 752) return false;
        if (L < 704) pg8::tile_order(L, 64, 11, u.pm, u.pn); else { const int L2 = L - 704; u.pm = 64 + (L2 & 7); u.pn = 2 + (L2 >> 3); }
        u.e = 0; u.tl = 0; u.cnt = 0; return true;
    }
    DI const char* a_base(const Unit& u) const { return A + (size_t)u.pm * (256 * 1024 * 2); }
    DI const char* b_base(const Unit& u) const { return Bt + (size_t)u.pn * (256 * 1024 * 2); }
    DI void a_offs(const Unit&, const int (&Rr)[2], const int (&Cc)[2], int rowb, unsigned (&o0)[2], unsigned (&o1)[2]) const { offs_plain(Rr, Cc, rowb, o0, o1); }
};
struct PlainSched : SchedBase {
    int G, c, nM, nN, K, eb; const char* A; const char* Bt;
    DI bool next(int i, Unit& u) const {
        const int L = i * G + c; if (L >= nM * nN) return false;
        pg8::tile_order(L, nM, nN, u.pm, u.pn); u.e = 0; u.tl = 0; u.cnt = 0; return true;
    }
    DI const char* a_base(const Unit& u) const { return A + (size_t)u.pm * 256 * K * eb; }
    DI const char* b_base(const Unit& u) const { return Bt + (size_t)u.pn * 256 * K * eb; }
    DI void a_offs(const Unit&, const int (&Rr)[2], const int (&Cc)[2], int rowb, unsigned (&o0)[2], unsigned (&o1)[2]) const { offs_plain(Rr, Cc, rowb, o0, o1); }
};
template <bool GATHER, int LOGNPN>
struct MoeSched : SchedBase {
    int G, cv; const LAS int* TT; const char* A; const char* Bt; size_t b_estride; const int* LIST;
    DI bool next(int i, Unit& u) const {
        const int ntl = __builtin_amdgcn_readfirstlane(TT[0]);
        const int per = (G & 7) ? G : (G >> 3), xq = cv / per, rr = cv - xq * per, T8 = (G & 7) ? ntl : ((ntl + 7) >> 3);
        const int ux = i * per + rr, tt = xq * T8 + (ux >> LOGNPN);
        if ((ux >> LOGNPN) >= T8 || tt >= ntl) return false;
        const int ent = __builtin_amdgcn_readfirstlane(TT[64 + tt]);
        u.pm = tt; u.pn = ux & ((1 << LOGNPN) - 1); u.e = ent & 255; u.tl = ent >> 8; u.cnt = __builtin_amdgcn_readfirstlane(TT[1 + u.e]); return true;
    }
    DI const char* a_base(const Unit& u) const { return GATHER ? A : A + (size_t)u.pm * (256 * 1024); }
    DI const char* b_base(const Unit& u) const { return Bt + (size_t)u.e * b_estride + (size_t)u.pn * (256 * 1024); }
    DI void a_offs(const Unit& u, const int (&Rr)[2], const int (&Cc)[2], int rowb, unsigned (&o0)[2], unsigned (&o1)[2]) const {
        if constexpr (!GATHER) { offs_plain(Rr, Cc, rowb, o0, o1); }
        else {
#pragma unroll
            for (int i = 0; i < 2; ++i) {
                const int p0 = 256 * u.tl + Rr[i], p1 = p0 + 128;
                const int s0 = (p0 < u.cnt) ? LIST[u.e * LISTCAP + p0] : 0, s1 = (p1 < u.cnt) ? LIST[u.e * LISTCAP + p1] : 0;
                o0[i] = (unsigned)((s0 >> 2) * rowb + Cc[i] * 2); o1[i] = (unsigned)((s1 >> 2) * rowb + Cc[i] * 2);
            }
        }
    }
};

typedef const f32x4 (&AccRef)[2][2][4][2];
DI void st8bf(bf16_t* p, f32x4 a, f32x4 b) { u32x4 w; w.x = pk2(a.x, a.y); w.y = pk2(a.z, a.w); w.z = pk2(b.x, b.y); w.w = pk2(b.z, b.w); *(u32x4*)p = w; }
DI void st4bf(bf16_t* p, f32x4 a) { u32x2 w; w.x = pk2(a.x, a.y); w.y = pk2(a.z, a.w); *(u32x2*)p = w; }
DI f32x2 sig2(f32x2 x) { const f32x2 t = x * (-LOG2E); f32x2 e; e.x = __builtin_amdgcn_exp2f(t.x); e.y = __builtin_amdgcn_exp2f(t.y); const f32x2 d = e + 1.0f; f32x2 r; r.x = __builtin_amdgcn_rcpf(d.x); r.y = __builtin_amdgcn_rcpf(d.y); return r; }
DI f32x4 sig4p(f32x4 v) { const f32x2 a = sig2((f32x2){v.x, v.y}), b = sig2((f32x2){v.z, v.w}); return (f32x4){a.x, a.y, b.x, b.y}; }
DI f32x4 silu4p(f32x4 v) { return v * sig4p(v); }
DI float logsig16(float z) { return (fminf(z, 0.f) - __logf(1.f + __expf(-fabsf(z)))) * 0.0625f; }

struct EpiInProj {
    static constexpr int MIDK = 0, RELAX = 0;
    bf16_t *Q, *Kb, *Vb, *GQ, *GK, *GV, *GR, *GA, *GG, *LAF, *LAB;
    const float *qn, *kn, *baf, *bab, *ropec, *ropes;
    DI void operator()(AccRef acc, const Unit& u, int wr, int wc, int fr, int fq) const {
        const int pn = u.pn, rowb = u.pm * 256 + wr * 64 + fr;
        if (pn <= 2) {
            const bool isV = (pn == 2 && wc >= 2), isK = (pn == 2 && wc < 2);
            const bool rope = (u.pm < 64) && !isV;
            const float* g = isK ? kn : qn;
            f32x4 gv[2][2];
#pragma unroll
            for (int bj = 0; bj < 2; ++bj)
#pragma unroll
                for (int n = 0; n < 2; ++n) gv[bj][n] = *(const f32x4*)(g + 32 * bj + 16 * n + 4 * fq);
            bf16_t* outp; int ld, colb;
            if (pn < 2) { outp = Q; ld = 512; colb = (4 * pn + wc) * 64; } else if (isK) { outp = Kb; ld = 128; colb = wc * 64; } else { outp = Vb; ld = 128; colb = (wc - 2) * 64; }
            const float osc = (pn < 2) ? QSCALE : 1.f;
#pragma unroll
            for (int ai = 0; ai < 2; ++ai)
#pragma unroll
                for (int m = 0; m < 4; ++m) {
                    const int r = rowb + ai * 128 + m * 16;
                    f32x4 v[2][2];
#pragma unroll
                    for (int bj = 0; bj < 2; ++bj)
#pragma unroll
                        for (int n = 0; n < 2; ++n) v[bj][n] = acc[ai][bj][m][n];
                    if (!isV) {
                        float ss = 0.f;
#pragma unroll
                        for (int bj = 0; bj < 2; ++bj)
#pragma unroll
                            for (int n = 0; n < 2; ++n) ss += (v[bj][n].x * v[bj][n].x + v[bj][n].y * v[bj][n].y) + (v[bj][n].z * v[bj][n].z + v[bj][n].w * v[bj][n].w);
                        ss = xadd32(xadd16(ss));
                        const float rstd = __builtin_amdgcn_rsqf(ss * (1.f / 64.f) + EPS);
#pragma unroll
                        for (int bj = 0; bj < 2; ++bj)
#pragma unroll
                            for (int n = 0; n < 2; ++n) v[bj][n] = v[bj][n] * rstd * gv[bj][n];
                        if (rope) {
                            const int t = r & (T - 1);
#pragma unroll
                            for (int bj = 0; bj < 2; ++bj) {
                                const int pos = bj ? (t & 63) : (t >> 6);
                                const f32x4 cs = *(const f32x4*)(ropec + pos * 16 + 4 * fq), sn = *(const f32x4*)(ropes + pos * 16 + 4 * fq);
                                const f32x4 x1 = v[bj][0], x2 = v[bj][1];
                                v[bj][0] = x1 * cs - x2 * sn; v[bj][1] = x2 * cs + x1 * sn;
                            }
                        }
#pragma unroll
                        for (int bj = 0; bj < 2; ++bj)
#pragma unroll
                            for (int n = 0; n < 2; ++n) v[bj][n] = v[bj][n] * osc;
                    }
                    bf16_t* rp = outp + (size_t)r * ld + colb + 4 * fq;
#pragma unroll
                    for (int bj = 0; bj < 2; ++bj)
#pragma unroll
                        for (int n = 0; n < 2; ++n) st4bf(rp + 32 * bj + 16 * n, v[bj][n]);
                }
            return;
        }
        const int lcol = 32 * wc + 8 * fq;
        if (pn == 6 || pn == 7) {
            bf16_t* outp = (pn == 6) ? LAF : LAB; const float* bb = (pn == 6) ? baf : bab;
            f32x4 bv[2][2];
#pragma unroll
            for (int bj = 0; bj < 2; ++bj)
#pragma unroll
                for (int n = 0; n < 2; ++n) bv[bj][n] = *(const f32x4*)(bb + 128 * bj + lcol + 4 * n);
#pragma unroll
            for (int ai = 0; ai < 2; ++ai)
#pragma unroll
                for (int m = 0; m < 4; ++m) {
                    const int r = rowb + ai * 128 + m * 16;
#pragma unroll
                    for (int bj = 0; bj < 2; ++bj) {
                        const f32x4 z0 = acc[ai][bj][m][0] + bv[bj][0], z1 = acc[ai][bj][m][1] + bv[bj][1];
                        st8bf(outp + (size_t)r * 256 + 128 * bj + lcol, (f32x4){logsig16(z0.x), logsig16(z0.y), logsig16(z0.z), logsig16(z0.w)}, (f32x4){logsig16(z1.x), logsig16(z1.y), logsig16(z1.z), logsig16(z1.w)});
                    }
                }
            return;
        }
        bf16_t* outp; int ld, colb, mode;
        if (pn == 3) { outp = GK; ld = 256; colb = 0; mode = 0; }
        else if (pn <= 5) { outp = GV; ld = 512; colb = 256 * (pn - 4); mode = 0; }
        else if (pn == 8) { outp = GQ; ld = 256; colb = 0; mode = 1; }
        else if (pn <= 10) { outp = GR; ld = 512; colb = 256 * (pn - 9); mode = 2; }
        else if (pn <= 14) { outp = GA; ld = 1024; colb = 256 * (pn - 11); mode = 3; }
        else { outp = GG; ld = 1024; colb = 256 * (pn - 15); mode = 3; }
#pragma unroll
        for (int ai = 0; ai < 2; ++ai)
#pragma unroll
            for (int m = 0; m < 4; ++m) {
                const int r = rowb + ai * 128 + m * 16;
#pragma unroll
                for (int bj = 0; bj < 2; ++bj) {
                    f32x4 a = acc[ai][bj][m][0], b = acc[ai][bj][m][1];
                    if (mode == 1) { a = a * 0.125f; b = b * 0.125f; }
                    else if (mode == 2) { a = silu4p(a); b = silu4p(b); }
                    else if (mode == 3) { a = sig4p(a); b = sig4p(b); }
                    st8bf(outp + (size_t)r * ld + colb + 128 * bj + lcol, a, b);
                }
            }
    }
};

struct EpiGates {
    static constexpr int MIDK = 0, RELAX = 0;
    bf16_t *GA, *GG;
    DI void operator()(AccRef acc, const Unit& u, int wr, int wc, int fr, int fq) const {
        const int rowb = u.pm * 256 + wr * 64 + fr, lcol = 32 * wc + 8 * fq;
        bf16_t* outp = (u.pn < 4 ? GA : GG) + 256 * (u.pn & 3);
#pragma unroll
        for (int ai = 0; ai < 2; ++ai)
#pragma unroll
            for (int m = 0; m < 4; ++m) {
                const int r = rowb + ai * 128 + m * 16;
#pragma unroll
                for (int bj = 0; bj < 2; ++bj)
                    st8bf(outp + (size_t)r * 1024 + 128 * bj + lcol, sig4p(acc[ai][bj][m][0] * (1.f / W8_SCALE)), sig4p(acc[ai][bj][m][1] * (1.f / W8_SCALE)));
            }
    }
};

struct EpiMerge1 {
    static constexpr int MIDK = 4, RELAX = 0;
    const bf16_t *GA, *GG; unsigned char* Y;
    DI void mid(f32x4 (&acc)[2][2][4][2], const Unit& u, int wr, int wc, int fr, int fq) const {
        unsigned z; asm volatile("v_mov_b32 %0, 0" : "=v"(z));
        const unsigned base = (unsigned)((u.pm * 256 + wr * 64 + fr) * 1024 + u.pn * 256 + 32 * wc + 8 * fq) * 2u + z;
#pragma unroll
        for (int ai = 0; ai < 2; ++ai)
#pragma unroll
            for (int m = 0; m < 4; ++m) {
#pragma unroll
                for (int bj = 0; bj < 2; ++bj) {
                    const unsigned off = base + (unsigned)((ai * 128 + m * 16) * 1024 + 128 * bj) * 2u;
                    const u32x4 aw = *(const u32x4*)((const char*)GA + off), gw = *(const u32x4*)((const char*)GG + off);
                    const f32x4 a0 = {bflo(aw.x), bfhi(aw.x), bflo(aw.y), bfhi(aw.y)}, a1 = {bflo(aw.z), bfhi(aw.z), bflo(aw.w), bfhi(aw.w)};
                    const f32x4 g0 = {bflo(gw.x), bfhi(gw.x), bflo(gw.y), bfhi(gw.y)}, g1 = {bflo(gw.z), bfhi(gw.z), bflo(gw.w), bfhi(gw.w)};
#pragma unroll
                    for (int e = 0; e < 4; ++e) { acc[ai][bj][m][0][e] *= a0[e] * __builtin_amdgcn_rcpf(fmaxf(g0[e], 1e-30f)); acc[ai][bj][m][1][e] *= a1[e] * __builtin_amdgcn_rcpf(fmaxf(g1[e], 1e-30f)); }
                }
                asm volatile("" ::: "memory");
            }
    }
    DI void operator()(AccRef acc, const Unit& u, int wr, int wc, int fr, int fq) const {
        const int rowb = u.pm * 256 + wr * 64 + fr, colb = u.pn * 256 + 32 * wc + 8 * fq;
#pragma unroll
        for (int ai = 0; ai < 2; ++ai)
#pragma unroll
            for (int m = 0; m < 4; ++m) {
                const int r = rowb + ai * 128 + m * 16;
#pragma unroll
                for (int bj = 0; bj < 2; ++bj) {
                    const size_t off = (size_t)r * 1024 + colb + 128 * bj;
                    const u32x4 gw = *(const u32x4*)(GG + off);
                    const f32x4 g0 = {bflo(gw.x), bfhi(gw.x), bflo(gw.y), bfhi(gw.y)}, g1 = {bflo(gw.z), bfhi(gw.z), bflo(gw.w), bfhi(gw.w)};
                    { const f32x4 a = acc[ai][bj][m][0] * g0 * (MIX8_SCALE / (W8_SCALE * MIX8_SCALE)), b = acc[ai][bj][m][1] * g1 * (MIX8_SCALE / (W8_SCALE * MIX8_SCALE));
                      u32x2 w; w.x = pk4_fp8(a.x, a.y, a.z, a.w); w.y = pk4_fp8(b.x, b.y, b.z, b.w); *(u32x2*)(Y + off) = w; }
                }
            }
    }
};

struct EpiMerge2 {
    static constexpr int MIDK = 0, RELAX = 0;
    const float* x; const float* MOD; bf16_t* X1;
    DI void operator()(AccRef acc, const Unit& u, int wr, int wc, int fr, int fq) const {
        const int rowb = u.pm * 256 + wr * 64 + fr, colb = u.pn * 256 + 32 * wc + 8 * fq;
        const int b = (u.pm * 256) >> 11;
        f32x4 gt[2][2];
#pragma unroll
        for (int bj = 0; bj < 2; ++bj)
#pragma unroll
            for (int n = 0; n < 2; ++n) gt[bj][n] = *(const f32x4*)(MOD + b * 6144 + 2048 + colb + 128 * bj + 4 * n);
#pragma unroll
        for (int ai = 0; ai < 2; ++ai)
#pragma unroll
            for (int m = 0; m < 4; ++m) {
                const int r = rowb + ai * 128 + m * 16;
#pragma unroll
                for (int bj = 0; bj < 2; ++bj) {
                    const size_t off = (size_t)r * 1024 + colb + 128 * bj;
                    const f32x4 x0 = *(const f32x4*)(x + off), x1 = *(const f32x4*)(x + off + 4);
                    st8bf(X1 + off, x0 + gt[bj][0] * acc[ai][bj][m][0] * (1.f / (W8_SCALE * MIX8_SCALE)), x1 + gt[bj][1] * acc[ai][bj][m][1] * (1.f / (W8_SCALE * MIX8_SCALE)));
                }
            }
    }
};

struct EpiMoe1 {
    static constexpr int MIDK = 0, RELAX = 8;
    const float* b1; unsigned char* ACT;
    DI void operator()(AccRef acc, const Unit& u, int wr, int wc, int fr, int fq) const {
        const int rowb = u.pm * 256 + wr * 64 + fr, f0 = 128 * u.pn + 32 * wc + 8 * fq;
        f32x4 bg[2], bu[2];
#pragma unroll
        for (int n = 0; n < 2; ++n) { bg[n] = *(const f32x4*)(b1 + (size_t)u.e * 2048 + f0 + 4 * n); bu[n] = *(const f32x4*)(b1 + (size_t)u.e * 2048 + 1024 + f0 + 4 * n); }
#pragma unroll
        for (int ai = 0; ai < 2; ++ai)
#pragma unroll
            for (int m = 0; m < 4; ++m) {
                const int r = rowb + ai * 128 + m * 16;
                f32x4 o[2];
#pragma unroll
                for (int n = 0; n < 2; ++n) {
                    const f32x4 gt = acc[ai][0][m][n] * (1.f / W8_SCALE) + bg[n], up = acc[ai][1][m][n] * (1.f / W8_SCALE) + bu[n];
#pragma unroll
                    for (int hh = 0; hh < 2; ++hh) {
                        const f32x2 g = __builtin_elementwise_min((f32x2){gt[2 * hh], gt[2 * hh + 1]}, (f32x2){7.f, 7.f});
                        const f32x2 uu = __builtin_elementwise_min(__builtin_elementwise_max((f32x2){up[2 * hh], up[2 * hh + 1]}, (f32x2){-7.f, -7.f}), (f32x2){7.f, 7.f});
                        const f32x2 r = (g * sig2(g * 1.702f)) * (uu * ACT8_SCALE + ACT8_SCALE);
                        o[n][2 * hh] = r.x; o[n][2 * hh + 1] = r.y;
                    }
                }
                u32x2 w;
                { int w0 = 0, w1 = 0; w0 = __builtin_amdgcn_cvt_pk_fp8_f32(o[0].x, o[0].y, w0, false); w0 = __builtin_amdgcn_cvt_pk_fp8_f32(o[0].z, o[0].w, w0, true);
                  w1 = __builtin_amdgcn_cvt_pk_fp8_f32(o[1].x, o[1].y, w1, false); w1 = __builtin_amdgcn_cvt_pk_fp8_f32(o[1].z, o[1].w, w1, true); w.x = (unsigned)w0; w.y = (unsigned)w1; }
                *(u32x2*)(ACT + (size_t)r * 1024 + f0) = w;
            }
    }
};

struct EpiMoe2 {
    static constexpr int MIDK = 0, RELAX = 0;
    const float* b2; const int* LIST; const float* WL; unsigned char* YS;
    DI void operator()(AccRef acc, const Unit& u, int wr, int wc, int fr, int fq) const {
        const int colb = u.pn * 256 + 64 * wc + 16 * fq;
        f32x4 bv[2][2];
#pragma unroll
        for (int bj = 0; bj < 2; ++bj)
#pragma unroll
            for (int n = 0; n < 2; ++n) bv[bj][n] = *(const f32x4*)(b2 + (size_t)u.e * 1024 + colb + 8 * bj + 4 * n);
        constexpr float SC = 1.f / (W8_SCALE * ACT8_SCALE);
#pragma unroll
        for (int ai = 0; ai < 2; ++ai) {
            int slot[4]; float wgt[4];
#pragma unroll
            for (int m = 0; m < 4; ++m) { const int p = 256 * u.tl + ai * 128 + wr * 64 + m * 16 + fr; const bool ok = p < u.cnt;
                slot[m] = ok ? LIST[u.e * LISTCAP + p] : -1; wgt[m] = ok ? WL[u.e * LISTCAP + p] * YS8_SCALE : 0.f; }
#pragma unroll
            for (int m = 0; m < 4; ++m) {
                if (slot[m] >= 0) {
                    const float w = wgt[m];
                    u32x4 o;
                    { const f32x4 a = (acc[ai][0][m][0] * SC + bv[0][0]) * w, b = (acc[ai][0][m][1] * SC + bv[0][1]) * w, c = (acc[ai][1][m][0] * SC + bv[1][0]) * w, d = (acc[ai][1][m][1] * SC + bv[1][1]) * w;
                      o.x = pk4_fp8(a.x, a.y, a.z, a.w); o.y = pk4_fp8(b.x, b.y, b.z, b.w); o.z = pk4_fp8(c.x, c.y, c.z, c.w); o.w = pk4_fp8(d.x, d.y, d.z, d.w); }
                    *(u32x4*)(YS + (size_t)slot[m] * 1024 + colb) = o;
                }
            }
        }
    }
};

constexpr int ATT_KS = 72;
constexpr int ATT_BUF = 2 * 64 * ATT_KS * 2;
DI void attn_unit(int b, int kvh, int qb, const bf16_t* Qb, const bf16_t* Kb, const bf16_t* Vb, bf16_t* AO, const float* attn_sink, LAS unsigned char* lds, int tid, int lane, int wave) {
    const int g = lane >> 4, l15 = lane & 15, hq = wave >> 1, xh = wave & 1, h = kvh * 4 + hq;
    const int q0 = qb * 128, qw0 = q0 + xh * 64;
    bf16x8 qf[4][2];
#pragma unroll
    for (int qg = 0; qg < 4; ++qg)
#pragma unroll
        for (int ks = 0; ks < 2; ++ks) qf[qg][ks] = *(const bf16x8*)(Qb + (size_t)(b * T + qw0 + 16 * qg + l15) * 512 + h * 64 + 32 * ks + 8 * g);
    const float sink2 = attn_sink[h] * LOG2E;
    float mrow[4], lrow[4]; f32x4 o[4][4];
#pragma unroll
    for (int qg = 0; qg < 4; ++qg) { mrow[qg] = sink2; lrow[qg] = (g == 0) ? 1.f : 0.f;
#pragma unroll
        for (int dt = 0; dt < 4; ++dt) o[dt][qg] = (f32x4){0.f, 0.f, 0.f, 0.f}; }
    const int jlo = (qb == 0) ? 2 : 0, jhi = (qb == 15) ? 3 : 5, nloc = jhi - jlo + 1, ntile = nloc + 4;
    const int srow = tid & 63, sch = tid >> 6;
    u32x4 kreg, vreg;
#define ATT_ROW0(s) (((s) < nloc) ? (b * T + q0 - 128 + 64 * (jlo + (s))) : (M + b * LC + 64 * ((s) - nloc)))
#define ATT_LOAD(s) do { const size_t _o = (size_t)(ATT_ROW0(s) + srow) * 128 + kvh * 64 + 8 * sch; kreg = *(const u32x4*)(Kb + _o); vreg = *(const u32x4*)(Vb + _o); } while (0)
#define ATT_WRITE(buf) do { LAS bf16_t* _k = (LAS bf16_t*)(lds + (buf) * ATT_BUF); LAS bf16_t* _v = _k + 64 * ATT_KS; \
        *(LAS u32x4*)(_k + srow * ATT_KS + 8 * sch) = kreg; \
        _v[(8 * sch + 0) * ATT_KS + srow] = (bf16_t)(vreg.x & 0xffffu); _v[(8 * sch + 1) * ATT_KS + srow] = (bf16_t)(vreg.x >> 16); \
        _v[(8 * sch + 2) * ATT_KS + srow] = (bf16_t)(vreg.y & 0xffffu); _v[(8 * sch + 3) * ATT_KS + srow] = (bf16_t)(vreg.y >> 16); \
        _v[(8 * sch + 4) * ATT_KS + srow] = (bf16_t)(vreg.z & 0xffffu); _v[(8 * sch + 5) * ATT_KS + srow] = (bf16_t)(vreg.z >> 16); \
        _v[(8 * sch + 6) * ATT_KS + srow] = (bf16_t)(vreg.w & 0xffffu); _v[(8 * sch + 7) * ATT_KS + srow] = (bf16_t)(vreg.w >> 16); } while (0)
    ATT_LOAD(0); ATT_WRITE(0);
    LDS_BAR();
    for (int s = 0; s < ntile; ++s) {
        if (s + 1 < ntile) ATT_LOAD(s + 1);
        const bool isloc = s < nloc; const int j = jlo + s;
        const bool need = !isloc || (xh == 0 ? (j <= 4) : (j >= 1));
        if (need) {
            const bool partial = isloc && (xh == 0 ? (j == 0 || j == 4) : (j == 1 || j == 5));
            const LAS bf16_t* Kt = (const LAS bf16_t*)(lds + (s & 1) * ATT_BUF); const LAS bf16_t* Vt = Kt + 64 * ATT_KS;
            f32x4 sc[4][4];
#pragma unroll
            for (int kt = 0; kt < 4; ++kt) {
                const bf16x8 k0 = *(const LAS bf16x8*)(Kt + (16 * kt + l15) * ATT_KS + 8 * g), k1 = *(const LAS bf16x8*)(Kt + (16 * kt + l15) * ATT_KS + 32 + 8 * g);
#pragma unroll
                for (int qg = 0; qg < 4; ++qg) {
                    f32x4 a = __builtin_amdgcn_mfma_f32_16x16x32_bf16(k0, qf[qg][0], (f32x4){0.f, 0.f, 0.f, 0.f}, 0, 0, 0);
                    sc[kt][qg] = __builtin_amdgcn_mfma_f32_16x16x32_bf16(k1, qf[qg][1], a, 0, 0, 0);
                }
            }
            asm volatile("s_nop 15" : "+v"(sc[3][0]), "+v"(sc[3][1]), "+v"(sc[3][2]), "+v"(sc[3][3]));
            if (partial) {
                const int kb = q0 - 128 + 64 * j;
#pragma unroll
                for (int kt = 0; kt < 4; ++kt)
#pragma unroll
                    for (int qg = 0; qg < 4; ++qg)
#pragma unroll
                        for (int r = 0; r < 4; ++r) { const int dk = (kb + 16 * kt + 4 * g + r) - (qw0 + 16 * qg + l15); if (dk > 128 || dk < -128) sc[kt][qg][r] = -INFINITY; }
            }
            bf16x8 pf[4][2];
#pragma unroll
            for (int qg = 0; qg < 4; ++qg) {
                float mx = max3_nc(sc[0][qg][0], sc[0][qg][1], sc[0][qg][2]);
                mx = max3_nc(mx, sc[0][qg][3], sc[1][qg][0]); mx = max3_nc(mx, sc[1][qg][1], sc[1][qg][2]); mx = max3_nc(mx, sc[1][qg][3], sc[2][qg][0]); mx = max3_nc(mx, sc[2][qg][1], sc[2][qg][2]);
                mx = max3_nc(mx, sc[2][qg][3], sc[3][qg][0]); mx = max3_nc(mx, sc[3][qg][1], sc[3][qg][2]); mx = max_nc(mx, sc[3][qg][3]);
                mx = xmax32(xmax16(mx));
                const float mold = mrow[qg], mnew = max_nc(mold, mx);
                mrow[qg] = mnew;
                const bool grew = __any(mnew > mold);
                const float scl = grew ? __builtin_amdgcn_exp2f(mold - mnew) : 1.f;
                float ls = 0.f;
#pragma unroll
                for (int kt = 0; kt < 4; ++kt)
#pragma unroll
                    for (int r = 0; r < 4; ++r) { const float p = __builtin_amdgcn_exp2f(sc[kt][qg][r] - mnew); sc[kt][qg][r] = p; ls += p; }
                lrow[qg] = lrow[qg] * scl + ls;
                if (grew) {
#pragma unroll
                    for (int dt = 0; dt < 4; ++dt) o[dt][qg] = o[dt][qg] * scl;
                }
#pragma unroll
                for (int s2 = 0; s2 < 2; ++s2) { u32x4 w; w.x = pk2(sc[2 * s2][qg][0], sc[2 * s2][qg][1]); w.y = pk2(sc[2 * s2][qg][2], sc[2 * s2][qg][3]);
                    w.z = pk2(sc[2 * s2 + 1][qg][0], sc[2 * s2 + 1][qg][1]); w.w = pk2(sc[2 * s2 + 1][qg][2], sc[2 * s2 + 1][qg][3]); pf[qg][s2] = __builtin_bit_cast(bf16x8, w); }
            }
#pragma unroll
            for (int dt = 0; dt < 4; ++dt)
#pragma unroll
                for (int s2 = 0; s2 < 2; ++s2) {
                    const LAS bf16_t* vp = Vt + (16 * dt + l15) * ATT_KS + 32 * s2 + 4 * g;
                    const u32x2 vlo = *(const LAS u32x2*)vp, vhi = *(const LAS u32x2*)(vp + 16);
                    const bf16x8 vf = __builtin_bit_cast(bf16x8, (u32x4){vlo.x, vlo.y, vhi.x, vhi.y});
#pragma unroll
                    for (int qg = 0; qg < 4; ++qg) o[dt][qg] = __builtin_amdgcn_mfma_f32_16x16x32_bf16(vf, pf[qg][s2], o[dt][qg], 0, 0, 0);
                }
        }
        if (s + 1 < ntile) ATT_WRITE((s + 1) & 1);
        LDS_BAR();
    }
#undef ATT_ROW0
#undef ATT_LOAD
#undef ATT_WRITE
#pragma unroll
    for (int qg = 0; qg < 4; ++qg) {
        const float l = xadd32(xadd16(lrow[qg]));
        const float inv = __builtin_amdgcn_rcpf(l);
        unsigned char* op = (unsigned char*)AO + (size_t)(b * T + qw0 + 16 * qg + l15) * 1024 + h * 64 + 4 * g;
#pragma unroll
        for (int dt = 0; dt < 4; ++dt) { const f32x4 v = o[dt][qg] * (inv * MIX8_SCALE); *(unsigned*)(op + 16 * dt) = pk4_fp8(v.x, v.y, v.z, v.w); }
    }
}


constexpr int GL_KS = 72;
constexpr int GL_VP = 144;
typedef short v4i16_t __attribute__((ext_vector_type(4)));
DI u32x2 lds_tr4(const LAS bf16_t* blk, int pitch, int l15) { return __builtin_bit_cast(u32x2, __builtin_amdgcn_ds_read_tr16_b64_v4i16((LAS v4i16_t*)(blk + (l15 >> 2) * pitch + 4 * (l15 & 3)))); }
struct CvtRegs { f32x4 v[16]; };
struct GlaRegs { u32x4 k, q; u32x4 laf, lab; u32x4 v[2]; u32x4 st[2][2]; };
template <bool G3>
DI void gla_issue(GlaRegs& R, int row0, int h, int seq0, int c, const bf16_t* GQ, const bf16_t* GK, const bf16_t* GV, const bf16_t* LAF, const bf16_t* LAB, const bf16_t* ST, int tid) {
    const int j = tid >> 3, dch = tid & 7;
    R.k = *(const u32x4*)(GK + (size_t)(row0 + j) * 256 + h * 64 + 8 * dch);
    R.laf = *(const u32x4*)(LAF + (size_t)(row0 + j) * 256 + h * 64 + 8 * dch); R.lab = *(const u32x4*)(LAB + (size_t)(row0 + j) * 256 + h * 64 + 8 * dch);
    if constexpr (G3) R.q = *(const u32x4*)(GQ + (size_t)(row0 + j) * 256 + h * 64 + 8 * dch);
#pragma unroll
    for (int i = 0; i < 2; ++i) { const int idx = tid + 512 * i, jj = idx >> 4, c4 = idx & 15;
        R.v[i] = *(const u32x4*)(GV + (size_t)(row0 + jj) * 512 + h * 128 + 8 * c4); }
    if constexpr (G3) {
#pragma unroll
        for (int dir = 0; dir < 2; ++dir)
#pragma unroll
            for (int i = 0; i < 2; ++i) { const int idx = tid + 512 * i, e = idx >> 3, ch = idx & 7; R.st[dir][i] = *(const u32x4*)(ST + ((size_t)((seq0 + dir) * 32 + c) * 128 + e) * 64 + 8 * ch); }
    }
}
DI void gla_commit(const GlaRegs& R, LAS float* Lf, LAS float* Lb, LAS bf16_t* Vt, int tid) {
    { const int j = tid >> 3, dch = tid & 7; LAS float* pf = Lf + j * 64 + 8 * dch; LAS float* pb = Lb + j * 64 + 8 * dch;
      *(LAS f32x4*)pf = (f32x4){bflo(R.laf.x), bfhi(R.laf.x), bflo(R.laf.y), bfhi(R.laf.y)}; *(LAS f32x4*)(pf + 4) = (f32x4){bflo(R.laf.z), bfhi(R.laf.z), bflo(R.laf.w), bfhi(R.laf.w)};
      *(LAS f32x4*)pb = (f32x4){bflo(R.lab.x), bfhi(R.lab.x), bflo(R.lab.y), bfhi(R.lab.y)}; *(LAS f32x4*)(pb + 4) = (f32x4){bflo(R.lab.z), bfhi(R.lab.z), bflo(R.lab.w), bfhi(R.lab.w)}; }
#pragma unroll
    for (int i = 0; i < 2; ++i) { const int idx = tid + 512 * i, jj = idx >> 4, c4 = idx & 15; *(LAS u32x4*)(Vt + jj * GL_VP + 8 * c4) = R.v[i]; }
}
DI float gla_cumsum2(LAS float* Lf, LAS float* Lb, LAS float* segtot, int tid) {
    const int dir = tid >> 8, d = tid & 63, seg = (tid >> 6) & 3; LAS float* L = (dir ? Lb : Lf) + (16 * seg) * 64 + d;
    float x[16];
#pragma unroll
    for (int i = 0; i < 16; ++i) x[i] = L[i * 64];
    if (!dir) {
#pragma unroll
        for (int i = 1; i < 16; ++i) x[i] += x[i - 1];
    } else {
#pragma unroll
        for (int i = 14; i >= 0; --i) x[i] += x[i + 1];
    }
    segtot[(dir * 4 + seg) * 64 + d] = dir ? x[0] : x[15];
    LDS_BAR();
    const float s0 = segtot[(dir * 4 + 0) * 64 + d], s1 = segtot[(dir * 4 + 1) * 64 + d], s2 = segtot[(dir * 4 + 2) * 64 + d], s3 = segtot[(dir * 4 + 3) * 64 + d];
    const float off = dir ? ((seg < 1 ? s1 : 0.f) + (seg < 2 ? s2 : 0.f) + (seg < 3 ? s3 : 0.f)) : ((seg > 0 ? s0 : 0.f) + (seg > 1 ? s1 : 0.f) + (seg > 2 ? s2 : 0.f));
#pragma unroll
    for (int i = 0; i < 16; ++i) L[i * 64] = x[i] + off;
    return (s0 + s1) + (s2 + s3);
}
#define G1_DECODE(u, b_, h_, c_, r_) const int b_ = (u) / 144, h_ = ((u) / 36) & 3, c_ = (u) % 36, r_ = (c_ < 4) ? M + b_ * LC + 64 * c_ : b_ * T + 64 * (c_ - 4)
template <class CS> DI void gla_g1_unit2(CS& cs, GlaRegs& RC, int uidx, int G, const bf16_t* GK, const bf16_t* GV, const bf16_t* LAF, const bf16_t* LAB, bf16_t* UB, float* DV, LAS unsigned char* lds, int tid, int lane, int wave) {
    LAS float* Lf = (LAS float*)lds; LAS float* Lb = Lf + 4096; LAS float* tot = Lb + 4096; LAS float* segtot = tot + 128;
    LAS bf16_t* Vt = (LAS bf16_t*)(segtot + 512); LAS bf16_t* Kh = Vt + 64 * GL_VP;
    const int j = tid >> 3, dch = tid & 7, g = lane >> 4, l15 = lane & 15;
    G1_DECODE(uidx, b, h, c36, row0); (void)row0;
    const int seq0 = (b * 4 + h) * 2;
    const u32x4 kreg = RC.k;
    gla_commit(RC, Lf, Lb, Vt, tid);
    const int nidx = uidx + 2 * G;
    if (nidx < NB * 4 * 36) { G1_DECODE(nidx, nb, nh, nc, nr); (void)nb; (void)nc; gla_issue<false>(RC, nr, nh, 0, 0, nullptr, GK, GV, LAF, LAB, nullptr, tid); }
    CvtRegs CR; cs.issue(CR);
    LDS_BAR();
    { const float ctot = gla_cumsum2(Lf, Lb, segtot, tid);
      if (((tid >> 6) & 3) == 0) { const int dir = tid >> 8, d = tid & 63; tot[dir * 64 + d] = ctot; DV[(size_t)((seq0 + dir) * 36 + c36) * 64 + d] = __expf(ctot); } }
    LDS_BAR();
    { const float kv[8] = {bflo(kreg.x), bfhi(kreg.x), bflo(kreg.y), bfhi(kreg.y), bflo(kreg.z), bfhi(kreg.z), bflo(kreg.w), bfhi(kreg.w)};
#pragma unroll
      for (int dir = 0; dir < 2; ++dir) { const LAS float* L = (dir ? Lb : Lf) + j * 64 + 8 * dch; const LAS float* tp = tot + dir * 64 + 8 * dch;
        const f32x4 b0 = *(const LAS f32x4*)L, b1 = *(const LAS f32x4*)(L + 4), t0 = *(const LAS f32x4*)tp, t1 = *(const LAS f32x4*)(tp + 4);
        u32x4 w; w.x = pk2(kv[0] * __expf(t0.x - b0.x), kv[1] * __expf(t0.y - b0.y)); w.y = pk2(kv[2] * __expf(t0.z - b0.z), kv[3] * __expf(t0.w - b0.w));
        w.z = pk2(kv[4] * __expf(t1.x - b1.x), kv[5] * __expf(t1.y - b1.y)); w.w = pk2(kv[6] * __expf(t1.z - b1.z), kv[7] * __expf(t1.w - b1.w));
        *(LAS u32x4*)(Kh + (dir * 64 + j) * GL_KS + 8 * dch) = w; } }
    LDS_BAR();
    asm volatile("" : "+v"(RC.k), "+v"(RC.laf), "+v"(RC.lab), "+v"(RC.v[0]), "+v"(RC.v[1]));
    { const int dt = wave & 3, eh = wave >> 2;
#pragma unroll
      for (int dir = 0; dir < 2; ++dir) {
        bf16x8 af[2];
#pragma unroll
        for (int s2 = 0; s2 < 2; ++s2) { const LAS bf16_t* kb = Kh + (dir * 64 + 32 * s2 + 8 * g) * GL_KS + 16 * dt; const u32x2 lo = lds_tr4(kb, GL_KS, l15), hi = lds_tr4(kb + 4 * GL_KS, GL_KS, l15);
            af[s2] = __builtin_bit_cast(bf16x8, (u32x4){lo.x, lo.y, hi.x, hi.y}); }
        bf16_t* ub = UB + (size_t)((seq0 + dir) * 36 + c36) * (128 * 64);
#pragma unroll
        for (int et = 0; et < 4; ++et) {
            f32x4 acc = {0.f, 0.f, 0.f, 0.f};
#pragma unroll
            for (int s2 = 0; s2 < 2; ++s2) { const LAS bf16_t* vb = Vt + (32 * s2 + 8 * g) * GL_VP + 64 * eh + 16 * et; const u32x2 lo = lds_tr4(vb, GL_VP, l15), hi = lds_tr4(vb + 4 * GL_VP, GL_VP, l15);
                acc = __builtin_amdgcn_mfma_f32_16x16x32_bf16(af[s2], __builtin_bit_cast(bf16x8, (u32x4){lo.x, lo.y, hi.x, hi.y}), acc, 0, 0, 0); }
            st4bf(ub + (size_t)(64 * eh + 16 * et + l15) * 64 + 16 * dt + 4 * g, acc);
        }
      } }
    cs.finish(CR);
    LDS_BAR();
}
template <class CS> DI void gla_g1_phase(CS& cs, int G, int bx, const bf16_t* GK, const bf16_t* GV, const bf16_t* LAF, const bf16_t* LAB, bf16_t* UB, float* DV, LAS unsigned char* lds, int tid, int lane, int wave) {
    constexpr int NU = NB * 4 * 36;
    int uidx = bx; if (uidx >= NU) return;
    GlaRegs Ra, Rb;
    { G1_DECODE(uidx, b0, h0, c0, r0); (void)b0; (void)c0; gla_issue<false>(Ra, r0, h0, 0, 0, nullptr, GK, GV, LAF, LAB, nullptr, tid); }
    if (uidx + G < NU) { G1_DECODE(uidx + G, b1, h1, c1, r1); (void)b1; (void)c1; gla_issue<false>(Rb, r1, h1, 0, 0, nullptr, GK, GV, LAF, LAB, nullptr, tid); }
    for (;;) {
        gla_g1_unit2(cs, Ra, uidx, G, GK, GV, LAF, LAB, UB, DV, lds, tid, lane, wave);
        uidx += G; if (uidx >= NU) break;
        gla_g1_unit2(cs, Rb, uidx, G, GK, GV, LAF, LAB, UB, DV, lds, tid, lane, wave);
        uidx += G; if (uidx >= NU) break;
    }
}
#undef G1_DECODE
template <class CS> DI void gla_g3_phase(CS& cs, int G, int bx, const bf16_t* GQ, const bf16_t* GK, const bf16_t* GV, const bf16_t* LAF, const bf16_t* LAB, const bf16_t* ST, const bf16_t* GR, const float* gla_norm, bf16_t* OG,
                     LAS unsigned char* lds, int tid, int lane, int wave) {
    LAS float* Lf = (LAS float*)lds; LAS float* Lb = Lf + 4096;
    LAS bf16_t* Qt = (LAS bf16_t*)(Lb + 4096);
    LAS bf16_t* Kt = Qt + 2 * 64 * GL_KS;
    LAS bf16_t* Vt = Kt + 2 * 64 * GL_KS;
    LAS bf16_t* St = Vt + 64 * GL_VP;
    LAS float* ssx = (LAS float*)(St + 2 * 128 * GL_KS);
    LAS float* segtot = ssx + 128;
    const int j = tid >> 3, dch = tid & 7, g = lane >> 4, l15 = lane & 15;
    int uidx = bx; if (uidx >= NB * 4 * 32) return;
    f32x4 gnv[4];
#pragma unroll
    for (int et = 0; et < 4; ++et) gnv[et] = *(const f32x4*)(gla_norm + 64 * (wave >> 2) + 16 * et + 4 * g);
    GlaRegs R;
    gla_issue<true>(R, (uidx >> 7) * T + 64 * (uidx & 31), (uidx >> 5) & 3, ((uidx >> 7) * 4 + ((uidx >> 5) & 3)) * 2, uidx & 31, GQ, GK, GV, LAF, LAB, ST, tid);
    for (;;) {
        const int b = uidx >> 7, h = (uidx >> 5) & 3, c = uidx & 31, row0 = b * T + 64 * c;
        const u32x4 qreg = R.q, kreg = R.k;
        gla_commit(R, Lf, Lb, Vt, tid);
#pragma unroll
        for (int dir = 0; dir < 2; ++dir)
#pragma unroll
            for (int i = 0; i < 2; ++i) { const int idx = tid + 512 * i, e = idx >> 3, ch = idx & 7; *(LAS u32x4*)(St + (dir * 128 + e) * GL_KS + 8 * ch) = R.st[dir][i]; }
        const int nidx = uidx + G; const bool has_next = nidx < NB * 4 * 32;
        if (has_next) gla_issue<true>(R, (nidx >> 7) * T + 64 * (nidx & 31), (nidx >> 5) & 3, ((nidx >> 7) * 4 + ((nidx >> 5) & 3)) * 2, nidx & 31, GQ, GK, GV, LAF, LAB, ST, tid);
        LDS_BAR();
        (void)gla_cumsum2(Lf, Lb, segtot, tid);
        LDS_BAR();
        { const float qv[8] = {bflo(qreg.x), bfhi(qreg.x), bflo(qreg.y), bfhi(qreg.y), bflo(qreg.z), bfhi(qreg.z), bflo(qreg.w), bfhi(qreg.w)};
          const float kv[8] = {bflo(kreg.x), bfhi(kreg.x), bflo(kreg.y), bfhi(kreg.y), bflo(kreg.z), bfhi(kreg.z), bflo(kreg.w), bfhi(kreg.w)};
#pragma unroll
          for (int dir = 0; dir < 2; ++dir) { const LAS float* L = (dir ? Lb : Lf) + j * 64 + 8 * dch;
            const f32x4 b0 = *(const LAS f32x4*)L, b1 = *(const LAS f32x4*)(L + 4);
            const float bb[8] = {b0.x, b0.y, b0.z, b0.w, b1.x, b1.y, b1.z, b1.w};
            float qt[8], kt[8];
#pragma unroll
            for (int i = 0; i < 8; ++i) { const float ex = __expf(bb[i]); qt[i] = qv[i] * ex; kt[i] = kv[i] * __builtin_amdgcn_rcpf(ex); }
            u32x4 qw, kw; qw.x = pk2(qt[0], qt[1]); qw.y = pk2(qt[2], qt[3]); qw.z = pk2(qt[4], qt[5]); qw.w = pk2(qt[6], qt[7]);
            kw.x = pk2(kt[0], kt[1]); kw.y = pk2(kt[2], kt[3]); kw.z = pk2(kt[4], kt[5]); kw.w = pk2(kt[6], kt[7]);
            *(LAS u32x4*)(Qt + (dir * 64 + j) * GL_KS + 8 * dch) = qw; *(LAS u32x4*)(Kt + (dir * 64 + j) * GL_KS + 8 * dch) = kw; } }
        LDS_BAR();
        const int it = wave & 3, eh = wave >> 2;
        u32x2 grv[4];
#pragma unroll
        for (int et = 0; et < 4; ++et) grv[et] = *(const u32x2*)(GR + (size_t)(row0 + 16 * it + l15) * 512 + h * 128 + 64 * eh + 16 * et + 4 * g);
        f32x4 o[4];
#pragma unroll
        for (int et = 0; et < 4; ++et) o[et] = (f32x4){0.f, 0.f, 0.f, 0.f};
#pragma unroll
        for (int dir = 0; dir < 2; ++dir) {
            bf16x8 qf[2];
#pragma unroll
            for (int s2 = 0; s2 < 2; ++s2) qf[s2] = *(const LAS bf16x8*)(Qt + (dir * 64 + 16 * it + l15) * GL_KS + 32 * s2 + 8 * g);
#pragma unroll
            for (int et = 0; et < 4; ++et)
#pragma unroll
                for (int s2 = 0; s2 < 2; ++s2) { const bf16x8 a = *(const LAS bf16x8*)(St + (dir * 128 + 64 * eh + 16 * et + l15) * GL_KS + 32 * s2 + 8 * g); o[et] = __builtin_amdgcn_mfma_f32_16x16x32_bf16(a, qf[s2], o[et], 0, 0, 0); }
            f32x4 at[4];
#pragma unroll
            for (int jt = 0; jt < 4; ++jt) { at[jt] = (f32x4){0.f, 0.f, 0.f, 0.f};
#pragma unroll
                for (int s2 = 0; s2 < 2; ++s2) { const bf16x8 kf = *(const LAS bf16x8*)(Kt + (dir * 64 + 16 * jt + l15) * GL_KS + 32 * s2 + 8 * g); at[jt] = __builtin_amdgcn_mfma_f32_16x16x32_bf16(kf, qf[s2], at[jt], 0, 0, 0); }
#pragma unroll
                for (int r = 0; r < 4; ++r) { const int jj = 16 * jt + 4 * g + r, ii = 16 * it + l15; const bool keep = dir ? (jj >= ii) : (jj <= ii); if (!keep) at[jt][r] = 0.f; } }
#pragma unroll
            for (int s2 = 0; s2 < 2; ++s2) {
                u32x4 w; w.x = pk2(at[2 * s2][0], at[2 * s2][1]); w.y = pk2(at[2 * s2][2], at[2 * s2][3]); w.z = pk2(at[2 * s2 + 1][0], at[2 * s2 + 1][1]); w.w = pk2(at[2 * s2 + 1][2], at[2 * s2 + 1][3]);
                const bf16x8 pf = __builtin_bit_cast(bf16x8, w);
#pragma unroll
                for (int et = 0; et < 4; ++et) { const LAS bf16_t* vb = Vt + (32 * s2 + 4 * g) * GL_VP + 64 * eh + 16 * et;
                    const u32x2 vlo = lds_tr4(vb, GL_VP, l15), vhi = lds_tr4(vb + 16 * GL_VP, GL_VP, l15);
                    o[et] = __builtin_amdgcn_mfma_f32_16x16x32_bf16(__builtin_bit_cast(bf16x8, (u32x4){vlo.x, vlo.y, vhi.x, vhi.y}), pf, o[et], 0, 0, 0); }
            }
        }
        float ss = 0.f;
#pragma unroll
        for (int et = 0; et < 4; ++et) ss += (o[et].x * o[et].x + o[et].y * o[et].y) + (o[et].z * o[et].z + o[et].w * o[et].w);
        asm volatile("" : "+v"(R.k), "+v"(R.q), "+v"(R.laf), "+v"(R.lab), "+v"(R.v[0]), "+v"(R.v[1]), "+v"(R.st[0][0]), "+v"(R.st[0][1]), "+v"(R.st[1][0]), "+v"(R.st[1][1]));
        ss = xadd32(xadd16(ss));
        if (g == 0) ssx[eh * 64 + 16 * it + l15] = ss;
        LDS_BAR();
        { const float rstd = rsqrtf((ssx[16 * it + l15] + ssx[64 + 16 * it + l15]) * (1.f / 128.f) + EPS);
          const size_t ro = (size_t)(row0 + 16 * it + l15) * 512 + h * 128, ro2 = (size_t)(row0 + 16 * it + l15) * 1024 + h * 128;
#pragma unroll
          for (int et = 0; et < 4; ++et) { const int e0 = 64 * eh + 16 * et + 4 * g; const f32x4 gn = gnv[et]; const u32x2 gr = grv[et]; (void)ro;
              const f32x4 v = o[et] * (rstd * MIX8_SCALE) * gn * (f32x4){bflo(gr.x), bfhi(gr.x), bflo(gr.y), bfhi(gr.y)}; *(unsigned*)((unsigned char*)OG + ro2 + e0) = pk4_fp8(v.x, v.y, v.z, v.w); } }
        LDS_BAR();
        if (!has_next) break;
        uidx = nidx;
    }
}

struct Args { const float* in[26]; float* out; unsigned char* ws; int ph_lo, ph_hi, li, flags; };
constexpr int NPH = 12;

template <bool FP8, int NB, class Dest>
DI void cvt_item(const float* W, int ldw, int ncols, int k0, int s0, void* WT, int Kd, Dest dest, float scale, int lane) {
    const int g = lane >> 4, c0 = s0 + 4 * (lane & 15);
    if (c0 >= ncols) return;
    const float* src = W + (size_t)(k0 + 16 * g) * ldw + c0;
    int dr[4];
#pragma unroll
    for (int c = 0; c < 4; ++c) dr[c] = dest(c0 + c);
#pragma unroll
    for (int kb = 0; kb < NB * 64; kb += 64) {
        f32x4 v[16];
#pragma unroll
        for (int i = 0; i < 16; ++i) v[i] = *(const f32x4*)(src + (size_t)(kb + i) * ldw);
#pragma unroll
        for (int c = 0; c < 4; ++c) {
            if (dr[c] >= 0) {
            if constexpr (FP8) {
                u32x4 o; o.x = pk4_fp8(v[0][c] * scale, v[1][c] * scale, v[2][c] * scale, v[3][c] * scale); o.y = pk4_fp8(v[4][c] * scale, v[5][c] * scale, v[6][c] * scale, v[7][c] * scale);
                o.z = pk4_fp8(v[8][c] * scale, v[9][c] * scale, v[10][c] * scale, v[11][c] * scale); o.w = pk4_fp8(v[12][c] * scale, v[13][c] * scale, v[14][c] * scale, v[15][c] * scale);
                *(u32x4*)((unsigned char*)WT + (size_t)dr[c] * Kd + k0 + kb + 16 * g) = o;
            } else {
                u32x4 o0, o1; o0.x = pk2(v[0][c], v[1][c]); o0.y = pk2(v[2][c], v[3][c]); o0.z = pk2(v[4][c], v[5][c]); o0.w = pk2(v[6][c], v[7][c]);
                o1.x = pk2(v[8][c], v[9][c]); o1.y = pk2(v[10][c], v[11][c]); o1.z = pk2(v[12][c], v[13][c]); o1.w = pk2(v[14][c], v[15][c]);
                bf16_t* dp = (bf16_t*)WT + (size_t)dr[c] * Kd + k0 + kb + 16 * g; *(u32x4*)dp = o0; *(u32x4*)(dp + 8) = o1;
            }
            }
        }
    }
}
DI void sincos_d(double a, double& s, double& c) {
    const double q = __builtin_rint(a * 0.63661977236758134308), f = a - q * 1.57079632679489661923, f2 = f * f;
    const double sp = f * (1.0 + f2 * (-1.0 / 6 + f2 * (1.0 / 120 + f2 * (-1.0 / 5040 + f2 * (1.0 / 362880 + f2 * (-1.0 / 39916800 + f2 * (1.0 / 6227020800.0)))))));
    const double cp = 1.0 + f2 * (-0.5 + f2 * (1.0 / 24 + f2 * (-1.0 / 720 + f2 * (1.0 / 40320 + f2 * (-1.0 / 3628800 + f2 * (1.0 / 479001600 + f2 * (-1.0 / 87178291200.0)))))));
    const int qi = ((int)q) & 3;
    s = (qi == 0) ? sp : (qi == 1) ? cp : (qi == 2) ? -sp : -cp;
    c = (qi == 0) ? cp : (qi == 1) ? -sp : (qi == 2) ? -cp : sp;
}
DI int dest_win(int s) {
    if (s < 512) { const int head = s >> 6, d = s & 63; return (head >> 2) * 256 + slot_head(head & 3, d); }
    if (s < 640) { const int x = s - 512; return 2 * 256 + slot_head(x >> 6, x & 63); }
    if (s < 768) { const int x = s - 640; return 2 * 256 + slot_head(2 + (x >> 6), x & 63); }
    if (s < 1024) return 8 * 256 + slot_std8(s - 768);
    if (s < 1280) return 3 * 256 + slot_std8(s - 1024);
    if (s < 1792) { const int x = s - 1280; return (4 + (x >> 8)) * 256 + slot_std8(x & 255); }
    if (s < 2304) { const int x = s - 1792; return (9 + (x >> 8)) * 256 + slot_std8(x & 255); }
    if (s < 2336) return -1;
    if (s < 3360) { const int x = s - 2336; return (11 + (x >> 8)) * 256 + slot_std8(x & 255); }
    { const int x = s - 3360; return (15 + (x >> 8)) * 256 + slot_std8(x & 255); }
}
DI int dest_std8(int s) { return (s & ~255) + slot_std8(s & 255); }
DI int dest_win_lo(int s) { return s < 2336 ? dest_win(s) : -1; }
DI int dest_gate(int s) { return s < 2336 ? -1 : dest_std8(s - 2336); }
DI int dest_std16(int s) { const int L = s & 255; return (s & ~255) + 128 * ((L >> 3) & 1) + 32 * (L >> 6) + 16 * ((L >> 2) & 1) + 4 * ((L >> 4) & 3) + (L & 3); }
DI int dest_w1(int s) { const int g = s >> 10, f = s & 1023, t = f >> 7, fl = f & 127; return t * 256 + 128 * g + (fl & 0x60) + (((fl >> 2) & 1) << 4) + (((fl >> 3) & 3) << 2) + (fl & 3); }

constexpr int CVT_I_W1 = 32 * 32 * 8, CVT_I_W2 = 32 * 16 * 8, CVT_NBATCH = 2 * (CVT_I_W1 + CVT_I_W2);
struct CvtStream {
    const float* w_e1; const float* w_e2; unsigned char* W1; unsigned char* W2; int gw, ngw, seq, lane;
    DI bool pending() const { return seq * ngw + gw < CVT_NBATCH; }
    DI void issue(CvtRegs& C) const {
        const int id = seq * ngw + gw; if (id >= CVT_NBATCH) return;
        const int item = id >> 1, half = id & 1, g = lane >> 4;
        const float* src;  int ldw;
        if (item < CVT_I_W1) { const int e = item >> 8, q = item & 255; ldw = 2048; src = w_e1 + (size_t)e * 1024 * 2048 + (size_t)((q >> 5) * 128 + half * 64 + 16 * g) * 2048 + (q & 31) * 64 + 4 * (lane & 15); }
        else { const int it2 = item - CVT_I_W1, e = it2 >> 7, q = it2 & 127; ldw = 1024; src = w_e2 + (size_t)e * 1024 * 1024 + (size_t)((q >> 4) * 128 + half * 64 + 16 * g) * 1024 + (q & 15) * 64 + 4 * (lane & 15); }
#pragma unroll
        for (int i = 0; i < 16; ++i) C.v[i] = __builtin_nontemporal_load((const f32x4*)(src + (size_t)i * ldw));
    }
    DI void finish(const CvtRegs& C) {
        const int id = seq * ngw + gw; if (id >= CVT_NBATCH) return;
        ++seq;
        const int item = id >> 1, half = id & 1, g = lane >> 4;
        unsigned char* dst; int c0; bool isw1 = item < CVT_I_W1;
        if (isw1) { const int e = item >> 8, q = item & 255; dst = W1 + (size_t)e * 2048 * 1024 + (q >> 5) * 128 + half * 64 + 16 * g; c0 = (q & 31) * 64 + 4 * (lane & 15); }
        else { const int it2 = item - CVT_I_W1, e = it2 >> 7, q = it2 & 127; dst = W2 + (size_t)e * 1024 * 1024 + (q >> 4) * 128 + half * 64 + 16 * g; c0 = (q & 15) * 64 + 4 * (lane & 15); }
#pragma unroll
        for (int c = 0; c < 4; ++c) {
            const int dr = isw1 ? dest_w1(c0 + c) : dest_std16(c0 + c);
            u32x4 o; o.x = pk4_fp8(C.v[0][c] * W8_SCALE, C.v[1][c] * W8_SCALE, C.v[2][c] * W8_SCALE, C.v[3][c] * W8_SCALE); o.y = pk4_fp8(C.v[4][c] * W8_SCALE, C.v[5][c] * W8_SCALE, C.v[6][c] * W8_SCALE, C.v[7][c] * W8_SCALE);
            o.z = pk4_fp8(C.v[8][c] * W8_SCALE, C.v[9][c] * W8_SCALE, C.v[10][c] * W8_SCALE, C.v[11][c] * W8_SCALE); o.w = pk4_fp8(C.v[12][c] * W8_SCALE, C.v[13][c] * W8_SCALE, C.v[14][c] * W8_SCALE, C.v[15][c] * W8_SCALE);
            *(u32x4*)(dst + (size_t)dr * 1024) = o;
        }
    }
};

__global__ void __launch_bounds__(512, 2) fwd_kernel(Args args) {
    extern __shared__ __attribute__((aligned(16))) unsigned char lds_raw[];
    LAS unsigned char* lds = (LAS unsigned char*)lds_raw;
    volatile LAS unsigned* MISC = (volatile LAS unsigned*)(lds + MISC_OFF);
    const int tid = threadIdx.x, lane = tid & 63, wave = __builtin_amdgcn_readfirstlane(tid >> 6);
    const int G = gridDim.x, bx = blockIdx.x;
    const int vcu = (G % 8 == 0) ? (bx % 8) * (G / 8) + bx / 8 : bx;
    const int gw = vcu * 8 + wave, NGW = G * 8;
    unsigned char* ws = args.ws;
    unsigned* ctl = (unsigned*)(ws + O_CTL);
    CvtStream cvs; cvs.w_e1 = args.in[22]; cvs.w_e2 = args.in[24]; cvs.W1 = ws + O_W1; cvs.W2 = ws + O_W2; cvs.gw = gw; cvs.ngw = NGW; cvs.lane = lane;
    cvs.seq = (args.ph_lo > 3) ? 1 << 20 : 0;
    const float* x = args.in[0]; const float* cvec = args.in[1]; const float* ctx = args.in[2]; const float* c_ctx = args.in[3];
    const float* w_mod = args.in[4]; const float* b_mod = args.in[5]; const float* norm1 = args.in[6]; const float* norm2 = args.in[7];
    const float* w_in = args.in[8]; const float* q_norm = args.in[9]; const float* k_norm = args.in[10]; const float* attn_sink = args.in[11];
    const float* w_alpha_f = args.in[12]; const float* b_alpha_f = args.in[13]; const float* w_alpha_b = args.in[14]; const float* b_alpha_b = args.in[15];
    const float* gla_norm = args.in[16]; const float* w_battn = args.in[17]; const float* w_bgla = args.in[18]; const float* w_out = args.in[19];
    const float* w_router = args.in[20]; const float* b_router = args.in[21]; const float* w_e1 = args.in[22]; const float* b_e1 = args.in[23];
    const float* w_e2 = args.in[24]; const float* b_e2 = args.in[25];
    float* out = args.out;
    float* MOD = (float*)(ws + O_MOD); float* ROPEC = (float*)(ws + O_ROPE); float* ROPES = ROPEC + 1024;
    float* WTS = (float*)(ws + O_WTS); int* LIST = (int*)(ws + O_LIST); float* WL = (float*)(ws + O_WL);
    bf16_t* WIN = (bf16_t*)(ws + O_WIN); bf16_t* WBA = (bf16_t*)(ws + O_WBA); bf16_t* WBG = (bf16_t*)(ws + O_WBG); bf16_t* WOUT = (bf16_t*)(ws + O_WOUT);
    unsigned char* WIN8 = ws + O_WIN + (size_t)11 * 256 * 1024 * 2; unsigned char* HN8 = ws + O_ACT;
    unsigned char* W1 = ws + O_W1; unsigned char* W2 = ws + O_W2;
    bf16_t* HN = (bf16_t*)(ws + O_HN); bf16_t* Qb = (bf16_t*)(ws + O_Q); bf16_t* Kb = (bf16_t*)(ws + O_K); bf16_t* Vb = (bf16_t*)(ws + O_V);
    bf16_t* GQ = (bf16_t*)(ws + O_GQ); bf16_t* GK = (bf16_t*)(ws + O_GK); bf16_t* GV = (bf16_t*)(ws + O_GV);
    bf16_t* LAF = (bf16_t*)(ws + O_LAF); bf16_t* LAB = (bf16_t*)(ws + O_LAB);
    bf16_t* GR = (bf16_t*)(ws + O_GR); bf16_t* GA = (bf16_t*)(ws + O_GA); bf16_t* GG = (bf16_t*)(ws + O_GG);
    bf16_t* AO = (bf16_t*)(ws + O_AO); bf16_t* UB = (bf16_t*)(ws + O_UB); float* DV = (float*)(ws + O_DV); bf16_t* ST = (bf16_t*)(ws + O_ST); bf16_t* OG = (bf16_t*)((unsigned char*)AO + 512);
    bf16_t* X1b = (bf16_t*)(ws + O_X1); bf16_t* Yb = (bf16_t*)(ws + O_Y); unsigned char* H2 = ws + O_H2;
    unsigned char* ACT = ws + O_ACT; unsigned char* YS = ws + O_YS;

    for (int u = tid; u < 64; u += 512) MISC[u] = 0u;
    __syncthreads();
    XcdBarrier bar; bar.bar = ctl + CW_BAR + args.li * XCD_BAR_WORDS; bar.x = 0; bar.st = nullptr;
    bar = xcd_barrier_post(ctl + CW_BAR + args.li * XCD_BAR_WORDS, MISC + 8);
    const int lo = args.ph_lo, hi = args.ph_hi;
#define IN(k) (lo <= (k) && (k) < hi)
#define SEAM(k) do { if (IN(k) && IN((k) + 1)) xcd_barrier(bar); } while (0)

    if (IN(0)) {
        for (int it = bx; it < MOD_ITEMS; it += G) {
            const int cb = it >> 1, kh = it & 1;
            LAS float* sc = (LAS float*)lds; LAS float* part = sc + 9 * 512;
            for (int idx = tid; idx < 9 * 512; idx += 512) { const int r = idx >> 9, k = kh * 512 + (idx & 511); const float v = (r < 8) ? cvec[r * 1024 + k] : c_ctx[k]; sc[idx] = v * sigmoidf_(v); }
            __syncthreads();
            float ac[9];
#pragma unroll
            for (int r = 0; r < 9; ++r) ac[r] = 0.f;
            const int col = cb * 64 + lane;
#pragma unroll 4
            for (int k4 = 0; k4 < 16; ++k4) {
                float w[4];
#pragma unroll
                for (int q = 0; q < 4; ++q) w[q] = w_mod[(size_t)(kh * 512 + wave * 64 + k4 * 4 + q) * 6144 + col];
#pragma unroll
                for (int r = 0; r < 9; ++r) { const f32x4 s4 = *(const LAS f32x4*)(sc + r * 512 + wave * 64 + k4 * 4); ac[r] += (s4.x * w[0] + s4.y * w[1]) + (s4.z * w[2] + s4.w * w[3]); }
            }
#pragma unroll
            for (int r = 0; r < 9; ++r) part[(wave * 9 + r) * 64 + lane] = ac[r];
            __syncthreads();
            for (int idx = tid; idx < 576; idx += 512) { const int r = idx >> 6, l = idx & 63; float sm = kh ? 0.f : b_mod[cb * 64 + l];
#pragma unroll
                for (int w = 0; w < 8; ++w) sm += part[(w * 9 + r) * 64 + l];
                (void)__hip_atomic_fetch_add(MOD + r * 6144 + cb * 64 + l, sm, __ATOMIC_RELAXED, __HIP_MEMORY_SCOPE_AGENT); }
            asm volatile("s_waitcnt vmcnt(0)" ::: "memory");
            __syncthreads();
            if (tid == 0) (void)__hip_atomic_fetch_add(ctl + CW_MODF, 1u, __ATOMIC_RELAXED, __HIP_MEMORY_SCOPE_AGENT);
        }
        if (bx == G - 1) {
            for (int idx = tid; idx < 1024; idx += 512) { const int pos = idx >> 4, i = idx & 15; double inv = 1.0; for (int j = 0; j < i; ++j) inv *= 0.56234132519034908039;
                double s, c; sincos_d((double)pos * inv, s, c); ROPEC[idx] = (float)c; ROPES[idx] = (float)s; }
        }
        LAS float* scr = (LAS float*)(lds + wave * 16384);
        constexpr int I_EFF = 32, I_WIN = 69 * 16, I_BA = 16 * 8, I_BG = 16 * 8, I_OUT = 16 * 16;
        constexpr int NITEMS = I_EFF + I_WIN + I_BA + I_BG + I_OUT;
        for (int it = gw; it < NITEMS; it += NGW) {
            int r = it;
            if (r < I_EFF) {
                const int dir = r >> 4, kb = r & 15; const float* wa = dir ? w_alpha_b : w_alpha_f;
                { const float* lrp = w_in + (size_t)(kb * 64 + lane) * CIN + 2304 + 16 * dir;
#pragma unroll
                  for (int q4 = 0; q4 < 4; ++q4) *(LAS f32x4*)(scr + lane * 16 + 4 * q4) = *(const f32x4*)(lrp + 4 * q4); }
                LDS_WAIT(); asm volatile("" ::: "memory");
                for (int p = 0; p < 4; ++p) {
                    const int n = p * 64 + lane; float al[16];
#pragma unroll
                    for (int q = 0; q < 16; ++q) al[q] = wa[q * 256 + n];
                    bf16_t* dst = WIN + (size_t)((6 + dir) * 256 + slot_std8(n)) * 1024 + kb * 64;
#pragma unroll 2
                    for (int g8 = 0; g8 < 8; ++g8) {
                        float sv[8];
#pragma unroll
                        for (int j = 0; j < 8; ++j) { const LAS float* lr = scr + (g8 * 8 + j) * 16; float sm = 0.f;
#pragma unroll
                            for (int q4 = 0; q4 < 4; ++q4) { const f32x4 l4 = *(const LAS f32x4*)(lr + 4 * q4); sm += (l4.x * al[4 * q4] + l4.y * al[4 * q4 + 1]) + (l4.z * al[4 * q4 + 2] + l4.w * al[4 * q4 + 3]); }
                            sv[j] = sm; }
                        u32x4 o; o.x = pk2(sv[0], sv[1]); o.y = pk2(sv[2], sv[3]); o.z = pk2(sv[4], sv[5]); o.w = pk2(sv[6], sv[7]);
                        *(u32x4*)(dst + g8 * 8) = o;
                    }
                }
                LDS_WAIT(); asm volatile("" ::: "memory");
                continue; } r -= I_EFF;
            if (r < I_WIN) { const int cb = r % 69, kb = r / 69;
                if (cb <= 36) cvt_item<false, 1>(w_in, CIN, CIN, kb * 64, cb * 64, WIN, 1024, [](int s) { return dest_win_lo(s); }, 1.f, lane);
                if (cb >= 36) cvt_item<true, 1>(w_in, CIN, CIN, kb * 64, cb * 64, WIN8, 1024, [](int s) { return dest_gate(s); }, W8_SCALE, lane);
                continue; } r -= I_WIN;
            if (r < I_BA) { cvt_item<true, 1>(w_battn, 1024, 1024, (r >> 4) * 64, (r & 15) * 64, WBA, 1024, [](int s) { return dest_std8(s); }, W8_SCALE, lane); continue; } r -= I_BA;
            if (r < I_BG) { cvt_item<true, 1>(w_bgla, 1024, 1024, (r >> 4) * 64, (r & 15) * 64, (unsigned char*)WBA + 512, 1024, [](int s) { return dest_std8(s); }, W8_SCALE, lane); continue; } r -= I_BG;
            cvt_item<true, 1>(w_out, 1024, 1024, (r >> 4) * 64, (r & 15) * 64, WOUT, 1024, [](int s) { return dest_std8(s); }, W8_SCALE, lane);
        }
        f32x4 vn[4];
#define P1_LOAD(m_) do { const float* xr_ = ((m_) < M) ? x + (size_t)(m_) * D : ctx + (size_t)((m_) - M) * D; _Pragma("unroll") for (int j = 0; j < 4; ++j) vn[j] = *(const f32x4*)(xr_ + 4 * lane + 256 * j); } while (0)
        if (gw < MT) P1_LOAD(gw);
        { unsigned spins = 0;
          while ((unsigned)__builtin_amdgcn_readfirstlane(__hip_atomic_load(ctl + CW_MODF, __ATOMIC_RELAXED, __HIP_MEMORY_SCOPE_AGENT)) < (unsigned)MOD_ITEMS) {
              __builtin_amdgcn_s_sleep(2); if (++spins > (1u << 22)) { if (lane == 0) __hip_atomic_store(ctl + CW_TMO, 1u, __ATOMIC_RELAXED, __HIP_MEMORY_SCOPE_AGENT); break; } }
          __builtin_amdgcn_fence(__ATOMIC_ACQUIRE, "agent"); asm volatile("s_waitcnt vmcnt(0)" ::: "memory"); }

        for (int m = gw; m < MT; m += NGW) {
            const float* md = MOD + ((m < M) ? (m >> 11) : 8) * 6144;
            f32x4 v[4]; float ss = 0.f;
#pragma unroll
            for (int j = 0; j < 4; ++j) { v[j] = vn[j]; ss += (v[j].x * v[j].x + v[j].y * v[j].y) + (v[j].z * v[j].z + v[j].w * v[j].w); }
            if (m + NGW < MT) P1_LOAD(m + NGW);
            const float rstd = rsqrtf(wave_sum_dpp(ss) * (1.f / D) + EPS);
#pragma unroll
            for (int j = 0; j < 4; ++j) { const int c = 4 * lane + 256 * j;
                const f32x4 g = *(const f32x4*)(norm1 + c), sh = *(const f32x4*)(md + c), sc = *(const f32x4*)(md + 1024 + c);
                const f32x4 h = (v[j] * rstd * g) * (sc + 1.f) + sh;
                st4bf(HN + (size_t)m * D + c, h);
                if (m < M) *(unsigned*)(HN8 + (size_t)m * D + c) = pk4_fp8(h.x, h.y, h.z, h.w); }
        }
#undef P1_LOAD
    }
    SEAM(1);

    if (IN(2)) {
        InProjSched S; S.G = G; S.c = bx; S.A = (const char*)HN; S.Bt = (const char*)WIN;
        EpiInProj E{Qb, Kb, Vb, GQ, GK, GV, GR, GA, GG, LAF, LAB, q_norm, k_norm, b_alpha_f, b_alpha_b, ROPEC, ROPES};
        pg8::gemm_phase<EpiInProj, InProjSched, true>(lds, 1024, S, E);
        PlainSched S2; S2.G = G; S2.c = bx; S2.nM = 64; S2.nN = 8; S2.K = 1024; S2.eb = 1; S2.A = (const char*)HN8; S2.Bt = (const char*)WIN8;
        EpiGates E2{GA, GG};
        pg8::gemm_phase<EpiGates, PlainSched, true, true>(lds, 1024, S2, E2);
    }
    SEAM(2);

    if (IN(3)) {
        for (int uidx = bx; uidx < 256; uidx += G) attn_unit(uidx >> 5, (uidx >> 4) & 1, uidx & 15, Qb, Kb, Vb, AO, attn_sink, lds, tid, lane, wave);
        gla_g1_phase(cvs, G, bx, GK, GV, LAF, LAB, UB, DV, lds, tid, lane, wave);
    }
    SEAM(3);

    if (IN(4)) {
        for (int gid = bx * 512 + tid; gid < 64 * 128 * 16; gid += G * 512) {
            const int seq = gid >> 11, e = (gid >> 4) & 127, dq = gid & 15, dir = seq & 1;
            f32x4 S = {0.f, 0.f, 0.f, 0.f};
            const bf16_t* ub = UB + ((size_t)seq * 36 * 128 + e) * 64 + 4 * dq; const float* dvp = DV + (size_t)seq * 36 * 64 + 4 * dq;
            bf16_t* stp = ST + ((size_t)seq * 32 * 128 + e) * 64 + 4 * dq;
            u32x2 ua[6], ub2[6]; f32x4 da[6], db[6];
#define G2_LOAD(U_, D_, p0_) do { _Pragma("unroll") for (int i = 0; i < 6; ++i) { const int p = (p0_) + i, cc = dir ? (p < 4 ? 3 - p : 39 - p) : p; \
                U_[i] = *(const u32x2*)(ub + cc * (128 * 64)); D_[i] = *(const f32x4*)(dvp + cc * 64); } } while (0)
#define G2_SCAN(U_, D_, p0_) do { _Pragma("unroll") for (int i = 0; i < 6; ++i) { const int p = (p0_) + i, cc = dir ? (p < 4 ? 3 - p : 39 - p) : p; \
                if (cc >= 4) st4bf(stp + (cc - 4) * (128 * 64), S); \
                S = D_[i] * S + (f32x4){bflo(U_[i].x), bfhi(U_[i].x), bflo(U_[i].y), bfhi(U_[i].y)}; } } while (0)
            G2_LOAD(ua, da, 0);
#pragma unroll 1
            for (int p0 = 0; p0 < 36; p0 += 12) {
                G2_LOAD(ub2, db, p0 + 6);
                CvtRegs CR; cvs.issue(CR);
                G2_SCAN(ua, da, p0);
                if (p0 + 12 < 36) G2_LOAD(ua, da, p0 + 12);
                G2_SCAN(ub2, db, p0 + 6);
                cvs.finish(CR);
            }
#undef G2_LOAD
#undef G2_SCAN
        }
    }
    SEAM(4);

    if (IN(5)) {
        gla_g3_phase(cvs, G, bx, GQ, GK, GV, LAF, LAB, ST, GR, gla_norm, OG, lds, tid, lane, wave);
    }
    SEAM(5);

    if (IN(6)) {
        PlainSched S; S.G = G; S.c = bx; S.nM = 64; S.nN = 4; S.K = 1024; S.eb = 1; S.A = (const char*)AO; S.Bt = (const char*)WBA;
        EpiMerge1 E{GA, GG, (unsigned char*)Yb};
        pg8::gemm_phase<EpiMerge1, PlainSched, true, true>(lds, 1024, S, E);
    }
    SEAM(6);

    if (IN(7)) {
        PlainSched S; S.G = G; S.c = bx; S.nM = 64; S.nN = 4; S.K = 1024; S.eb = 1; S.A = (const char*)Yb; S.Bt = (const char*)WOUT;
        EpiMerge2 E{x, MOD, X1b};
        pg8::gemm_phase<EpiMerge2, PlainSched, true, true>(lds, 1024, S, E);
    }
    SEAM(7);

    if (IN(8)) {
        LAS float* wrt = (LAS float*)lds;
        LAS int* lcnt = (LAS int*)(lds + XTRA_OFF);
        LAS int* lbase = lcnt + 32; LAS int* lexp = lcnt + 64; LAS int* lrank = lexp + 256; LAS float* lwt = (LAS float*)(lrank + 256);
        for (int idx = tid; idx < 8192; idx += 512) { const int col = idx & 1023, eg = idx >> 10; const f32x4 w = *(const f32x4*)(w_router + (size_t)col * 32 + eg * 4);
            wrt[(4 * eg + 0) * 1024 + col] = w.x; wrt[(4 * eg + 1) * 1024 + col] = w.y; wrt[(4 * eg + 2) * 1024 + col] = w.z; wrt[(4 * eg + 3) * 1024 + col] = w.w; }
        for (int rb = bx; rb < M / 64; rb += G) {
            if (tid < 32) lcnt[tid] = 0;
            __syncthreads();
            LAS float* lg = (LAS float*)(lds + XTRA_OFF + 4096);
            f32x4 vn[4];
#pragma unroll
            for (int j = 0; j < 4; ++j) { const u32x2 w = *(const u32x2*)(X1b + (size_t)(rb * 64 + wave * 8) * D + 4 * lane + 256 * j); vn[j] = (f32x4){bflo(w.x), bfhi(w.x), bflo(w.y), bfhi(w.y)}; }
            CvtRegs CR;
            for (int i = 0; i < 8; ++i) {
                if ((i & 1) == 0) cvs.issue(CR);
                const int rl = wave * 8 + i, m = rb * 64 + rl; const float* md = MOD + (m >> 11) * 6144;
                f32x4 v[4]; float ss = 0.f;
#pragma unroll
                for (int j = 0; j < 4; ++j) { v[j] = vn[j]; ss += (v[j].x * v[j].x + v[j].y * v[j].y) + (v[j].z * v[j].z + v[j].w * v[j].w); }
                if (i < 7) {
#pragma unroll
                    for (int j = 0; j < 4; ++j) { const u32x2 w = *(const u32x2*)(X1b + (size_t)(m + 1) * D + 4 * lane + 256 * j); vn[j] = (f32x4){bflo(w.x), bfhi(w.x), bflo(w.y), bfhi(w.y)}; }
                }
                const float rstd = rsqrtf(wave_sum_dpp(ss) * (1.f / D) + EPS);
#pragma unroll
                for (int j = 0; j < 4; ++j) { const int c = 4 * lane + 256 * j;
                    const f32x4 g = *(const f32x4*)(norm2 + c), sh = *(const f32x4*)(md + 3 * 1024 + c), sc = *(const f32x4*)(md + 4 * 1024 + c);
                    v[j] = (v[j] * rstd * g) * (sc + 1.f) + sh;
                    *(unsigned*)(H2 + (size_t)m * D + c) = pk4_fp8(v[j].x, v[j].y, v[j].z, v[j].w); }
                float mylogit = 0.f;
#pragma unroll 4
                for (int e = 0; e < 32; ++e) {
                    float p = 0.f;
#pragma unroll
                    for (int j = 0; j < 4; ++j) { const f32x4 w = *(const LAS f32x4*)(wrt + e * 1024 + 4 * lane + 256 * j); p += (v[j].x * w.x + v[j].y * w.y) + (v[j].z * w.z + v[j].w * w.w); }
                    const float tot = wave_sum_dpp(p);
                    if (lane == e) mylogit = tot;
                }
                if (lane < 32) lg[rl * 32 + lane] = mylogit + b_router[lane];
                if (i & 1) cvs.finish(CR);
            }
            LDS_WAIT(); asm volatile("" ::: "memory");
            if (lane < 8) {
                const int rl = wave * 8 + lane, m = rb * 64 + rl;
                float l[32];
#pragma unroll
                for (int q = 0; q < 8; ++q) { const f32x4 t4 = *(const LAS f32x4*)(lg + rl * 32 + 4 * q); l[4 * q] = t4.x; l[4 * q + 1] = t4.y; l[4 * q + 2] = t4.z; l[4 * q + 3] = t4.w; }
                float tv[4]; int ti[4]; unsigned taken = 0u;
#pragma unroll
                for (int k = 0; k < 4; ++k) {
                    float best = -INFINITY; int bi = 0;
#pragma unroll
                    for (int e = 0; e < 32; ++e) { const bool ok = !((taken >> e) & 1u) && (l[e] > best); best = ok ? l[e] : best; bi = ok ? e : bi; }
                    tv[k] = best; ti[k] = bi; taken |= 1u << bi;
                }
                const float e1 = __expf(tv[1] - tv[0]), e2 = __expf(tv[2] - tv[0]), e3 = __expf(tv[3] - tv[0]); const float inv = 1.f / (1.f + e1 + e2 + e3);
                const float wv[4] = {inv, e1 * inv, e2 * inv, e3 * inv};
#pragma unroll
                for (int k = 0; k < 4; ++k) { WTS[m * 4 + k] = wv[k]; lwt[rl * 4 + k] = wv[k]; lexp[rl * 4 + k] = ti[k]; lrank[rl * 4 + k] = atomicAdd((int*)&lcnt[ti[k]], 1); }
            }
            __syncthreads();
            if (tid < 32) lbase[tid] = (int)atomicAdd(ctl + CW_CNT + 64 * tid, (unsigned)lcnt[tid]);
            __syncthreads();
            if (tid < 256) { const int ex = lexp[tid], pos = ex * LISTCAP + lbase[ex] + lrank[tid]; LIST[pos] = (rb * 64) * 4 + tid; WL[pos] = lwt[tid]; }
            __syncthreads();
        }
        while (cvs.pending()) { CvtRegs CR2; cvs.issue(CR2); cvs.finish(CR2); }
    }
    SEAM(8);

    if (IN(9) || IN(10)) {
        LAS int* TT = (LAS int*)(lds + XTRA_OFF);
        __syncthreads();
        if (tid < NE) { const int c = (int)__hip_atomic_load(ctl + CW_CNT + 64 * tid, __ATOMIC_RELAXED, __HIP_MEMORY_SCOPE_AGENT); TT[1 + tid] = c; TT[33 + tid] = (c + 255) >> 8; }
        __syncthreads();
        {
            int pre = 0, myent = -1;
            for (int e = 0; e < NE; ++e) { const int n = TT[33 + e]; if (tid >= pre && tid < pre + n) myent = e | ((tid - pre) << 8); pre += n; }
            __syncthreads();
            if (myent >= 0) TT[64 + tid] = myent;
            if (tid == 0) TT[0] = pre;
        }
        __syncthreads();
        if (IN(9)) {
            MoeSched<true, 3> S; S.G = G; S.cv = vcu; S.TT = TT; S.A = (const char*)H2; S.Bt = (const char*)W1; S.b_estride = (size_t)2048 * 1024; S.LIST = LIST;
            EpiMoe1 E{b_e1, ACT};
            pg8::gemm_phase<EpiMoe1, MoeSched<true, 3>, true, true>(lds, 1024, S, E);
        }
        SEAM(9);
        if (IN(10)) {
            MoeSched<false, 2> S; S.G = G; S.cv = vcu; S.TT = TT; S.A = (const char*)ACT; S.Bt = (const char*)W2; S.b_estride = (size_t)1024 * 1024; S.LIST = LIST;
            EpiMoe2 E{b_e2, LIST, WL, YS};
            pg8::gemm_phase<EpiMoe2, MoeSched<false, 2>, true, true>(lds, 1024, S, E);
        }
    }
    SEAM(10);

    if (IN(11)) {
        f32x4 xn[4]; int yn[4][4];
#define P11_LOAD(m_) do { _Pragma("unroll") for (int j = 0; j < 4; ++j) { const int c_ = 4 * lane + 256 * j; { const u32x2 w_ = *(const u32x2*)(X1b + (size_t)(m_) * D + c_); xn[j] = (f32x4){bflo(w_.x), bfhi(w_.x), bflo(w_.y), bfhi(w_.y)}; } \
            _Pragma("unroll") for (int k = 0; k < 4; ++k) yn[j][k] = *(const int*)(YS + (size_t)((m_) * 4 + k) * D + c_); } } while (0)
        if (gw < M) P11_LOAD(gw);
        for (int m = gw; m < M; m += NGW) {
            const float* md = MOD + (m >> 11) * 6144 + 5 * 1024;
            f32x4 xv[4]; int yv[4][4];
#pragma unroll
            for (int j = 0; j < 4; ++j) { xv[j] = xn[j];
#pragma unroll
                for (int k = 0; k < 4; ++k) yv[j][k] = yn[j][k]; }
            if (m + NGW < M) P11_LOAD(m + NGW);
#pragma unroll
            for (int j = 0; j < 4; ++j) { const int c = 4 * lane + 256 * j;
                f32x4 s = {0.f, 0.f, 0.f, 0.f};
#pragma unroll
                for (int k = 0; k < 4; ++k) { const f32x2 lo = __builtin_amdgcn_cvt_pk_f32_fp8(yv[j][k], false), hi = __builtin_amdgcn_cvt_pk_f32_fp8(yv[j][k], true); s = s + (f32x4){lo.x, lo.y, hi.x, hi.y}; }
                s = s * (1.f / YS8_SCALE);
                const f32x4 g = *(const f32x4*)(md + c);
                *(f32x4*)(out + (size_t)m * D + c) = xv[j] + g * s; }
        }
#undef P11_LOAD
    }
#undef IN
#undef SEAM
}

extern "C" void kernel_launch(void* const* d_in, const int* in_sizes, int n_in, void* d_out, int out_size, void* d_ws, size_t ws_size, hipStream_t stream) {
    static int grid = 0;
    if (grid == 0) {
        if (n_in != 26 || out_size != M * D || ws_size < WS_END) { fprintf(stderr, "kernel_launch: unexpected shapes (n_in %d, out %d, ws %zu < %zu)\n", n_in, out_size, ws_size, (size_t)WS_END); grid = -1; return; }
        int dev = 0, cus = 0, per_cu = 0;
        if (hipGetDevice(&dev) != hipSuccess || hipDeviceGetAttribute(&cus, hipDeviceAttributeMultiprocessorCount, dev) != hipSuccess) { grid = -1; return; }
        if (hipFuncSetAttribute((const void*)fwd_kernel, hipFuncAttributeMaxDynamicSharedMemorySize, LDS_BYTES) != hipSuccess) { fprintf(stderr, "kernel_launch: hipFuncSetAttribute failed\n"); grid = -1; return; }
        if (hipOccupancyMaxActiveBlocksPerMultiprocessor(&per_cu, (const void*)fwd_kernel, 512, LDS_BYTES) != hipSuccess || per_cu < 1) fprintf(stderr, "kernel_launch: occupancy query reports %d\n", per_cu);
        (void)hipGetLastError();
        grid = cus;
    }
    if (grid < 0) return;
    (void)hipMemsetAsync((char*)d_ws + O_CTL, 0, CTL_ZERO_BYTES, stream);
    Args a{};
    for (int i = 0; i < 26; ++i) a.in[i] = (const float*)d_in[i];
    a.out = (float*)d_out; a.ws = (unsigned char*)d_ws;
    a.ph_lo = 0; a.ph_hi = NPH; hipLaunchKernelGGL(fwd_kernel, dim3(grid), dim3(512), LDS_BYTES, stream, a);
}
```

```cpp
#include <hip/hip_runtime.h>
#include <cstdio>
#include <cstdint>

#define DI __device__ __forceinline__
#define GAS __attribute__((address_space(1)))
#define LAS __attribute__((address_space(3)))
typedef unsigned short bf16_t;
typedef short bf16x8 __attribute__((ext_vector_type(8)));
typedef float f32x4 __attribute__((ext_vector_type(4)));
typedef float f32x2 __attribute__((ext_vector_type(2)));
typedef unsigned u32x4 __attribute__((ext_vector_type(4)));
typedef unsigned u32x2 __attribute__((ext_vector_type(2)));
typedef __bf16 bf16x2_t __attribute__((ext_vector_type(2)));
typedef int i32x8 __attribute__((ext_vector_type(8)));
typedef int i32x4 __attribute__((ext_vector_type(4)));


constexpr int D = 1024, NB = 8, T = 2048, LC = 256;
constexpr int M = NB * T;
constexpr int MC = NB * LC;
constexpr int MT = M + MC;
constexpr int NIN = 4864;
constexpr int CIN = 4384;
constexpr int NE = 32, TOPK = 4, DFF = 1024;
constexpr float EPS = 1e-6f;
constexpr float LOG2E = 1.4426950408889634f;
constexpr float QSCALE = 0.125f * LOG2E;
constexpr int LISTCAP = 16384;
constexpr int ACT_ROWS = 73728;

constexpr size_t al64k(size_t x) { return (x + 65535) & ~(size_t)65535; }
constexpr size_t O_CTL = 0;
constexpr size_t O_MOD = 1u << 20;
constexpr size_t CTL_ZERO_BYTES = (1u << 20) + 9 * 6144 * 4;
constexpr size_t O_ROPE = O_MOD + al64k(9 * 6144 * 4);
constexpr size_t O_WTS = O_ROPE + al64k(2 * 64 * 16 * 4);
constexpr size_t O_LIST = O_WTS + al64k(65536 * 4);
constexpr size_t O_WL = O_LIST + al64k((size_t)NE * LISTCAP * 4);
constexpr size_t O_WIN = O_WL + al64k((size_t)NE * LISTCAP * 4);
constexpr size_t O_WBA = O_WIN + al64k((size_t)NIN * 1024 * 2);
constexpr size_t O_WBG = O_WBA + al64k(1024 * 1024 * 2);
constexpr size_t O_WOUT = O_WBG + al64k(1024 * 512 * 2);
constexpr size_t O_W1 = O_WOUT + al64k(1024 * 1024 * 2);
constexpr size_t O_W2 = O_W1 + al64k((size_t)NE * 2048 * 1024 * 2);
constexpr size_t O_HN = O_W2 + al64k((size_t)NE * 1024 * 1024 * 2);
constexpr size_t O_Q = O_HN + al64k((size_t)MT * 1024 * 2);
constexpr size_t O_K = O_Q + al64k((size_t)M * 512 * 2);
constexpr size_t O_V = O_K + al64k((size_t)MT * 128 * 2);
constexpr size_t O_GQ = O_V + al64k((size_t)MT * 128 * 2);
constexpr size_t O_GK = O_GQ + al64k((size_t)M * 256 * 2);
constexpr size_t O_GV = O_GK + al64k((size_t)MT * 256 * 2);
constexpr size_t O_LAF = O_GV + al64k((size_t)MT * 512 * 2);
constexpr size_t O_LAB = O_LAF + al64k((size_t)MT * 256 * 4);
constexpr size_t O_GR = O_LAB + al64k((size_t)MT * 256 * 4);
constexpr size_t O_GA = O_GR + al64k((size_t)M * 512 * 2);
constexpr size_t O_GG = O_GA + al64k((size_t)M * 1024 * 2);
constexpr size_t O_AO = O_GG + al64k((size_t)M * 1024 * 2);
constexpr size_t O_UB = O_AO + al64k((size_t)M * 1024 * 2);
constexpr size_t O_DV = O_UB + al64k((size_t)64 * 36 * 128 * 64 * 2);
constexpr size_t O_ST = O_DV + al64k((size_t)64 * 36 * 64 * 4);
constexpr size_t O_OG = O_ST + al64k((size_t)64 * 32 * 128 * 64 * 2);
constexpr size_t O_X1 = O_OG + al64k((size_t)M * 512 * 2);
constexpr size_t O_Y = O_X1 + al64k((size_t)M * 1024 * 4);
constexpr size_t O_H2 = O_Y + al64k((size_t)M * 1024 * 2);
constexpr size_t O_ACT = O_H2 + al64k((size_t)M * 1024 * 2);
constexpr size_t O_YS = O_ACT + al64k((size_t)ACT_ROWS * 1024 * 2);
constexpr size_t WS_END = O_YS + al64k((size_t)65536 * 1024 * 2);
static_assert(WS_END <= (size_t)1 << 30, "workspace map exceeds 1 GiB");
constexpr int CW_TMO = 0;
constexpr int CW_BAR = 4096;
constexpr int CW_CNT = 16384;
constexpr int CW_MODF = 20480;
constexpr int MOD_ITEMS = 192;

constexpr int RING_BYTES = 131072;
constexpr int XTRA_OFF = RING_BYTES, XTRA_BYTES = 16384;
constexpr int MISC_OFF = XTRA_OFF + XTRA_BYTES;
constexpr int LDS_BYTES = MISC_OFF + 256;
static_assert(LDS_BYTES <= 163840, "LDS");

DI float bf2f(bf16_t h) { return __uint_as_float((unsigned)h << 16); }
DI unsigned pk2(float lo, float hi) { f32x2 v = {lo, hi}; bf16x2_t b = __builtin_convertvector(v, bf16x2_t); return __builtin_bit_cast(unsigned, b); }
DI bf16_t f2bf(float f) { return (bf16_t)(pk2(f, 0.f) & 0xffffu); }
DI float bflo(unsigned w) { return __uint_as_float(w << 16); }
DI float bfhi(unsigned w) { return __uint_as_float(w & 0xffff0000u); }
DI float sigmoidf_(float x) { return 1.f / (1.f + __expf(-x)); }
DI float clamp8(float x) { return __builtin_amdgcn_fmed3f(x, -448.f, 448.f); }
DI unsigned pk4_fp8(float a, float b, float c, float d) { int w = 0; w = __builtin_amdgcn_cvt_pk_fp8_f32(clamp8(a), clamp8(b), w, false); w = __builtin_amdgcn_cvt_pk_fp8_f32(clamp8(c), clamp8(d), w, true); return (unsigned)w; }
constexpr float W8_SCALE = 32.f, ACT8_SCALE = 4.f, YS8_SCALE = 16.f, MIX8_SCALE = 4.f;
#define DPP_ADD(v, ctrl, rmask) ((v) + __builtin_bit_cast(float, __builtin_amdgcn_update_dpp(0, __builtin_bit_cast(int, (v)), (ctrl), (rmask), 0xf, true)))
DI float wave_sum_dpp(float v) {
    v = DPP_ADD(v, 0xB1, 0xf); v = DPP_ADD(v, 0x4E, 0xf); v = DPP_ADD(v, 0x141, 0xf); v = DPP_ADD(v, 0x140, 0xf);
    v = DPP_ADD(v, 0x142, 0xa); v = DPP_ADD(v, 0x143, 0xc);
    return __builtin_bit_cast(float, __builtin_amdgcn_readlane(__builtin_bit_cast(int, v), 63));
}
DI float max_nc(float a, float b) { float r; asm("v_max_f32_e32 %0, %1, %2" : "=v"(r) : "v"(a), "v"(b)); return r; }
DI float max3_nc(float a, float b, float c) { float r; asm("v_max3_f32 %0, %1, %2, %3" : "=v"(r) : "v"(a), "v"(b), "v"(c)); return r; }
DI float xmax16(float m) { const auto r = __builtin_amdgcn_permlane16_swap(__float_as_uint(m), __float_as_uint(m), false, false); return max_nc(__uint_as_float(r[0]), __uint_as_float(r[1])); }
DI float xmax32(float m) { const auto r = __builtin_amdgcn_permlane32_swap(__float_as_uint(m), __float_as_uint(m), false, false); return max_nc(__uint_as_float(r[0]), __uint_as_float(r[1])); }
DI float xadd16(float m) { const auto r = __builtin_amdgcn_permlane16_swap(__float_as_uint(m), __float_as_uint(m), false, false); return __uint_as_float(r[0]) + __uint_as_float(r[1]); }
DI float xadd32(float m) { const auto r = __builtin_amdgcn_permlane32_swap(__float_as_uint(m), __float_as_uint(m), false, false); return __uint_as_float(r[0]) + __uint_as_float(r[1]); }
#define LDS_WAIT() asm volatile("s_waitcnt lgkmcnt(0)" ::: "memory")
#define LDS_BAR() asm volatile("s_waitcnt lgkmcnt(0)\n\ts_barrier" ::: "memory")
#define VM_WAIT() asm volatile("s_waitcnt vmcnt(0)" ::: "memory")

#define XB_TMO      128
#define XB_XCNT(j)  (256  + 64 * (j))
#define XB_XSUB(j)  (1280 + 64 * (j))
#define XB_XGEN(j)  (2304 + 64 * (j))
#define XB_TOP      3328
#define XB_TOPGEN   3392
#define XCD_BAR_WORDS 3456
#define XB_SPIN_CAP (1u << 18)
DI unsigned xb_ld(unsigned* p)              { return __hip_atomic_load(p, __ATOMIC_RELAXED, __HIP_MEMORY_SCOPE_AGENT); }
DI unsigned xb_add(unsigned* p, unsigned v) { return __hip_atomic_fetch_add(p, v, __ATOMIC_RELAXED, __HIP_MEMORY_SCOPE_AGENT); }
DI unsigned xb_xcc_id() { return (unsigned)__builtin_amdgcn_s_getreg((3 << 11) | 20) & 0xFu; }
#define XB_SPIN(cond, bar) do { unsigned _sp = 0; while (cond) { __builtin_amdgcn_s_sleep(1); \
    if ((++_sp & 255u) == 0u) { if (xb_ld(&(bar)[XB_TMO])) break; if (_sp > XB_SPIN_CAP) { atomicAdd(&(bar)[XB_TMO], 1u); break; } } } } while (0)
struct XcdBarrier { unsigned* bar; unsigned x; volatile LAS unsigned* st; };
DI XcdBarrier xcd_barrier_post(unsigned* bar, volatile LAS unsigned* st) {
    XcdBarrier b; b.bar = bar; b.x = xb_xcc_id(); b.st = st;
    if (threadIdx.x == 0) (void)xb_add(&bar[XB_XCNT(b.x)], 1u);
    return b;
}
DI void xcd_barrier_complete(unsigned* bar, unsigned x, unsigned& nloc, unsigned& nx) {
    const unsigned G = gridDim.x * gridDim.y * gridDim.z;
    unsigned sum, cnt, mine, sp = 0u;
    for (;;) {
        sum = 0u; cnt = 0u; mine = 0u;
#pragma unroll
        for (unsigned j = 0; j < 16; ++j) { const unsigned c = xb_ld(&bar[XB_XCNT(j)]); sum += c; cnt += (c > 0u) ? 1u : 0u; mine = (j == x) ? c : mine; }
        if (sum == G) break;
        __builtin_amdgcn_s_sleep(1);
        if ((++sp & 255u) == 0u) { if (xb_ld(&bar[XB_TMO])) break; if (sp > XB_SPIN_CAP) { atomicAdd(&bar[XB_TMO], 1u); break; } }
    }
    nloc = mine > 0u ? mine : 1u; nx = cnt > 0u ? cnt : 1u;
}
DI void xcd_barrier(const XcdBarrier& b) {
    asm volatile("s_waitcnt vmcnt(0)" ::: "memory");
    __syncthreads();
    if (threadIdx.x == 0) {
        unsigned* bar = b.bar;
        __builtin_amdgcn_s_waitcnt(0);
        unsigned nloc = b.st[0], nx = b.st[1];
        if (nloc == 0u) { xcd_barrier_complete(bar, b.x, nloc, nx); b.st[0] = nloc; b.st[1] = nx; }
        const unsigned old = xb_add(&bar[XB_XSUB(b.x)], 1u);
        const unsigned gen = old / nloc;
        if (old + 1u == (gen + 1u) * nloc) {
            __builtin_amdgcn_fence(__ATOMIC_RELEASE, "agent");
            asm volatile("s_waitcnt vmcnt(0)" ::: "memory");
            const unsigned og = xb_add(&bar[XB_TOP], 1u);
            const unsigned tg = og / nx;
            if (og + 1u == (tg + 1u) * nx) xb_add(&bar[XB_TOPGEN], 1u);
            else XB_SPIN(xb_ld(&bar[XB_TOPGEN]) == tg, bar);
            __builtin_amdgcn_fence(__ATOMIC_ACQUIRE, "agent");
            xb_add(&bar[XB_XGEN(b.x)], 1u);
            asm volatile("s_waitcnt vmcnt(0)" ::: "memory");
        } else {
            XB_SPIN(xb_ld(&bar[XB_XGEN(b.x)]) == gen, bar);
            __builtin_amdgcn_fence(__ATOMIC_ACQUIRE, "agent");
            asm volatile("s_waitcnt vmcnt(0)" ::: "memory");
        }
    }
    __syncthreads();
}

namespace pg8 {
constexpr int BM = 256, BK = 64, HALF = 128, HTB = HALF * BK * 2, STAGE_BYTES = 8 * HTB, NXCD = 8, WGM = 8;
__host__ __device__ __forceinline__ int lds_byte(int r, int c) { const int st = (r >> 4) * 2 + (c >> 5), rr = r & 15, cc = c & 31, ob = rr * 64 + cc * 2; return st * 1024 + (ob ^ (((ob >> 9) & 1) << 5)); }
__host__ __device__ __forceinline__ void stage_rc(int b, int& R, int& C) { const int st = b / 1024, sb = b % 1024, swz = sb ^ (((sb >> 9) & 1) << 5); R = (st >> 1) * 16 + swz / 64; C = (st & 1) * 32 + (swz % 64) / 2; }
struct Unit { int pm, pn, e, tl, cnt; };
DI void tile_order(int L, int nM, int nN, int& pm, int& pn) {
    const int nwg = nM * nN; int wgid = L;
    { const int q = nwg / NXCD, r = nwg % NXCD, xcd = wgid % NXCD, off = wgid / NXCD; wgid = (xcd < r ? xcd * (q + 1) : r * (q + 1) + (xcd - r) * q) + off; }
    const int nig = WGM * nN, gid = wgid / nig, fm = gid * WGM, gsz = (nM - fm) < WGM ? (nM - fm) : WGM;
    pm = fm + ((wgid % nig) % gsz); pn = (wgid % nig) / gsz;
}
template <class Epi, class Sched, bool ALIGN_EPI, bool FP8 = false>
DI void gemm_phase(LAS unsigned char* lds, const int K, const Sched& S, const Epi& E) {
    const int tid = threadIdx.x, wid = __builtin_amdgcn_readfirstlane(tid >> 6), lane = tid & 63, wr = wid >> 2, wc = wid & 3, fr = lane & 15, fq = lane >> 4;
    const int rowb = FP8 ? K : 2 * K;
    const int nt = rowb / 128;
    int Rr[2], Cc[2]; unsigned voffB[2];
#pragma unroll
    for (int i = 0; i < 2; ++i) { int R, C; stage_rc(tid * 16 + i * 8192, R, C); Rr[i] = R; Cc[i] = C; voffB[i] = (unsigned)(R * rowb + C * 2); }
    const size_t kstep = (size_t)(BK * 2);
    const size_t hstep = (size_t)HALF * rowb;
    const unsigned ldsw = (unsigned)wid * 1024u;
    const int aoff = lds_byte(wr * 64 + fr, fq * 8), boff = lds_byte(wc * 32 + fr, fq * 8);
#define PG8_SA(b, h) (((b) * 2 + (h)) * HTB)
#define PG8_SB(b, h) ((4 + (b) * 2 + (h)) * HTB)
#define PG8_STAGE(bufoff, gbase, voff) do { _Pragma("unroll") for (int _i = 0; _i < 2; ++_i) \
        __builtin_amdgcn_global_load_lds((const unsigned*)((const char*)(gbase) + (voff)[_i]), (LAS unsigned*)(lds + (bufoff) + ldsw + _i * 8192), 16, 0, 0); } while (0)
#define PG8_LD2(base) __builtin_shufflevector(*(const LAS i32x4*)(base), *(const LAS i32x4*)((base) + 1024), 0, 1, 2, 3, 4, 5, 6, 7)
#define PG8_LDA(dst, b, h) do { if constexpr (FP8) { _Pragma("unroll") for (int m = 0; m < 4; ++m) dst##8[m] = PG8_LD2(lds + PG8_SA(b, h) + aoff + m * 2048); } \
        else { _Pragma("unroll") for (int m = 0; m < 4; ++m) _Pragma("unroll") for (int k = 0; k < 2; ++k) dst[m][k] = *(const LAS bf16x8*)(lds + PG8_SA(b, h) + aoff + m * 2048 + k * 1024); } } while (0)
#define PG8_LDB(dst, b, h) do { if constexpr (FP8) { _Pragma("unroll") for (int n = 0; n < 2; ++n) dst##8[n] = PG8_LD2(lds + PG8_SB(b, h) + boff + n * 2048); } \
        else { _Pragma("unroll") for (int n = 0; n < 2; ++n) _Pragma("unroll") for (int k = 0; k < 2; ++k) dst[n][k] = *(const LAS bf16x8*)(lds + PG8_SB(b, h) + boff + n * 2048 + k * 1024); } } while (0)
#define PG8_CAT(x) __builtin_shufflevector(__builtin_bit_cast(i32x4, (x)[0]), __builtin_bit_cast(i32x4, (x)[1]), 0, 1, 2, 3, 4, 5, 6, 7)
#define PG8_MMA(ai, bj, At, Bt) do { __builtin_amdgcn_s_setprio(1); \
        if constexpr (FP8) { _Pragma("unroll") for (int m = 0; m < 4; ++m) _Pragma("unroll") for (int n = 0; n < 2; ++n) \
            asm volatile("v_mfma_scale_f32_16x16x128_f8f6f4 %0, %1, %2, %0, %3, %3 op_sel_hi:[0,0,0]" : "+v"(acc[ai][bj][m][n]) : "v"(Bt##8[n]), "v"(At##8[m]), "v"(sc8)); } \
        else { _Pragma("unroll") for (int m = 0; m < 4; ++m) _Pragma("unroll") for (int n = 0; n < 2; ++n) _Pragma("unroll") for (int k = 0; k < 2; ++k) \
            acc[ai][bj][m][n] = __builtin_amdgcn_mfma_f32_16x16x32_bf16(Bt[n][k], At[m][k], acc[ai][bj][m][n], 0, 0, 0); } \
        __builtin_amdgcn_s_setprio(0); } while (0)
#define PG8_WAIT_V(n) asm volatile("s_waitcnt vmcnt(" #n ")" ::: "memory")
#define PG8_WAIT_L(n) asm volatile("s_waitcnt lgkmcnt(" #n ")" ::: "memory")
#define PG8_WAIT_VX() do { if constexpr (Epi::RELAX == 8) { if (t == 0 && relax) PG8_WAIT_V(16); else PG8_WAIT_V(8); } else PG8_WAIT_V(8); } while (0)
#define PG8_BAR __builtin_amdgcn_s_barrier()
#define PG8_SCHED __builtin_amdgcn_sched_barrier(0)
    Unit cur, nxt; int ui = 0, relax = 0;
    if (!S.next(0, cur)) return;
    f32x4 acc[2][2][4][2];
#pragma unroll
    for (int a = 0; a < 2; ++a)
#pragma unroll
        for (int b = 0; b < 2; ++b)
#pragma unroll
            for (int m = 0; m < 4; ++m)
#pragma unroll
                for (int n = 0; n < 2; ++n) acc[a][b][m][n] = (f32x4){0.f, 0.f, 0.f, 0.f};
    const int sc8 = 0x7f7f7f7f;
    bf16x8 At[4][2], B0[2][2], B1[2][2]; i32x8 At8[4], B08[2], B18[2];
    unsigned oc0[2], oc1[2], on0[2], on1[2];
    S.a_offs(cur, Rr, Cc, rowb, oc0, oc1);
    const char* cA = S.a_base(cur); const char* cB = S.b_base(cur);
    PG8_STAGE(PG8_SB(0, 0), cB, voffB); PG8_STAGE(PG8_SB(0, 1), cB + hstep, voffB); PG8_STAGE(PG8_SA(0, 0), cA, oc0); PG8_STAGE(PG8_SA(0, 1), cA, oc1);
    if (wr == 1) PG8_BAR;
    PG8_WAIT_V(2); PG8_BAR;
    PG8_STAGE(PG8_SB(1, 0), cB + kstep, voffB); PG8_STAGE(PG8_SA(1, 0), cA + kstep, oc0); PG8_STAGE(PG8_SB(1, 1), cB + hstep + kstep, voffB);
    PG8_WAIT_V(6); PG8_BAR;
    for (;;) {
        const bool has_next = S.next(ui + 1, nxt);
        const char* nA = cA; const char* nB = cB;
        on0[0] = oc0[0]; on0[1] = oc0[1]; on1[0] = oc1[0]; on1[1] = oc1[1];
        if (has_next) { nA = S.a_base(nxt); nB = S.b_base(nxt); S.a_offs(nxt, Rr, Cc, rowb, on0, on1); }
        for (int t = 0; t < nt; t += 2) {
            if constexpr (Epi::MIDK != 0) { if (t == Epi::MIDK) E.mid(acc, cur, wr, wc, fr, fq); }
            const bool last = (t == nt - 2);
            const char* a1 = cA + (size_t)(t + 1) * kstep;
            const char* a2 = last ? nA : cA + (size_t)(t + 2) * kstep; const char* b2 = last ? nB : cB + (size_t)(t + 2) * kstep;
            const char* a3 = a2 + kstep; const char* b3 = b2 + kstep;
            PG8_LDB(B0, 0, 0); PG8_LDB(B1, 0, 1); PG8_SCHED; PG8_LDA(At, 0, 0); PG8_STAGE(PG8_SA(1, 1), a1, oc1);
            PG8_WAIT_VX(); PG8_WAIT_L(0); PG8_BAR; PG8_MMA(0, 0, At, B0); PG8_MMA(0, 1, At, B1); PG8_BAR; PG8_SCHED;
            PG8_LDA(At, 0, 1); PG8_STAGE(PG8_SB(0, 0), b2, voffB); PG8_STAGE(PG8_SB(0, 1), b2 + hstep, voffB); if (last) { PG8_STAGE(PG8_SA(0, 0), a2, on0); } else { PG8_STAGE(PG8_SA(0, 0), a2, oc0); }
            PG8_WAIT_VX(); PG8_WAIT_L(0); PG8_BAR; PG8_MMA(1, 0, At, B0); PG8_MMA(1, 1, At, B1); PG8_BAR; PG8_SCHED;
            PG8_LDB(B0, 1, 0); PG8_LDB(B1, 1, 1); PG8_SCHED; PG8_LDA(At, 1, 0); if (last) { PG8_STAGE(PG8_SA(0, 1), a2, on1); } else { PG8_STAGE(PG8_SA(0, 1), a2, oc1); }
            PG8_WAIT_V(8); PG8_WAIT_L(0); PG8_BAR; PG8_MMA(0, 0, At, B0); PG8_MMA(0, 1, At, B1); PG8_BAR; PG8_SCHED;
            PG8_LDA(At, 1, 1); PG8_STAGE(PG8_SB(1, 0), b3, voffB); PG8_STAGE(PG8_SB(1, 1), b3 + hstep, voffB); if (last) { PG8_STAGE(PG8_SA(1, 0), a3, on0); } else { PG8_STAGE(PG8_SA(1, 0), a3, oc0); }
            PG8_WAIT_V(8); PG8_WAIT_L(0); PG8_BAR; PG8_MMA(1, 0, At, B0); PG8_MMA(1, 1, At, B1); PG8_BAR; PG8_SCHED;
        }
        if constexpr (ALIGN_EPI) { if (wr == 0) PG8_BAR; }
        if constexpr (FP8) asm volatile("s_nop 15\n\ts_nop 15" ::: "memory");
        E(acc, cur, wr, wc, fr, fq); relax = 1;
        if (!has_next) break;
#pragma unroll
        for (int a = 0; a < 2; ++a)
#pragma unroll
            for (int b = 0; b < 2; ++b)
#pragma unroll
                for (int m = 0; m < 4; ++m)
#pragma unroll
                    for (int n = 0; n < 2; ++n) acc[a][b][m][n] = (f32x4){0.f, 0.f, 0.f, 0.f};
        cur = nxt; cA = nA; cB = nB; ++ui;
        oc0[0] = on0[0]; oc0[1] = on0[1]; oc1[0] = on1[0]; oc1[1] = on1[1];
        if constexpr (ALIGN_EPI) { if (wr == 1) PG8_BAR; }
    }
    PG8_WAIT_V(0);
    if constexpr (!ALIGN_EPI) { if (wr == 0) PG8_BAR; }
    PG8_BAR;
#undef PG8_SA
#undef PG8_SB
#undef PG8_STAGE
#undef PG8_LDA
#undef PG8_LDB
#undef PG8_MMA
#undef PG8_CAT
#undef PG8_LD2
#undef PG8_WAIT_V
#undef PG8_WAIT_L
#undef PG8_WAIT_VX
#undef PG8_BAR
#undef PG8_SCHED
}
}
using pg8::Unit;

DI int slot_std8(int L) { return (L & 0xE0) | (((L >> 2) & 1) << 4) | (((L >> 3) & 3) << 2) | (L & 3); }
DI int slot_head(int hh, int d) { return 128 * (d >> 5) + 32 * hh + (d & 31); }

struct SchedBase {
    DI void offs_plain(const int (&Rr)[2], const int (&Cc)[2], int rowb, unsigned (&o0)[2], unsigned (&o1)[2]) const {
#pragma unroll
        for (int i = 0; i < 2; ++i) { o0[i] = (unsigned)(Rr[i] * rowb + Cc[i] * 2); o1[i] = (unsigned)((Rr[i] + 128) * rowb + Cc[i] * 2); }
    }
};
struct InProjSched : SchedBase {
    int G, c; const char* A; const char* Bt;
    DI bool next(int i, Unit& u) const {
        const int L = i * G + c; if (L >= 752) return false;
        if (L < 704) pg8::tile_order(L, 64, 11, u.pm, u.pn); else { const int L2 = L - 704; u.pm = 64 + (L2 & 7); u.pn = 2 + (L2 >> 3); }
        u.e = 0; u.tl = 0; u.cnt = 0; return true;
    }
    DI const char* a_base(const Unit& u) const { return A + (size_t)u.pm * (256 * 1024 * 2); }
    DI const char* b_base(const Unit& u) const { return Bt + (size_t)u.pn * (256 * 1024 * 2); }
    DI void a_offs(const Unit&, const int (&Rr)[2], const int (&Cc)[2], int rowb, unsigned (&o0)[2], unsigned (&o1)[2]) const { offs_plain(Rr, Cc, rowb, o0, o1); }
};
struct PlainSched : SchedBase {
    int G, c, nM, nN, K, eb; const char* A; const char* Bt;
    DI bool next(int i, Unit& u) const {
        const int L = i * G + c; if (L >= nM * nN) return false;
        pg8::tile_order(L, nM, nN, u.pm, u.pn); u.e = 0; u.tl = 0; u.cnt = 0; return true;
    }
    DI const char* a_base(const Unit& u) const { return A + (size_t)u.pm * 256 * K * eb; }
    DI const char* b_base(const Unit& u) const { return Bt + (size_t)u.pn * 256 * K * eb; }
    DI void a_offs(const Unit&, const int (&Rr)[2], const int (&Cc)[2], int rowb, unsigned (&o0)[2], unsigned (&o1)[2]) const { offs_plain(Rr, Cc, rowb, o0, o1); }
};
template <bool GATHER, int LOGNPN>
struct MoeSched : SchedBase {
    int G, cv; const LAS int* TT; const char* A; const char* Bt; size_t b_estride; const int* LIST;
    DI bool next(int i, Unit& u) const {
        const int ntl = __builtin_amdgcn_readfirstlane(TT[0]);
        const int per = (G & 7) ? G : (G >> 3), xq = cv / per, rr = cv - xq * per, T8 = (G & 7) ? ntl : ((ntl + 7) >> 3);
        const int ux = i * per + rr, tt = xq * T8 + (ux >> LOGNPN);
        if ((ux >> LOGNPN) >= T8 || tt >= ntl) return false;
        const int ent = __builtin_amdgcn_readfirstlane(TT[64 + tt]);
        u.pm = tt; u.pn = ux & ((1 << LOGNPN) - 1); u.e = ent & 255; u.tl = ent >> 8; u.cnt = __builtin_amdgcn_readfirstlane(TT[1 + u.e]); return true;
    }
    DI const char* a_base(const Unit& u) const { return GATHER ? A : A + (size_t)u.pm * (256 * 1024); }
    DI const char* b_base(const Unit& u) const { return Bt + (size_t)u.e * b_estride + (size_t)u.pn * (256 * 1024); }
    DI void a_offs(const Unit& u, const int (&Rr)[2], const int (&Cc)[2], int rowb, unsigned (&o0)[2], unsigned (&o1)[2]) const {
        if constexpr (!GATHER) { offs_plain(Rr, Cc, rowb, o0, o1); }
        else {
#pragma unroll
            for (int i = 0; i < 2; ++i) {
                const int p0 = 256 * u.tl + Rr[i], p1 = p0 + 128;
                const int s0 = (p0 < u.cnt) ? LIST[u.e * LISTCAP + p0] : 0, s1 = (p1 < u.cnt) ? LIST[u.e * LISTCAP + p1] : 0;
                o0[i] = (unsigned)((s0 >> 2) * rowb + Cc[i] * 2); o1[i] = (unsigned)((s1 >> 2) * rowb + Cc[i] * 2);
            }
        }
    }
};

typedef const f32x4 (&AccRef)[2][2][4][2];
DI void st8bf(bf16_t* p, f32x4 a, f32x4 b) { u32x4 w; w.x = pk2(a.x, a.y); w.y = pk2(a.z, a.w); w.z = pk2(b.x, b.y); w.w = pk2(b.z, b.w); *(u32x4*)p = w; }
DI void st4bf(bf16_t* p, f32x4 a) { u32x2 w; w.x = pk2(a.x, a.y); w.y = pk2(a.z, a.w); *(u32x2*)p = w; }
DI f32x2 sig2(f32x2 x) { const f32x2 t = x * (-LOG2E); f32x2 e; e.x = __builtin_amdgcn_exp2f(t.x); e.y = __builtin_amdgcn_exp2f(t.y); const f32x2 d = e + 1.0f; f32x2 r; r.x = __builtin_amdgcn_rcpf(d.x); r.y = __builtin_amdgcn_rcpf(d.y); return r; }
DI f32x4 sig4p(f32x4 v) { const f32x2 a = sig2((f32x2){v.x, v.y}), b = sig2((f32x2){v.z, v.w}); return (f32x4){a.x, a.y, b.x, b.y}; }
DI f32x4 silu4p(f32x4 v) { return v * sig4p(v); }
DI float logsig16(float z) { return (fminf(z, 0.f) - __logf(1.f + __expf(-fabsf(z)))) * 0.0625f; }

struct EpiInProj {
    static constexpr int MIDK = 0, RELAX = 0;
    bf16_t *Q, *Kb, *Vb, *GQ, *GK, *GV, *GR, *GA, *GG, *LAF, *LAB;
    const float *qn, *kn, *baf, *bab, *ropec, *ropes;
    DI void operator()(AccRef acc, const Unit& u, int wr, int wc, int fr, int fq) const {
        const int pn = u.pn, rowb = u.pm * 256 + wr * 64 + fr;
        if (pn <= 2) {
            const bool isV = (pn == 2 && wc >= 2), isK = (pn == 2 && wc < 2);
            const bool rope = (u.pm < 64) && !isV;
            const float* g = isK ? kn : qn;
            f32x4 gv[2][2];
#pragma unroll
            for (int bj = 0; bj < 2; ++bj)
#pragma unroll
                for (int n = 0; n < 2; ++n) gv[bj][n] = *(const f32x4*)(g + 32 * bj + 16 * n + 4 * fq);
            bf16_t* outp; int ld, colb;
            if (pn < 2) { outp = Q; ld = 512; colb = (4 * pn + wc) * 64; } else if (isK) { outp = Kb; ld = 128; colb = wc * 64; } else { outp = Vb; ld = 128; colb = (wc - 2) * 64; }
            const float osc = (pn < 2) ? QSCALE : 1.f;
#pragma unroll
            for (int ai = 0; ai < 2; ++ai)
#pragma unroll
                for (int m = 0; m < 4; ++m) {
                    const int r = rowb + ai * 128 + m * 16;
                    f32x4 v[2][2];
#pragma unroll
                    for (int bj = 0; bj < 2; ++bj)
#pragma unroll
                        for (int n = 0; n < 2; ++n) v[bj][n] = acc[ai][bj][m][n];
                    if (!isV) {
                        float ss = 0.f;
#pragma unroll
                        for (int bj = 0; bj < 2; ++bj)
#pragma unroll
                            for (int n = 0; n < 2; ++n) ss += (v[bj][n].x * v[bj][n].x + v[bj][n].y * v[bj][n].y) + (v[bj][n].z * v[bj][n].z + v[bj][n].w * v[bj][n].w);
                        ss = xadd32(xadd16(ss));
                        const float rstd = __builtin_amdgcn_rsqf(ss * (1.f / 64.f) + EPS);
#pragma unroll
                        for (int bj = 0; bj < 2; ++bj)
#pragma unroll
                            for (int n = 0; n < 2; ++n) v[bj][n] = v[bj][n] * rstd * gv[bj][n];
                        if (rope) {
                            const int t = r & (T - 1);
#pragma unroll
                            for (int bj = 0; bj < 2; ++bj) {
                                const int pos = bj ? (t & 63) : (t >> 6);
                                const f32x4 cs = *(const f32x4*)(ropec + pos * 16 + 4 * fq), sn = *(const f32x4*)(ropes + pos * 16 + 4 * fq);
                                const f32x4 x1 = v[bj][0], x2 = v[bj][1];
                                v[bj][0] = x1 * cs - x2 * sn; v[bj][1] = x2 * cs + x1 * sn;
                            }
                        }
#pragma unroll
                        for (int bj = 0; bj < 2; ++bj)
#pragma unroll
                            for (int n = 0; n < 2; ++n) v[bj][n] = v[bj][n] * osc;
                    }
                    bf16_t* rp = outp + (size_t)r * ld + colb + 4 * fq;
#pragma unroll
                    for (int bj = 0; bj < 2; ++bj)
#pragma unroll
                        for (int n = 0; n < 2; ++n) st4bf(rp + 32 * bj + 16 * n, v[bj][n]);
                }
            return;
        }
        const int lcol = 32 * wc + 8 * fq;
        if (pn == 6 || pn == 7) {
            bf16_t* outp = (pn == 6) ? LAF : LAB; const float* bb = (pn == 6) ? baf : bab;
            f32x4 bv[2][2];
#pragma unroll
            for (int bj = 0; bj < 2; ++bj)
#pragma unroll
                for (int n = 0; n < 2; ++n) bv[bj][n] = *(const f32x4*)(bb + 128 * bj + lcol + 4 * n);
#pragma unroll
            for (int ai = 0; ai < 2; ++ai)
#pragma unroll
                for (int m = 0; m < 4; ++m) {
                    const int r = rowb + ai * 128 + m * 16;
#pragma unroll
                    for (int bj = 0; bj < 2; ++bj) {
                        const f32x4 z0 = acc[ai][bj][m][0] + bv[bj][0], z1 = acc[ai][bj][m][1] + bv[bj][1];
                        st8bf(outp + (size_t)r * 256 + 128 * bj + lcol, (f32x4){logsig16(z0.x), logsig16(z0.y), logsig16(z0.z), logsig16(z0.w)}, (f32x4){logsig16(z1.x), logsig16(z1.y), logsig16(z1.z), logsig16(z1.w)});
                    }
                }
            return;
        }
        bf16_t* outp; int ld, colb, mode;
        if (pn == 3) { outp = GK; ld = 256; colb = 0; mode = 0; }
        else if (pn <= 5) { outp = GV; ld = 512; colb = 256 * (pn - 4); mode = 0; }
        else if (pn == 8) { outp = GQ; ld = 256; colb = 0; mode = 1; }
        else if (pn <= 10) { outp = GR; ld = 512; colb = 256 * (pn - 9); mode = 2; }
        else if (pn <= 14) { outp = GA; ld = 1024; colb = 256 * (pn - 11); mode = 3; }
        else { outp = GG; ld = 1024; colb = 256 * (pn - 15); mode = 3; }
#pragma unroll
        for (int ai = 0; ai < 2; ++ai)
#pragma unroll
            for (int m = 0; m < 4; ++m) {
                const int r = rowb + ai * 128 + m * 16;
#pragma unroll
                for (int bj = 0; bj < 2; ++bj) {
                    f32x4 a = acc[ai][bj][m][0], b = acc[ai][bj][m][1];
                    if (mode == 1) { a = a * 0.125f; b = b * 0.125f; }
                    else if (mode == 2) { a = silu4p(a); b = silu4p(b); }
                    else if (mode == 3) { a = sig4p(a); b = sig4p(b); }
                    st8bf(outp + (size_t)r * ld + colb + 128 * bj + lcol, a, b);
                }
            }
    }
};

struct EpiGates {
    static constexpr int MIDK = 0, RELAX = 0;
    bf16_t *GA, *GG;
    DI void operator()(AccRef acc, const Unit& u, int wr, int wc, int fr, int fq) const {
        const int rowb = u.pm * 256 + wr * 64 + fr, lcol = 32 * wc + 8 * fq;
        bf16_t* outp = (u.pn < 4 ? GA : GG) + 256 * (u.pn & 3);
#pragma unroll
        for (int ai = 0; ai < 2; ++ai)
#pragma unroll
            for (int m = 0; m < 4; ++m) {
                const int r = rowb + ai * 128 + m * 16;
#pragma unroll
                for (int bj = 0; bj < 2; ++bj)
                    st8bf(outp + (size_t)r * 1024 + 128 * bj + lcol, sig4p(acc[ai][bj][m][0] * (1.f / W8_SCALE)), sig4p(acc[ai][bj][m][1] * (1.f / W8_SCALE)));
            }
    }
};

struct EpiMerge1 {
    static constexpr int MIDK = 4, RELAX = 0;
    const bf16_t *GA, *GG; unsigned char* Y;
    DI void mid(f32x4 (&acc)[2][2][4][2], const Unit& u, int wr, int wc, int fr, int fq) const {
        unsigned z; asm volatile("v_mov_b32 %0, 0" : "=v"(z));
        const unsigned base = (unsigned)((u.pm * 256 + wr * 64 + fr) * 1024 + u.pn * 256 + 32 * wc + 8 * fq) * 2u + z;
#pragma unroll
        for (int ai = 0; ai < 2; ++ai)
#pragma unroll
            for (int m = 0; m < 4; ++m) {
#pragma unroll
                for (int bj = 0; bj < 2; ++bj) {
                    const unsigned off = base + (unsigned)((ai * 128 + m * 16) * 1024 + 128 * bj) * 2u;
                    const u32x4 aw = *(const u32x4*)((const char*)GA + off), gw = *(const u32x4*)((const char*)GG + off);
                    const f32x4 a0 = {bflo(aw.x), bfhi(aw.x), bflo(aw.y), bfhi(aw.y)}, a1 = {bflo(aw.z), bfhi(aw.z), bflo(aw.w), bfhi(aw.w)};
                    const f32x4 g0 = {bflo(gw.x), bfhi(gw.x), bflo(gw.y), bfhi(gw.y)}, g1 = {bflo(gw.z), bfhi(gw.z), bflo(gw.w), bfhi(gw.w)};
#pragma unroll
                    for (int e = 0; e < 4; ++e) { acc[ai][bj][m][0][e] *= a0[e] * __builtin_amdgcn_rcpf(fmaxf(g0[e], 1e-30f)); acc[ai][bj][m][1][e] *= a1[e] * __builtin_amdgcn_rcpf(fmaxf(g1[e], 1e-30f)); }
                }
                asm volatile("" ::: "memory");
            }
    }
    DI void operator()(AccRef acc, const Unit& u, int wr, int wc, int fr, int fq) const {
        const int rowb = u.pm * 256 + wr * 64 + fr, colb = u.pn * 256 + 32 * wc + 8 * fq;
#pragma unroll
        for (int ai = 0; ai < 2; ++ai)
#pragma unroll
            for (int m = 0; m < 4; ++m) {
                const int r = rowb + ai * 128 + m * 16;
#pragma unroll
                for (int bj = 0; bj < 2; ++bj) {
                    const size_t off = (size_t)r * 1024 + colb + 128 * bj;
                    const u32x4 gw = *(const u32x4*)(GG + off);
                    const f32x4 g0 = {bflo(gw.x), bfhi(gw.x), bflo(gw.y), bfhi(gw.y)}, g1 = {bflo(gw.z), bfhi(gw.z), bflo(gw.w), bfhi(gw.w)};
                    { const f32x4 a = acc[ai][bj][m][0] * g0 * (MIX8_SCALE / (W8_SCALE * MIX8_SCALE)), b = acc[ai][bj][m][1] * g1 * (MIX8_SCALE / (W8_SCALE * MIX8_SCALE));
                      u32x2 w; w.x = pk4_fp8(a.x, a.y, a.z, a.w); w.y = pk4_fp8(b.x, b.y, b.z, b.w); *(u32x2*)(Y + off) = w; }
                }
            }
    }
};

struct EpiMerge2 {
    static constexpr int MIDK = 0, RELAX = 0;
    const float* x; const float* MOD; bf16_t* X1;
    DI void operator()(AccRef acc, const Unit& u, int wr, int wc, int fr, int fq) const {
        const int rowb = u.pm * 256 + wr * 64 + fr, colb = u.pn * 256 + 32 * wc + 8 * fq;
        const int b = (u.pm * 256) >> 11;
        f32x4 gt[2][2];
#pragma unroll
        for (int bj = 0; bj < 2; ++bj)
#pragma unroll
            for (int n = 0; n < 2; ++n) gt[bj][n] = *(const f32x4*)(MOD + b * 6144 + 2048 + colb + 128 * bj + 4 * n);
#pragma unroll
        for (int ai = 0; ai < 2; ++ai)
#pragma unroll
            for (int m = 0; m < 4; ++m) {
                const int r = rowb + ai * 128 + m * 16;
#pragma unroll
                for (int bj = 0; bj < 2; ++bj) {
                    const size_t off = (size_t)r * 1024 + colb + 128 * bj;
                    const f32x4 x0 = *(const f32x4*)(x + off), x1 = *(const f32x4*)(x + off + 4);
                    st8bf(X1 + off, x0 + gt[bj][0] * acc[ai][bj][m][0] * (1.f / (W8_SCALE * MIX8_SCALE)), x1 + gt[bj][1] * acc[ai][bj][m][1] * (1.f / (W8_SCALE * MIX8_SCALE)));
                }
            }
    }
};

struct EpiMoe1 {
    static constexpr int MIDK = 0, RELAX = 8;
    const float* b1; unsigned char* ACT;
    DI void operator()(AccRef acc, const Unit& u, int wr, int wc, int fr, int fq) const {
        const int rowb = u.pm * 256 + wr * 64 + fr, f0 = 128 * u.pn + 32 * wc + 8 * fq;
        f32x4 bg[2], bu[2];
#pragma unroll
        for (int n = 0; n < 2; ++n) { bg[n] = *(const f32x4*)(b1 + (size_t)u.e * 2048 + f0 + 4 * n); bu[n] = *(const f32x4*)(b1 + (size_t)u.e * 2048 + 1024 + f0 + 4 * n); }
#pragma unroll
        for (int ai = 0; ai < 2; ++ai)
#pragma unroll
            for (int m = 0; m < 4; ++m) {
                const int r = rowb + ai * 128 + m * 16;
                f32x4 o[2];
#pragma unroll
                for (int n = 0; n < 2; ++n) {
                    const f32x4 gt = acc[ai][0][m][n] * (1.f / W8_SCALE) + bg[n], up = acc[ai][1][m][n] * (1.f / W8_SCALE) + bu[n];
#pragma unroll
                    for (int hh = 0; hh < 2; ++hh) {
                        const f32x2 g = __builtin_elementwise_min((f32x2){gt[2 * hh], gt[2 * hh + 1]}, (f32x2){7.f, 7.f});
                        const f32x2 uu = __builtin_elementwise_min(__builtin_elementwise_max((f32x2){up[2 * hh], up[2 * hh + 1]}, (f32x2){-7.f, -7.f}), (f32x2){7.f, 7.f});
                        const f32x2 r = (g * sig2(g * 1.702f)) * (uu * ACT8_SCALE + ACT8_SCALE);
                        o[n][2 * hh] = r.x; o[n][2 * hh + 1] = r.y;
                    }
                }
                u32x2 w;
                { int w0 = 0, w1 = 0; w0 = __builtin_amdgcn_cvt_pk_fp8_f32(o[0].x, o[0].y, w0, false); w0 = __builtin_amdgcn_cvt_pk_fp8_f32(o[0].z, o[0].w, w0, true);
                  w1 = __builtin_amdgcn_cvt_pk_fp8_f32(o[1].x, o[1].y, w1, false); w1 = __builtin_amdgcn_cvt_pk_fp8_f32(o[1].z, o[1].w, w1, true); w.x = (unsigned)w0; w.y = (unsigned)w1; }
                *(u32x2*)(ACT + (size_t)r * 1024 + f0) = w;
            }
    }
};

struct EpiMoe2 {
    static constexpr int MIDK = 0, RELAX = 0;
    const float* b2; const int* LIST; const float* WL; unsigned char* YS;
    DI void operator()(AccRef acc, const Unit& u, int wr, int wc, int fr, int fq) const {
        const int colb = u.pn * 256 + 64 * wc + 16 * fq;
        f32x4 bv[2][2];
#pragma unroll
        for (int bj = 0; bj < 2; ++bj)
#pragma unroll
            for (int n = 0; n < 2; ++n) bv[bj][n] = *(const f32x4*)(b2 + (size_t)u.e * 1024 + colb + 8 * bj + 4 * n);
        constexpr float SC = 1.f / (W8_SCALE * ACT8_SCALE);
#pragma unroll
        for (int ai = 0; ai < 2; ++ai) {
            int slot[4]; float wgt[4];
#pragma unroll
            for (int m = 0; m < 4; ++m) { const int p = 256 * u.tl + ai * 128 + wr * 64 + m * 16 + fr; const bool ok = p < u.cnt;
                slot[m] = ok ? LIST[u.e * LISTCAP + p] : -1; wgt[m] = ok ? WL[u.e * LISTCAP + p] * YS8_SCALE : 0.f; }
#pragma unroll
            for (int m = 0; m < 4; ++m) {
                if (slot[m] >= 0) {
                    const float w = wgt[m];
                    u32x4 o;
                    { const f32x4 a = (acc[ai][0][m][0] * SC + bv[0][0]) * w, b = (acc[ai][0][m][1] * SC + bv[0][1]) * w, c = (acc[ai][1][m][0] * SC + bv[1][0]) * w, d = (acc[ai][1][m][1] * SC + bv[1][1]) * w;
                      o.x = pk4_fp8(a.x, a.y, a.z, a.w); o.y = pk4_fp8(b.x, b.y, b.z, b.w); o.z = pk4_fp8(c.x, c.y, c.z, c.w); o.w = pk4_fp8(d.x, d.y, d.z, d.w); }
                    *(u32x4*)(YS + (size_t)slot[m] * 1024 + colb) = o;
                }
            }
        }
    }
};

constexpr int ATT_KS = 72;
constexpr int ATT_BUF = 2 * 64 * ATT_KS * 2;
DI void attn_unit(int b, int kvh, int qb, const bf16_t* Qb, const bf16_t* Kb, const bf16_t* Vb, bf16_t* AO, const float* attn_sink, LAS unsigned char* lds, int tid, int lane, int wave) {
    const int g = lane >> 4, l15 = lane & 15, hq = wave >> 1, xh = wave & 1, h = kvh * 4 + hq;
    const int q0 = qb * 128, qw0 = q0 + xh * 64;
    bf16x8 qf[4][2];
#pragma unroll
    for (int qg = 0; qg < 4; ++qg)
#pragma unroll
        for (int ks = 0; ks < 2; ++ks) qf[qg][ks] = *(const bf16x8*)(Qb + (size_t)(b * T + qw0 + 16 * qg + l15) * 512 + h * 64 + 32 * ks + 8 * g);
    const float sink2 = attn_sink[h] * LOG2E;
    float mrow[4], lrow[4]; f32x4 o[4][4];
#pragma unroll
    for (int qg = 0; qg < 4; ++qg) { mrow[qg] = sink2; lrow[qg] = (g == 0) ? 1.f : 0.f;
#pragma unroll
        for (int dt = 0; dt < 4; ++dt) o[dt][qg] = (f32x4){0.f, 0.f, 0.f, 0.f}; }
    const int jlo = (qb == 0) ? 2 : 0, jhi = (qb == 15) ? 3 : 5, nloc = jhi - jlo + 1, ntile = nloc + 4;
    const int srow = tid & 63, sch = tid >> 6;
    u32x4 kreg, vreg;
#define ATT_ROW0(s) (((s) < nloc) ? (b * T + q0 - 128 + 64 * (jlo + (s))) : (M + b * LC + 64 * ((s) - nloc)))
#define ATT_LOAD(s) do { const size_t _o = (size_t)(ATT_ROW0(s) + srow) * 128 + kvh * 64 + 8 * sch; kreg = *(const u32x4*)(Kb + _o); vreg = *(const u32x4*)(Vb + _o); } while (0)
#define ATT_WRITE(buf) do { LAS bf16_t* _k = (LAS bf16_t*)(lds + (buf) * ATT_BUF); LAS bf16_t* _v = _k + 64 * ATT_KS; \
        *(LAS u32x4*)(_k + srow * ATT_KS + 8 * sch) = kreg; \
        _v[(8 * sch + 0) * ATT_KS + srow] = (bf16_t)(vreg.x & 0xffffu); _v[(8 * sch + 1) * ATT_KS + srow] = (bf16_t)(vreg.x >> 16); \
        _v[(8 * sch + 2) * ATT_KS + srow] = (bf16_t)(vreg.y & 0xffffu); _v[(8 * sch + 3) * ATT_KS + srow] = (bf16_t)(vreg.y >> 16); \
        _v[(8 * sch + 4) * ATT_KS + srow] = (bf16_t)(vreg.z & 0xffffu); _v[(8 * sch + 5) * ATT_KS + srow] = (bf16_t)(vreg.z >> 16); \
        _v[(8 * sch + 6) * ATT_KS + srow] = (bf16_t)(vreg.w & 0xffffu); _v[(8 * sch + 7) * ATT_KS + srow] = (bf16_t)(vreg.w >> 16); } while (0)
    ATT_LOAD(0); ATT_WRITE(0);
    LDS_BAR();
    for (int s = 0; s < ntile; ++s) {
        if (s + 1 < ntile) ATT_LOAD(s + 1);
        const bool isloc = s < nloc; const int j = jlo + s;
        const bool need = !isloc || (xh == 0 ? (j <= 4) : (j >= 1));
        if (need) {
            const bool partial = isloc && (xh == 0 ? (j == 0 || j == 4) : (j == 1 || j == 5));
            const LAS bf16_t* Kt = (const LAS bf16_t*)(lds + (s & 1) * ATT_BUF); const LAS bf16_t* Vt = Kt + 64 * ATT_KS;
            f32x4 sc[4][4];
#pragma unroll
            for (int kt = 0; kt < 4; ++kt) {
                const bf16x8 k0 = *(const LAS bf16x8*)(Kt + (16 * kt + l15) * ATT_KS + 8 * g), k1 = *(const LAS bf16x8*)(Kt + (16 * kt + l15) * ATT_KS + 32 + 8 * g);
#pragma unroll
                for (int qg = 0; qg < 4; ++qg) {
                    f32x4 a = __builtin_amdgcn_mfma_f32_16x16x32_bf16(k0, qf[qg][0], (f32x4){0.f, 0.f, 0.f, 0.f}, 0, 0, 0);
                    sc[kt][qg] = __builtin_amdgcn_mfma_f32_16x16x32_bf16(k1, qf[qg][1], a, 0, 0, 0);
                }
            }
            asm volatile("s_nop 15" : "+v"(sc[3][0]), "+v"(sc[3][1]), "+v"(sc[3][2]), "+v"(sc[3][3]));
            if (partial) {
                const int kb = q0 - 128 + 64 * j;
#pragma unroll
                for (int kt = 0; kt < 4; ++kt)
#pragma unroll
                    for (int qg = 0; qg < 4; ++qg)
#pragma unroll
                        for (int r = 0; r < 4; ++r) { const int dk = (kb + 16 * kt + 4 * g + r) - (qw0 + 16 * qg + l15); if (dk > 128 || dk < -128) sc[kt][qg][r] = -INFINITY; }
            }
            bf16x8 pf[4][2];
#pragma unroll
            for (int qg = 0; qg < 4; ++qg) {
                float mx = max3_nc(sc[0][qg][0], sc[0][qg][1], sc[0][qg][2]);
                mx = max3_nc(mx, sc[0][qg][3], sc[1][qg][0]); mx = max3_nc(mx, sc[1][qg][1], sc[1][qg][2]); mx = max3_nc(mx, sc[1][qg][3], sc[2][qg][0]); mx = max3_nc(mx, sc[2][qg][1], sc[2][qg][2]);
                mx = max3_nc(mx, sc[2][qg][3], sc[3][qg][0]); mx = max3_nc(mx, sc[3][qg][1], sc[3][qg][2]); mx = max_nc(mx, sc[3][qg][3]);
                mx = xmax32(xmax16(mx));
                const float mold = mrow[qg], mnew = max_nc(mold, mx);
                mrow[qg] = mnew;
                const bool grew = __any(mnew > mold);
                const float scl = grew ? __builtin_amdgcn_exp2f(mold - mnew) : 1.f;
                float ls = 0.f;
#pragma unroll
                for (int kt = 0; kt < 4; ++kt)
#pragma unroll
                    for (int r = 0; r < 4; ++r) { const float p = __builtin_amdgcn_exp2f(sc[kt][qg][r] - mnew); sc[kt][qg][r] = p; ls += p; }
                lrow[qg] = lrow[qg] * scl + ls;
                if (grew) {
#pragma unroll
                    for (int dt = 0; dt < 4; ++dt) o[dt][qg] = o[dt][qg] * scl;
                }
#pragma unroll
                for (int s2 = 0; s2 < 2; ++s2) { u32x4 w; w.x = pk2(sc[2 * s2][qg][0], sc[2 * s2][qg][1]); w.y = pk2(sc[2 * s2][qg][2], sc[2 * s2][qg][3]);
                    w.z = pk2(sc[2 * s2 + 1][qg][0], sc[2 * s2 + 1][qg][1]); w.w = pk2(sc[2 * s2 + 1][qg][2], sc[2 * s2 + 1][qg][3]); pf[qg][s2] = __builtin_bit_cast(bf16x8, w); }
            }
#pragma unroll
            for (int dt = 0; dt < 4; ++dt)
#pragma unroll
                for (int s2 = 0; s2 < 2; ++s2) {
                    const LAS bf16_t* vp = Vt + (16 * dt + l15) * ATT_KS + 32 * s2 + 4 * g;
                    const u32x2 vlo = *(const LAS u32x2*)vp, vhi = *(const LAS u32x2*)(vp + 16);
                    const bf16x8 vf = __builtin_bit_cast(bf16x8, (u32x4){vlo.x, vlo.y, vhi.x, vhi.y});
#pragma unroll
                    for (int qg = 0; qg < 4; ++qg) o[dt][qg] = __builtin_amdgcn_mfma_f32_16x16x32_bf16(vf, pf[qg][s2], o[dt][qg], 0, 0, 0);
                }
        }
        if (s + 1 < ntile) ATT_WRITE((s + 1) & 1);
        LDS_BAR();
    }
#undef ATT_ROW0
#undef ATT_LOAD
#undef ATT_WRITE
#pragma unroll
    for (int qg = 0; qg < 4; ++qg) {
        const float l = xadd32(xadd16(lrow[qg]));
        const float inv = __builtin_amdgcn_rcpf(l);
        unsigned char* op = (unsigned char*)AO + (size_t)(b * T + qw0 + 16 * qg + l15) * 1024 + h * 64 + 4 * g;
#pragma unroll
        for (int dt = 0; dt < 4; ++dt) { const f32x4 v = o[dt][qg] * (inv * MIX8_SCALE); *(unsigned*)(op + 16 * dt) = pk4_fp8(v.x, v.y, v.z, v.w); }
    }
}


constexpr int GL_KS = 72;
constexpr int GL_VP = 144;
typedef short v4i16_t __attribute__((ext_vector_type(4)));
DI u32x2 lds_tr4(const LAS bf16_t* blk, int pitch, int l15) { return __builtin_bit_cast(u32x2, __builtin_amdgcn_ds_read_tr16_b64_v4i16((LAS v4i16_t*)(blk + (l15 >> 2) * pitch + 4 * (l15 & 3)))); }
struct CvtRegs { f32x4 v[16]; };
struct GlaRegs { u32x4 k, q; u32x4 laf, lab; u32x4 v[2]; u32x4 st[2][2]; };
template <bool G3>
DI void gla_issue(GlaRegs& R, int row0, int h, int seq0, int c, const bf16_t* GQ, const bf16_t* GK, const bf16_t* GV, const bf16_t* LAF, const bf16_t* LAB, const bf16_t* ST, int tid) {
    const int j = tid >> 3, dch = tid & 7;
    R.k = *(const u32x4*)(GK + (size_t)(row0 + j) * 256 + h * 64 + 8 * dch);
    R.laf = *(const u32x4*)(LAF + (size_t)(row0 + j) * 256 + h * 64 + 8 * dch); R.lab = *(const u32x4*)(LAB + (size_t)(row0 + j) * 256 + h * 64 + 8 * dch);
    if constexpr (G3) R.q = *(const u32x4*)(GQ + (size_t)(row0 + j) * 256 + h * 64 + 8 * dch);
#pragma unroll
    for (int i = 0; i < 2; ++i) { const int idx = tid + 512 * i, jj = idx >> 4, c4 = idx & 15;
        R.v[i] = *(const u32x4*)(GV + (size_t)(row0 + jj) * 512 + h * 128 + 8 * c4); }
    if constexpr (G3) {
#pragma unroll
        for (int dir = 0; dir < 2; ++dir)
#pragma unroll
            for (int i = 0; i < 2; ++i) { const int idx = tid + 512 * i, e = idx >> 3, ch = idx & 7; R.st[dir][i] = *(const u32x4*)(ST + ((size_t)((seq0 + dir) * 32 + c) * 128 + e) * 64 + 8 * ch); }
    }
}
DI void gla_commit(const GlaRegs& R, LAS float* Lf, LAS float* Lb, LAS bf16_t* Vt, int tid) {
    { const int j = tid >> 3, dch = tid & 7; LAS float* pf = Lf + j * 64 + 8 * dch; LAS float* pb = Lb + j * 64 + 8 * dch;
      *(LAS f32x4*)pf = (f32x4){bflo(R.laf.x), bfhi(R.laf.x), bflo(R.laf.y), bfhi(R.laf.y)}; *(LAS f32x4*)(pf + 4) = (f32x4){bflo(R.laf.z), bfhi(R.laf.z), bflo(R.laf.w), bfhi(R.laf.w)};
      *(LAS f32x4*)pb = (f32x4){bflo(R.lab.x), bfhi(R.lab.x), bflo(R.lab.y), bfhi(R.lab.y)}; *(LAS f32x4*)(pb + 4) = (f32x4){bflo(R.lab.z), bfhi(R.lab.z), bflo(R.lab.w), bfhi(R.lab.w)}; }
#pragma unroll
    for (int i = 0; i < 2; ++i) { const int idx = tid + 512 * i, jj = idx >> 4, c4 = idx & 15; *(LAS u32x4*)(Vt + jj * GL_VP + 8 * c4) = R.v[i]; }
}
DI float gla_cumsum2(LAS float* Lf, LAS float* Lb, LAS float* segtot, int tid) {
    const int dir = tid >> 8, d = tid & 63, seg = (tid >> 6) & 3; LAS float* L = (dir ? Lb : Lf) + (16 * seg) * 64 + d;
    float x[16];
#pragma unroll
    for (int i = 0; i < 16; ++i) x[i] = L[i * 64];
    if (!dir) {
#pragma unroll
        for (int i = 1; i < 16; ++i) x[i] += x[i - 1];
    } else {
#pragma unroll
        for (int i = 14; i >= 0; --i) x[i] += x[i + 1];
    }
    segtot[(dir * 4 + seg) * 64 + d] = dir ? x[0] : x[15];
    LDS_BAR();
    const float s0 = segtot[(dir * 4 + 0) * 64 + d], s1 = segtot[(dir * 4 + 1) * 64 + d], s2 = segtot[(dir * 4 + 2) * 64 + d], s3 = segtot[(dir * 4 + 3) * 64 + d];
    const float off = dir ? ((seg < 1 ? s1 : 0.f) + (seg < 2 ? s2 : 0.f) + (seg < 3 ? s3 : 0.f)) : ((seg > 0 ? s0 : 0.f) + (seg > 1 ? s1 : 0.f) + (seg > 2 ? s2 : 0.f));
#pragma unroll
    for (int i = 0; i < 16; ++i) L[i * 64] = x[i] + off;
    return (s0 + s1) + (s2 + s3);
}
#define G1_DECODE(u, b_, h_, c_, r_) const int b_ = (u) / 144, h_ = ((u) / 36) & 3, c_ = (u) % 36, r_ = (c_ < 4) ? M + b_ * LC + 64 * c_ : b_ * T + 64 * (c_ - 4)
template <class CS> DI void gla_g1_unit2(CS& cs, GlaRegs& RC, int uidx, int G, const bf16_t* GK, const bf16_t* GV, const bf16_t* LAF, const bf16_t* LAB, bf16_t* UB, float* DV, LAS unsigned char* lds, int tid, int lane, int wave) {
    LAS float* Lf = (LAS float*)lds; LAS float* Lb = Lf + 4096; LAS float* tot = Lb + 4096; LAS float* segtot = tot + 128;
    LAS bf16_t* Vt = (LAS bf16_t*)(segtot + 512); LAS bf16_t* Kh = Vt + 64 * GL_VP;
    const int j = tid >> 3, dch = tid & 7, g = lane >> 4, l15 = lane & 15;
    G1_DECODE(uidx, b, h, c36, row0); (void)row0;
    const int seq0 = (b * 4 + h) * 2;
    const u32x4 kreg = RC.k;
    gla_commit(RC, Lf, Lb, Vt, tid);
    const int nidx = uidx + 2 * G;
    if (nidx < NB * 4 * 36) { G1_DECODE(nidx, nb, nh, nc, nr); (void)nb; (void)nc; gla_issue<false>(RC, nr, nh, 0, 0, nullptr, GK, GV, LAF, LAB, nullptr, tid); }
    CvtRegs CR; cs.issue(CR);
    LDS_BAR();
    { const float ctot = gla_cumsum2(Lf, Lb, segtot, tid);
      if (((tid >> 6) & 3) == 0) { const int dir = tid >> 8, d = tid & 63; tot[dir * 64 + d] = ctot; DV[(size_t)((seq0 + dir) * 36 + c36) * 64 + d] = __expf(ctot); } }
    LDS_BAR();
    { const float kv[8] = {bflo(kreg.x), bfhi(kreg.x), bflo(kreg.y), bfhi(kreg.y), bflo(kreg.z), bfhi(kreg.z), bflo(kreg.w), bfhi(kreg.w)};
#pragma unroll
      for (int dir = 0; dir < 2; ++dir) { const LAS float* L = (dir ? Lb : Lf) + j * 64 + 8 * dch; const LAS float* tp = tot + dir * 64 + 8 * dch;
        const f32x4 b0 = *(const LAS f32x4*)L, b1 = *(const LAS f32x4*)(L + 4), t0 = *(const LAS f32x4*)tp, t1 = *(const LAS f32x4*)(tp + 4);
        u32x4 w; w.x = pk2(kv[0] * __expf(t0.x - b0.x), kv[1] * __expf(t0.y - b0.y)); w.y = pk2(kv[2] * __expf(t0.z - b0.z), kv[3] * __expf(t0.w - b0.w));
        w.z = pk2(kv[4] * __expf(t1.x - b1.x), kv[5] * __expf(t1.y - b1.y)); w.w = pk2(kv[6] * __expf(t1.z - b1.z), kv[7] * __expf(t1.w - b1.w));
        *(LAS u32x4*)(Kh + (dir * 64 + j) * GL_KS + 8 * dch) = w; } }
    LDS_BAR();
    asm volatile("" : "+v"(RC.k), "+v"(RC.laf), "+v"(RC.lab), "+v"(RC.v[0]), "+v"(RC.v[1]));
    { const int dt = wave & 3, eh = wave >> 2;
#pragma unroll
      for (int dir = 0; dir < 2; ++dir) {
        bf16x8 af[2];
#pragma unroll
        for (int s2 = 0; s2 < 2; ++s2) { const LAS bf16_t* kb = Kh + (dir * 64 + 32 * s2 + 8 * g) * GL_KS + 16 * dt; const u32x2 lo = lds_tr4(kb, GL_KS, l15), hi = lds_tr4(kb + 4 * GL_KS, GL_KS, l15);
            af[s2] = __builtin_bit_cast(bf16x8, (u32x4){lo.x, lo.y, hi.x, hi.y}); }
        bf16_t* ub = UB + (size_t)((seq0 + dir) * 36 + c36) * (128 * 64);
#pragma unroll
        for (int et = 0; et < 4; ++et) {
            f32x4 acc = {0.f, 0.f, 0.f, 0.f};
#pragma unroll
            for (int s2 = 0; s2 < 2; ++s2) { const LAS bf16_t* vb = Vt + (32 * s2 + 8 * g) * GL_VP + 64 * eh + 16 * et; const u32x2 lo = lds_tr4(vb, GL_VP, l15), hi = lds_tr4(vb + 4 * GL_VP, GL_VP, l15);
                acc = __builtin_amdgcn_mfma_f32_16x16x32_bf16(af[s2], __builtin_bit_cast(bf16x8, (u32x4){lo.x, lo.y, hi.x, hi.y}), acc, 0, 0, 0); }
            st4bf(ub + (size_t)(64 * eh + 16 * et + l15) * 64 + 16 * dt + 4 * g, acc);
        }
      } }
    cs.finish(CR);
    LDS_BAR();
}
template <class CS> DI void gla_g1_phase(CS& cs, int G, int bx, const bf16_t* GK, const bf16_t* GV, const bf16_t* LAF, const bf16_t* LAB, bf16_t* UB, float* DV, LAS unsigned char* lds, int tid, int lane, int wave) {
    constexpr int NU = NB * 4 * 36;
    int uidx = bx; if (uidx >= NU) return;
    GlaRegs Ra, Rb;
    { G1_DECODE(uidx, b0, h0, c0, r0); (void)b0; (void)c0; gla_issue<false>(Ra, r0, h0, 0, 0, nullptr, GK, GV, LAF, LAB, nullptr, tid); }
    if (uidx + G < NU) { G1_DECODE(uidx + G, b1, h1, c1, r1); (void)b1; (void)c1; gla_issue<false>(Rb, r1, h1, 0, 0, nullptr, GK, GV, LAF, LAB, nullptr, tid); }
    for (;;) {
        gla_g1_unit2(cs, Ra, uidx, G, GK, GV, LAF, LAB, UB, DV, lds, tid, lane, wave);
        uidx += G; if (uidx >= NU) break;
        gla_g1_unit2(cs, Rb, uidx, G, GK, GV, LAF, LAB, UB, DV, lds, tid, lane, wave);
        uidx += G; if (uidx >= NU) break;
    }
}
#undef G1_DECODE
template <class CS> DI void gla_g3_phase(CS& cs, int G, int bx, const bf16_t* GQ, const bf16_t* GK, const bf16_t* GV, const bf16_t* LAF, const bf16_t* LAB, const bf16_t* ST, const bf16_t* GR, const float* gla_norm, bf16_t* OG,
                     LAS unsigned char* lds, int tid, int lane, int wave) {
    LAS float* Lf = (LAS float*)lds; LAS float* Lb = Lf + 4096;
    LAS bf16_t* Qt = (LAS bf16_t*)(Lb + 4096);
    LAS bf16_t* Kt = Qt + 2 * 64 * GL_KS;
    LAS bf16_t* Vt = Kt + 2 * 64 * GL_KS;
    LAS bf16_t* St = Vt + 64 * GL_VP;
    LAS float* ssx = (LAS float*)(St + 2 * 128 * GL_KS);
    LAS float* segtot = ssx + 128;
    const int j = tid >> 3, dch = tid & 7, g = lane >> 4, l15 = lane & 15;
    int uidx = bx; if (uidx >= NB * 4 * 32) return;
    f32x4 gnv[4];
#pragma unroll
    for (int et = 0; et < 4; ++et) gnv[et] = *(const f32x4*)(gla_norm + 64 * (wave >> 2) + 16 * et + 4 * g);
    GlaRegs R;
    gla_issue<true>(R, (uidx >> 7) * T + 64 * (uidx & 31), (uidx >> 5) & 3, ((uidx >> 7) * 4 + ((uidx >> 5) & 3)) * 2, uidx & 31, GQ, GK, GV, LAF, LAB, ST, tid);
    for (;;) {
        const int b = uidx >> 7, h = (uidx >> 5) & 3, c = uidx & 31, row0 = b * T + 64 * c;
        const u32x4 qreg = R.q, kreg = R.k;
        gla_commit(R, Lf, Lb, Vt, tid);
#pragma unroll
        for (int dir = 0; dir < 2; ++dir)
#pragma unroll
            for (int i = 0; i < 2; ++i) { const int idx = tid + 512 * i, e = idx >> 3, ch = idx & 7; *(LAS u32x4*)(St + (dir * 128 + e) * GL_KS + 8 * ch) = R.st[dir][i]; }
        const int nidx = uidx + G; const bool has_next = nidx < NB * 4 * 32;
        if (has_next) gla_issue<true>(R, (nidx >> 7) * T + 64 * (nidx & 31), (nidx >> 5) & 3, ((nidx >> 7) * 4 + ((nidx >> 5) & 3)) * 2, nidx & 31, GQ, GK, GV, LAF, LAB, ST, tid);
        LDS_BAR();
        (void)gla_cumsum2(Lf, Lb, segtot, tid);
        LDS_BAR();
        { const float qv[8] = {bflo(qreg.x), bfhi(qreg.x), bflo(qreg.y), bfhi(qreg.y), bflo(qreg.z), bfhi(qreg.z), bflo(qreg.w), bfhi(qreg.w)};
          const float kv[8] = {bflo(kreg.x), bfhi(kreg.x), bflo(kreg.y), bfhi(kreg.y), bflo(kreg.z), bfhi(kreg.z), bflo(kreg.w), bfhi(kreg.w)};
#pragma unroll
          for (int dir = 0; dir < 2; ++dir) { const LAS float* L = (dir ? Lb : Lf) + j * 64 + 8 * dch;
            const f32x4 b0 = *(const LAS f32x4*)L, b1 = *(const LAS f32x4*)(L + 4);
            const float bb[8] = {b0.x, b0.y, b0.z, b0.w, b1.x, b1.y, b1.z, b1.w};
            float qt[8], kt[8];
#pragma unroll
            for (int i = 0; i < 8; ++i) { const float ex = __expf(bb[i]); qt[i] = qv[i] * ex; kt[i] = kv[i] * __builtin_amdgcn_rcpf(ex); }
            u32x4 qw, kw; qw.x = pk2(qt[0], qt[1]); qw.y = pk2(qt[2], qt[3]); qw.z = pk2(qt[4], qt[5]); qw.w = pk2(qt[6], qt[7]);
            kw.x = pk2(kt[0], kt[1]); kw.y = pk2(kt[2], kt[3]); kw.z = pk2(kt[4], kt[5]); kw.w = pk2(kt[6], kt[7]);
            *(LAS u32x4*)(Qt + (dir * 64 + j) * GL_KS + 8 * dch) = qw; *(LAS u32x4*)(Kt + (dir * 64 + j) * GL_KS + 8 * dch) = kw; } }
        LDS_BAR();
        const int it = wave & 3, eh = wave >> 2;
        u32x2 grv[4];
#pragma unroll
        for (int et = 0; et < 4; ++et) grv[et] = *(const u32x2*)(GR + (size_t)(row0 + 16 * it + l15) * 512 + h * 128 + 64 * eh + 16 * et + 4 * g);
        f32x4 o[4];
#pragma unroll
        for (int et = 0; et < 4; ++et) o[et] = (f32x4){0.f, 0.f, 0.f, 0.f};
#pragma unroll
        for (int dir = 0; dir < 2; ++dir) {
            bf16x8 qf[2];
#pragma unroll
            for (int s2 = 0; s2 < 2; ++s2) qf[s2] = *(const LAS bf16x8*)(Qt + (dir * 64 + 16 * it + l15) * GL_KS + 32 * s2 + 8 * g);
#pragma unroll
            for (int et = 0; et < 4; ++et)
#pragma unroll
                for (int s2 = 0; s2 < 2; ++s2) { const bf16x8 a = *(const LAS bf16x8*)(St + (dir * 128 + 64 * eh + 16 * et + l15) * GL_KS + 32 * s2 + 8 * g); o[et] = __builtin_amdgcn_mfma_f32_16x16x32_bf16(a, qf[s2], o[et], 0, 0, 0); }
            f32x4 at[4];
#pragma unroll
            for (int jt = 0; jt < 4; ++jt) { at[jt] = (f32x4){0.f, 0.f, 0.f, 0.f};
#pragma unroll
                for (int s2 = 0; s2 < 2; ++s2) { const bf16x8 kf = *(const LAS bf16x8*)(Kt + (dir * 64 + 16 * jt + l15) * GL_KS + 32 * s2 + 8 * g); at[jt] = __builtin_amdgcn_mfma_f32_16x16x32_bf16(kf, qf[s2], at[jt], 0, 0, 0); }
#pragma unroll
                for (int r = 0; r < 4; ++r) { const int jj = 16 * jt + 4 * g + r, ii = 16 * it + l15; const bool keep = dir ? (jj >= ii) : (jj <= ii); if (!keep) at[jt][r] = 0.f; } }
#pragma unroll
            for (int s2 = 0; s2 < 2; ++s2) {
                u32x4 w; w.x = pk2(at[2 * s2][0], at[2 * s2][1]); w.y = pk2(at[2 * s2][2], at[2 * s2][3]); w.z = pk2(at[2 * s2 + 1][0], at[2 * s2 + 1][1]); w.w = pk2(at[2 * s2 + 1][2], at[2 * s2 + 1][3]);
                const bf16x8 pf = __builtin_bit_cast(bf16x8, w);
#pragma unroll
                for (int et = 0; et < 4; ++et) { const LAS bf16_t* vb = Vt + (32 * s2 + 4 * g) * GL_VP + 64 * eh + 16 * et;
                    const u32x2 vlo = lds_tr4(vb, GL_VP, l15), vhi = lds_tr4(vb + 16 * GL_VP, GL_VP, l15);
                    o[et] = __builtin_amdgcn_mfma_f32_16x16x32_bf16(__builtin_bit_cast(bf16x8, (u32x4){vlo.x, vlo.y, vhi.x, vhi.y}), pf, o[et], 0, 0, 0); }
            }
        }
        float ss = 0.f;
#pragma unroll
        for (int et = 0; et < 4; ++et) ss += (o[et].x * o[et].x + o[et].y * o[et].y) + (o[et].z * o[et].z + o[et].w * o[et].w);
        asm volatile("" : "+v"(R.k), "+v"(R.q), "+v"(R.laf), "+v"(R.lab), "+v"(R.v[0]), "+v"(R.v[1]), "+v"(R.st[0][0]), "+v"(R.st[0][1]), "+v"(R.st[1][0]), "+v"(R.st[1][1]));
        ss = xadd32(xadd16(ss));
        if (g == 0) ssx[eh * 64 + 16 * it + l15] = ss;
        LDS_BAR();
        { const float rstd = rsqrtf((ssx[16 * it + l15] + ssx[64 + 16 * it + l15]) * (1.f / 128.f) + EPS);
          const size_t ro = (size_t)(row0 + 16 * it + l15) * 512 + h * 128, ro2 = (size_t)(row0 + 16 * it + l15) * 1024 + h * 128;
#pragma unroll
          for (int et = 0; et < 4; ++et) { const int e0 = 64 * eh + 16 * et + 4 * g; const f32x4 gn = gnv[et]; const u32x2 gr = grv[et]; (void)ro;
              const f32x4 v = o[et] * (rstd * MIX8_SCALE) * gn * (f32x4){bflo(gr.x), bfhi(gr.x), bflo(gr.y), bfhi(gr.y)}; *(unsigned*)((unsigned char*)OG + ro2 + e0) = pk4_fp8(v.x, v.y, v.z, v.w); } }
        LDS_BAR();
        if (!has_next) break;
        uidx = nidx;
    }
}

struct Args { const float* in[26]; float* out; unsigned char* ws; int ph_lo, ph_hi, li, flags; };
constexpr int NPH = 12;

template <bool FP8, int NB, class Dest>
DI void cvt_item(const float* W, int ldw, int ncols, int k0, int s0, void* WT, int Kd, Dest dest, float scale, int lane) {
    const int g = lane >> 4, c0 = s0 + 4 * (lane & 15);
    if (c0 >= ncols) return;
    const float* src = W + (size_t)(k0 + 16 * g) * ldw + c0;
    int dr[4];
#pragma unroll
    for (int c = 0; c < 4; ++c) dr[c] = dest(c0 + c);
#pragma unroll
    for (int kb = 0; kb < NB * 64; kb += 64) {
        f32x4 v[16];
#pragma unroll
        for (int i = 0; i < 16; ++i) v[i] = *(const f32x4*)(src + (size_t)(kb + i) * ldw);
#pragma unroll
        for (int c = 0; c < 4; ++c) {
            if (dr[c] >= 0) {
            if constexpr (FP8) {
                u32x4 o; o.x = pk4_fp8(v[0][c] * scale, v[1][c] * scale, v[2][c] * scale, v[3][c] * scale); o.y = pk4_fp8(v[4][c] * scale, v[5][c] * scale, v[6][c] * scale, v[7][c] * scale);
                o.z = pk4_fp8(v[8][c] * scale, v[9][c] * scale, v[10][c] * scale, v[11][c] * scale); o.w = pk4_fp8(v[12][c] * scale, v[13][c] * scale, v[14][c] * scale, v[15][c] * scale);
                *(u32x4*)((unsigned char*)WT + (size_t)dr[c] * Kd + k0 + kb + 16 * g) = o;
            } else {
                u32x4 o0, o1; o0.x = pk2(v[0][c], v[1][c]); o0.y = pk2(v[2][c], v[3][c]); o0.z = pk2(v[4][c], v[5][c]); o0.w = pk2(v[6][c], v[7][c]);
                o1.x = pk2(v[8][c], v[9][c]); o1.y = pk2(v[10][c], v[11][c]); o1.z = pk2(v[12][c], v[13][c]); o1.w = pk2(v[14][c], v[15][c]);
                bf16_t* dp = (bf16_t*)WT + (size_t)dr[c] * Kd + k0 + kb + 16 * g; *(u32x4*)dp = o0; *(u32x4*)(dp + 8) = o1;
            }
            }
        }
    }
}
DI void sincos_d(double a, double& s, double& c) {
    const double q = __builtin_rint(a * 0.63661977236758134308), f = a - q * 1.57079632679489661923, f2 = f * f;
    const double sp = f * (1.0 + f2 * (-1.0 / 6 + f2 * (1.0 / 120 + f2 * (-1.0 / 5040 + f2 * (1.0 / 362880 + f2 * (-1.0 / 39916800 + f2 * (1.0 / 6227020800.0)))))));
    const double cp = 1.0 + f2 * (-0.5 + f2 * (1.0 / 24 + f2 * (-1.0 / 720 + f2 * (1.0 / 40320 + f2 * (-1.0 / 3628800 + f2 * (1.0 / 479001600 + f2 * (-1.0 / 87178291200.0)))))));
    const int qi = ((int)q) & 3;
    s = (qi == 0) ? sp : (qi == 1) ? cp : (qi == 2) ? -sp : -cp;
    c = (qi == 0) ? cp : (qi == 1) ? -sp : (qi == 2) ? -cp : sp;
}
DI int dest_win(int s) {
    if (s < 512) { const int head = s >> 6, d = s & 63; return (head >> 2) * 256 + slot_head(head & 3, d); }
    if (s < 640) { const int x = s - 512; return 2 * 256 + slot_head(x >> 6, x & 63); }
    if (s < 768) { const int x = s - 640; return 2 * 256 + slot_head(2 + (x >> 6), x & 63); }
    if (s < 1024) return 8 * 256 + slot_std8(s - 768);
    if (s < 1280) return 3 * 256 + slot_std8(s - 1024);
    if (s < 1792) { const int x = s - 1280; return (4 + (x >> 8)) * 256 + slot_std8(x & 255); }
    if (s < 2304) { const int x = s - 1792; return (9 + (x >> 8)) * 256 + slot_std8(x & 255); }
    if (s < 2336) return -1;
    if (s < 3360) { const int x = s - 2336; return (11 + (x >> 8)) * 256 + slot_std8(x & 255); }
    { const int x = s - 3360; return (15 + (x >> 8)) * 256 + slot_std8(x & 255); }
}
DI int dest_std8(int s) { return (s & ~255) + slot_std8(s & 255); }
DI int dest_win_lo(int s) { return s < 2336 ? dest_win(s) : -1; }
DI int dest_gate(int s) { return s < 2336 ? -1 : dest_std8(s - 2336); }
DI int dest_std16(int s) { const int L = s & 255; return (s & ~255) + 128 * ((L >> 3) & 1) + 32 * (L >> 6) + 16 * ((L >> 2) & 1) + 4 * ((L >> 4) & 3) + (L & 3); }
DI int dest_w1(int s) { const int g = s >> 10, f = s & 1023, t = f >> 7, fl = f & 127; return t * 256 + 128 * g + (fl & 0x60) + (((fl >> 2) & 1) << 4) + (((fl >> 3) & 3) << 2) + (fl & 3); }

constexpr int CVT_I_W1 = 32 * 32 * 8, CVT_I_W2 = 32 * 16 * 8, CVT_NBATCH = 2 * (CVT_I_W1 + CVT_I_W2);
struct CvtStream {
    const float* w_e1; const float* w_e2; unsigned char* W1; unsigned char* W2; int gw, ngw, seq, lane;
    DI bool pending() const { return seq * ngw + gw < CVT_NBATCH; }
    DI void issue(CvtRegs& C) const {
        const int id = seq * ngw + gw; if (id >= CVT_NBATCH) return;
        const int item = id >> 1, half = id & 1, g = lane >> 4;
        const float* src;  int ldw;
        if (item < CVT_I_W1) { const int e = item >> 8, q = item & 255; ldw = 2048; src = w_e1 + (size_t)e * 1024 * 2048 + (size_t)((q >> 5) * 128 + half * 64 + 16 * g) * 2048 + (q & 31) * 64 + 4 * (lane & 15); }
        else { const int it2 = item - CVT_I_W1, e = it2 >> 7, q = it2 & 127; ldw = 1024; src = w_e2 + (size_t)e * 1024 * 1024 + (size_t)((q >> 4) * 128 + half * 64 + 16 * g) * 1024 + (q & 15) * 64 + 4 * (lane & 15); }
#pragma unroll
        for (int i = 0; i < 16; ++i) C.v[i] = __builtin_nontemporal_load((const f32x4*)(src + (size_t)i * ldw));
    }
    DI void finish(const CvtRegs& C) {
        const int id = seq * ngw + gw; if (id >= CVT_NBATCH) return;
        ++seq;
        const int item = id >> 1, half = id & 1, g = lane >> 4;
        unsigned char* dst; int c0; bool isw1 = item < CVT_I_W1;
        if (isw1) { const int e = item >> 8, q = item & 255; dst = W1 + (size_t)e * 2048 * 1024 + (q >> 5) * 128 + half * 64 + 16 * g; c0 = (q & 31) * 64 + 4 * (lane & 15); }
        else { const int it2 = item - CVT_I_W1, e = it2 >> 7, q = it2 & 127; dst = W2 + (size_t)e * 1024 * 1024 + (q >> 4) * 128 + half * 64 + 16 * g; c0 = (q & 15) * 64 + 4 * (lane & 15); }
#pragma unroll
        for (int c = 0; c < 4; ++c) {
            const int dr = isw1 ? dest_w1(c0 + c) : dest_std16(c0 + c);
            u32x4 o; o.x = pk4_fp8(C.v[0][c] * W8_SCALE, C.v[1][c] * W8_SCALE, C.v[2][c] * W8_SCALE, C.v[3][c] * W8_SCALE); o.y = pk4_fp8(C.v[4][c] * W8_SCALE, C.v[5][c] * W8_SCALE, C.v[6][c] * W8_SCALE, C.v[7][c] * W8_SCALE);
            o.z = pk4_fp8(C.v[8][c] * W8_SCALE, C.v[9][c] * W8_SCALE, C.v[10][c] * W8_SCALE, C.v[11][c] * W8_SCALE); o.w = pk4_fp8(C.v[12][c] * W8_SCALE, C.v[13][c] * W8_SCALE, C.v[14][c] * W8_SCALE, C.v[15][c] * W8_SCALE);
            *(u32x4*)(dst + (size_t)dr * 1024) = o;
        }
    }
};

__global__ void __launch_bounds__(512, 2) fwd_kernel(Args args) {
    extern __shared__ __attribute__((aligned(16))) unsigned char lds_raw[];
    LAS unsigned char* lds = (LAS unsigned char*)lds_raw;
    volatile LAS unsigned* MISC = (volatile LAS unsigned*)(lds + MISC_OFF);
    const int tid = threadIdx.x, lane = tid & 63, wave = __builtin_amdgcn_readfirstlane(tid >> 6);
    const int G = gridDim.x, bx = blockIdx.x;
    const int vcu = (G % 8 == 0) ? (bx % 8) * (G / 8) + bx / 8 : bx;
    const int gw = vcu * 8 + wave, NGW = G * 8;
    unsigned char* ws = args.ws;
    unsigned* ctl = (unsigned*)(ws + O_CTL);
    CvtStream cvs; cvs.w_e1 = args.in[22]; cvs.w_e2 = args.in[24]; cvs.W1 = ws + O_W1; cvs.W2 = ws + O_W2; cvs.gw = gw; cvs.ngw = NGW; cvs.lane = lane;
    cvs.seq = (args.ph_lo > 3) ? 1 << 20 : 0;
    const float* x = args.in[0]; const float* cvec = args.in[1]; const float* ctx = args.in[2]; const float* c_ctx = args.in[3];
    const float* w_mod = args.in[4]; const float* b_mod = args.in[5]; const float* norm1 = args.in[6]; const float* norm2 = args.in[7];
    const float* w_in = args.in[8]; const float* q_norm = args.in[9]; const float* k_norm = args.in[10]; const float* attn_sink = args.in[11];
    const float* w_alpha_f = args.in[12]; const float* b_alpha_f = args.in[13]; const float* w_alpha_b = args.in[14]; const float* b_alpha_b = args.in[15];
    const float* gla_norm = args.in[16]; const float* w_battn = args.in[17]; const float* w_bgla = args.in[18]; const float* w_out = args.in[19];
    const float* w_router = args.in[20]; const float* b_router = args.in[21]; const float* w_e1 = args.in[22]; const float* b_e1 = args.in[23];
    const float* w_e2 = args.in[24]; const float* b_e2 = args.in[25];
    float* out = args.out;
    float* MOD = (float*)(ws + O_MOD); float* ROPEC = (float*)(ws + O_ROPE); float* ROPES = ROPEC + 1024;
    float* WTS = (float*)(ws + O_WTS); int* LIST = (int*)(ws + O_LIST); float* WL = (float*)(ws + O_WL);
    bf16_t* WIN = (bf16_t*)(ws + O_WIN); bf16_t* WBA = (bf16_t*)(ws + O_WBA); bf16_t* WBG = (bf16_t*)(ws + O_WBG); bf16_t* WOUT = (bf16_t*)(ws + O_WOUT);
    unsigned char* WIN8 = ws + O_WIN + (size_t)11 * 256 * 1024 * 2; unsigned char* HN8 = ws + O_ACT;
    unsigned char* W1 = ws + O_W1; unsigned char* W2 = ws + O_W2;
    bf16_t* HN = (bf16_t*)(ws + O_HN); bf16_t* Qb = (bf16_t*)(ws + O_Q); bf16_t* Kb = (bf16_t*)(ws + O_K); bf16_t* Vb = (bf16_t*)(ws + O_V);
    bf16_t* GQ = (bf16_t*)(ws + O_GQ); bf16_t* GK = (bf16_t*)(ws + O_GK); bf16_t* GV = (bf16_t*)(ws + O_GV);
    bf16_t* LAF = (bf16_t*)(ws + O_LAF); bf16_t* LAB = (bf16_t*)(ws + O_LAB);
    bf16_t* GR = (bf16_t*)(ws + O_GR); bf16_t* GA = (bf16_t*)(ws + O_GA); bf16_t* GG = (bf16_t*)(ws + O_GG);
    bf16_t* AO = (bf16_t*)(ws + O_AO); bf16_t* UB = (bf16_t*)(ws + O_UB); float* DV = (float*)(ws + O_DV); bf16_t* ST = (bf16_t*)(ws + O_ST); bf16_t* OG = (bf16_t*)((unsigned char*)AO + 512);
    bf16_t* X1b = (bf16_t*)(ws + O_X1); bf16_t* Yb = (bf16_t*)(ws + O_Y); unsigned char* H2 = ws + O_H2;
    unsigned char* ACT = ws + O_ACT; unsigned char* YS = ws + O_YS;

    for (int u = tid; u < 64; u += 512) MISC[u] = 0u;
    __syncthreads();
    XcdBarrier bar; bar.bar = ctl + CW_BAR + args.li * XCD_BAR_WORDS; bar.x = 0; bar.st = nullptr;
    bar = xcd_barrier_post(ctl + CW_BAR + args.li * XCD_BAR_WORDS, MISC + 8);
    const int lo = args.ph_lo, hi = args.ph_hi;
#define IN(k) (lo <= (k) && (k) < hi)
#define SEAM(k) do { if (IN(k) && IN((k) + 1)) xcd_barrier(bar); } while (0)

    if (IN(0)) {
        for (int it = bx; it < MOD_ITEMS; it += G) {
            const int cb = it >> 1, kh = it & 1;
            LAS float* sc = (LAS float*)lds; LAS float* part = sc + 9 * 512;
            for (int idx = tid; idx < 9 * 512; idx += 512) { const int r = idx >> 9, k = kh * 512 + (idx & 511); const float v = (r < 8) ? cvec[r * 1024 + k] : c_ctx[k]; sc[idx] = v * sigmoidf_(v); }
            __syncthreads();
            float ac[9];
#pragma unroll
            for (int r = 0; r < 9; ++r) ac[r] = 0.f;
            const int col = cb * 64 + lane;
#pragma unroll 4
            for (int k4 = 0; k4 < 16; ++k4) {
                float w[4];
#pragma unroll
                for (int q = 0; q < 4; ++q) w[q] = w_mod[(size_t)(kh * 512 + wave * 64 + k4 * 4 + q) * 6144 + col];
#pragma unroll
                for (int r = 0; r < 9; ++r) { const f32x4 s4 = *(const LAS f32x4*)(sc + r * 512 + wave * 64 + k4 * 4); ac[r] += (s4.x * w[0] + s4.y * w[1]) + (s4.z * w[2] + s4.w * w[3]); }
            }
#pragma unroll
            for (int r = 0; r < 9; ++r) part[(wave * 9 + r) * 64 + lane] = ac[r];
            __syncthreads();
            for (int idx = tid; idx < 576; idx += 512) { const int r = idx >> 6, l = idx & 63; float sm = kh ? 0.f : b_mod[cb * 64 + l];
#pragma unroll
                for (int w = 0; w < 8; ++w) sm += part[(w * 9 + r) * 64 + l];
                (void)__hip_atomic_fetch_add(MOD + r * 6144 + cb * 64 + l, sm, __ATOMIC_RELAXED, __HIP_MEMORY_SCOPE_AGENT); }
            asm volatile("s_waitcnt vmcnt(0)" ::: "memory");
            __syncthreads();
            if (tid == 0) (void)__hip_atomic_fetch_add(ctl + CW_MODF, 1u, __ATOMIC_RELAXED, __HIP_MEMORY_SCOPE_AGENT);
        }
        if (bx == G - 1) {
            for (int idx = tid; idx < 1024; idx += 512) { const int pos = idx >> 4, i = idx & 15; double inv = 1.0; for (int j = 0; j < i; ++j) inv *= 0.56234132519034908039;
                double s, c; sincos_d((double)pos * inv, s, c); ROPEC[idx] = (float)c; ROPES[idx] = (float)s; }
        }
        LAS float* scr = (LAS float*)(lds + wave * 16384);
        constexpr int I_EFF = 32, I_WIN = 69 * 16, I_BA = 16 * 8, I_BG = 16 * 8, I_OUT = 16 * 16;
        constexpr int NITEMS = I_EFF + I_WIN + I_BA + I_BG + I_OUT;
        for (int it = gw; it < NITEMS; it += NGW) {
            int r = it;
            if (r < I_EFF) {
                const int dir = r >> 4, kb = r & 15; const float* wa = dir ? w_alpha_b : w_alpha_f;
                { const float* lrp = w_in + (size_t)(kb * 64 + lane) * CIN + 2304 + 16 * dir;
#pragma unroll
                  for (int q4 = 0; q4 < 4; ++q4) *(LAS f32x4*)(scr + lane * 16 + 4 * q4) = *(const f32x4*)(lrp + 4 * q4); }
                LDS_WAIT(); asm volatile("" ::: "memory");
                for (int p = 0; p < 4; ++p) {
                    const int n = p * 64 + lane; float al[16];
#pragma unroll
                    for (int q = 0; q < 16; ++q) al[q] = wa[q * 256 + n];
                    bf16_t* dst = WIN + (size_t)((6 + dir) * 256 + slot_std8(n)) * 1024 + kb * 64;
#pragma unroll 2
                    for (int g8 = 0; g8 < 8; ++g8) {
                        float sv[8];
#pragma unroll
                        for (int j = 0; j < 8; ++j) { const LAS float* lr = scr + (g8 * 8 + j) * 16; float sm = 0.f;
#pragma unroll
                            for (int q4 = 0; q4 < 4; ++q4) { const f32x4 l4 = *(const LAS f32x4*)(lr + 4 * q4); sm += (l4.x * al[4 * q4] + l4.y * al[4 * q4 + 1]) + (l4.z * al[4 * q4 + 2] + l4.w * al[4 * q4 + 3]); }
                            sv[j] = sm; }
                        u32x4 o; o.x = pk2(sv[0], sv[1]); o.y = pk2(sv[2], sv[3]); o.z = pk2(sv[4], sv[5]); o.w = pk2(sv[6], sv[7]);
                        *(u32x4*)(dst + g8 * 8) = o;
                    }
                }
                LDS_WAIT(); asm volatile("" ::: "memory");
                continue; } r -= I_EFF;
            if (r < I_WIN) { const int cb = r % 69, kb = r / 69;
                if (cb <= 36) cvt_item<false, 1>(w_in, CIN, CIN, kb * 64, cb * 64, WIN, 1024, [](int s) { return dest_win_lo(s); }, 1.f, lane);
                if (cb >= 36) cvt_item<true, 1>(w_in, CIN, CIN, kb * 64, cb * 64, WIN8, 1024, [](int s) { return dest_gate(s); }, W8_SCALE, lane);
                continue; } r -= I_WIN;
            if (r < I_BA) { cvt_item<true, 1>(w_battn, 1024, 1024, (r >> 4) * 64, (r & 15) * 64, WBA, 1024, [](int s) { return dest_std8(s); }, W8_SCALE, lane); continue; } r -= I_BA;
            if (r < I_BG) { cvt_item<true, 1>(w_bgla, 1024, 1024, (r >> 4) * 64, (r & 15) * 64, (unsigned char*)WBA + 512, 1024, [](int s) { return dest_std8(s); }, W8_SCALE, lane); continue; } r -= I_BG;
            cvt_item<true, 1>(w_out, 1024, 1024, (r >> 4) * 64, (r & 15) * 64, WOUT, 1024, [](int s) { return dest_std8(s); }, W8_SCALE, lane);
        }
        f32x4 vn[4];
#define P1_LOAD(m_) do { const float* xr_ = ((m_) < M) ? x + (size_t)(m_) * D : ctx + (size_t)((m_) - M) * D; _Pragma("unroll") for (int j = 0; j < 4; ++j) vn[j] = *(const f32x4*)(xr_ + 4 * lane + 256 * j); } while (0)
        if (gw < MT) P1_LOAD(gw);
        { unsigned spins = 0;
          while ((unsigned)__builtin_amdgcn_readfirstlane(__hip_atomic_load(ctl + CW_MODF, __ATOMIC_RELAXED, __HIP_MEMORY_SCOPE_AGENT)) < (unsigned)MOD_ITEMS) {
              __builtin_amdgcn_s_sleep(2); if (++spins > (1u << 22)) { if (lane == 0) __hip_atomic_store(ctl + CW_TMO, 1u, __ATOMIC_RELAXED, __HIP_MEMORY_SCOPE_AGENT); break; } }
          __builtin_amdgcn_fence(__ATOMIC_ACQUIRE, "agent"); asm volatile("s_waitcnt vmcnt(0)" ::: "memory"); }

        for (int m = gw; m < MT; m += NGW) {
            const float* md = MOD + ((m < M) ? (m >> 11) : 8) * 6144;
            f32x4 v[4]; float ss = 0.f;
#pragma unroll
            for (int j = 0; j < 4; ++j) { v[j] = vn[j]; ss += (v[j].x * v[j].x + v[j].y * v[j].y) + (v[j].z * v[j].z + v[j].w * v[j].w); }
            if (m + NGW < MT) P1_LOAD(m + NGW);
            const float rstd = rsqrtf(wave_sum_dpp(ss) * (1.f / D) + EPS);
#pragma unroll
            for (int j = 0; j < 4; ++j) { const int c = 4 * lane + 256 * j;
                const f32x4 g = *(const f32x4*)(norm1 + c), sh = *(const f32x4*)(md + c), sc = *(const f32x4*)(md + 1024 + c);
                const f32x4 h = (v[j] * rstd * g) * (sc + 1.f) + sh;
                st4bf(HN + (size_t)m * D + c, h);
                if (m < M) *(unsigned*)(HN8 + (size_t)m * D + c) = pk4_fp8(h.x, h.y, h.z, h.w); }
        }
#undef P1_LOAD
    }
    SEAM(1);

    if (IN(2)) {
        InProjSched S; S.G = G; S.c = bx; S.A = (const char*)HN; S.Bt = (const char*)WIN;
        EpiInProj E{Qb, Kb, Vb, GQ, GK, GV, GR, GA, GG, LAF, LAB, q_norm, k_norm, b_alpha_f, b_alpha_b, ROPEC, ROPES};
        pg8::gemm_phase<EpiInProj, InProjSched, true>(lds, 1024, S, E);
        PlainSched S2; S2.G = G; S2.c = bx; S2.nM = 64; S2.nN = 8; S2.K = 1024; S2.eb = 1; S2.A = (const char*)HN8; S2.Bt = (const char*)WIN8;
        EpiGates E2{GA, GG};
        pg8::gemm_phase<EpiGates, PlainSched, true, true>(lds, 1024, S2, E2);
    }
    SEAM(2);

    if (IN(3)) {
        for (int uidx = bx; uidx < 256; uidx += G) attn_unit(uidx >> 5, (uidx >> 4) & 1, uidx & 15, Qb, Kb, Vb, AO, attn_sink, lds, tid, lane, wave);
        gla_g1_phase(cvs, G, bx, GK, GV, LAF, LAB, UB, DV, lds, tid, lane, wave);
    }
    SEAM(3);

    if (IN(4)) {
        if (bx < NB) {
            const float* mdr = MOD + bx * 6144 + 3 * 1024; float s4[4] = {0.f, 0.f, 0.f, 0.f};
            for (int i = 0; i < 16; ++i) { const int c = lane + 64 * i; const float sh = mdr[c]; const f32x4 w = *(const f32x4*)(w_router + (size_t)c * 32 + 4 * wave);
                s4[0] += sh * w.x; s4[1] += sh * w.y; s4[2] += sh * w.z; s4[3] += sh * w.w; }
#pragma unroll
            for (int j = 0; j < 4; ++j) { const float tot = wave_sum_dpp(s4[j]); if (lane == 0) ((float*)(ws + O_ROPE + 16384))[bx * 32 + 4 * wave + j] = tot + b_router[4 * wave + j]; }
        }
        for (int gid = bx * 512 + tid; gid < 64 * 128 * 16; gid += G * 512) {
            const int seq = gid >> 11, e = (gid >> 4) & 127, dq = gid & 15, dir = seq & 1;
            f32x4 S = {0.f, 0.f, 0.f, 0.f};
            const bf16_t* ub = UB + ((size_t)seq * 36 * 128 + e) * 64 + 4 * dq; const float* dvp = DV + (size_t)seq * 36 * 64 + 4 * dq;
            bf16_t* stp = ST + ((size_t)seq * 32 * 128 + e) * 64 + 4 * dq;
            u32x2 ua[6], ub2[6]; f32x4 da[6], db[6];
#define G2_LOAD(U_, D_, p0_) do { _Pragma("unroll") for (int i = 0; i < 6; ++i) { const int p = (p0_) + i, cc = dir ? (p < 4 ? 3 - p : 39 - p) : p; \
                U_[i] = *(const u32x2*)(ub + cc * (128 * 64)); D_[i] = *(const f32x4*)(dvp + cc * 64); } } while (0)
#define G2_SCAN(U_, D_, p0_) do { _Pragma("unroll") for (int i = 0; i < 6; ++i) { const int p = (p0_) + i, cc = dir ? (p < 4 ? 3 - p : 39 - p) : p; \
                if (cc >= 4) st4bf(stp + (cc - 4) * (128 * 64), S); \
                S = D_[i] * S + (f32x4){bflo(U_[i].x), bfhi(U_[i].x), bflo(U_[i].y), bfhi(U_[i].y)}; } } while (0)
            G2_LOAD(ua, da, 0);
#pragma unroll 1
            for (int p0 = 0; p0 < 36; p0 += 12) {
                G2_LOAD(ub2, db, p0 + 6);
                CvtRegs CR; cvs.issue(CR);
                G2_SCAN(ua, da, p0);
                if (p0 + 12 < 36) G2_LOAD(ua, da, p0 + 12);
                G2_SCAN(ub2, db, p0 + 6);
                cvs.finish(CR);
            }
#undef G2_LOAD
#undef G2_SCAN
        }
    }
    SEAM(4);

    if (IN(5)) {
        gla_g3_phase(cvs, G, bx, GQ, GK, GV, LAF, LAB, ST, GR, gla_norm, OG, lds, tid, lane, wave);
    }
    SEAM(5);

    if (IN(6)) {
        PlainSched S; S.G = G; S.c = bx; S.nM = 64; S.nN = 4; S.K = 1024; S.eb = 1; S.A = (const char*)AO; S.Bt = (const char*)WBA;
        EpiMerge1 E{GA, GG, (unsigned char*)Yb};
        pg8::gemm_phase<EpiMerge1, PlainSched, true, true>(lds, 1024, S, E);
    }
    SEAM(6);

    if (IN(7)) {
        PlainSched S; S.G = G; S.c = bx; S.nM = 64; S.nN = 4; S.K = 1024; S.eb = 1; S.A = (const char*)Yb; S.Bt = (const char*)WOUT;
        EpiMerge2 E{x, MOD, X1b};
        pg8::gemm_phase<EpiMerge2, PlainSched, true, true>(lds, 1024, S, E);
    }
    SEAM(7);

    if (IN(8)) {
        LAS float* wrt = (LAS float*)lds;
        LAS int* lcnt = (LAS int*)(lds + XTRA_OFF);
        LAS int* lbase = lcnt + 32; LAS int* lexp = lcnt + 64; LAS int* lrank = lexp + 256; LAS float* lwt = (LAS float*)(lrank + 256);
        LAS float* rsd = (LAS float*)(lds + XTRA_OFF + 3584);
        LAS float* lg = (LAS float*)(lds + XTRA_OFF + 4096);
        const float* RB = (const float*)(ws + O_ROPE + 16384);
        for (int rb = bx; rb < M / 64; rb += G) {
            const float* md = MOD + ((rb * 64) >> 11) * 6144;
            int zz; asm volatile("v_mov_b32 %0, 0" : "=v"(zz));
            const int tz = tid + zz, lz = lane + zz;
            CvtRegs CR; cvs.issue(CR);
            if (tid < 32) lcnt[tid] = 0;
#pragma unroll
            for (int cc = 0; cc < 2; ++cc) {
                const int col = tz + 512 * cc; const float gsc = norm2[col] * (1.f + md[4 * 1024 + col]);
#pragma unroll
                for (int q = 0; q < 8; ++q) { const f32x4 w = *(const f32x4*)(w_router + (size_t)col * 32 + 4 * q);
#pragma unroll
                    for (int j = 0; j < 4; ++j) { const int e = 4 * q + j; wrt[e * 1024 + (col ^ ((e & 15) << 2))] = w[j] * gsc; } }
            }
            cvs.finish(CR);
            LDS_BAR();
            cvs.issue(CR);
            {
                f32x4 Gc[4], Sh[4];
#pragma unroll
                for (int j = 0; j < 4; ++j) { const int c = 4 * lz + 256 * j; const f32x4 g = *(const f32x4*)(norm2 + c), sc = *(const f32x4*)(md + 4 * 1024 + c); Sh[j] = *(const f32x4*)(md + 3 * 1024 + c); Gc[j] = g * (sc + 1.f); }
                u32x2 vn[4];
#pragma unroll
                for (int j = 0; j < 4; ++j) vn[j] = *(const u32x2*)(X1b + (size_t)(rb * 64 + wave * 8) * D + 4 * lane + 256 * j);
#pragma unroll 2
                for (int i = 0; i < 8; ++i) {
                    const int rl = wave * 8 + i, m = rb * 64 + rl;
                    f32x4 v[4]; float ss = 0.f;
#pragma unroll
                    for (int j = 0; j < 4; ++j) { v[j] = (f32x4){bflo(vn[j].x), bfhi(vn[j].x), bflo(vn[j].y), bfhi(vn[j].y)}; ss += (v[j].x * v[j].x + v[j].y * v[j].y) + (v[j].z * v[j].z + v[j].w * v[j].w); }
                    if (i < 7) {
#pragma unroll
                        for (int j = 0; j < 4; ++j) vn[j] = *(const u32x2*)(X1b + (size_t)(m + 1) * D + 4 * lane + 256 * j);
                    }
                    const float rstd = rsqrtf(wave_sum_dpp(ss) * (1.f / D) + EPS);
                    if (lane == 0) rsd[rl] = rstd;
#pragma unroll
                    for (int j = 0; j < 4; ++j) { const f32x4 h = (v[j] * rstd) * Gc[j] + Sh[j]; *(unsigned*)(H2 + (size_t)m * D + 4 * lane + 256 * j) = pk4_fp8(h.x, h.y, h.z, h.w); }
                }
            }
            cvs.finish(CR);
            {
                const int rg = wave & 3, kh = wave >> 2, li = lz & 15, kq = lz >> 4;
                const bf16_t* xp = X1b + (size_t)(rb * 64 + rg * 16 + li) * D + kh * 512 + 8 * kq;
                u32x4 xa[16];
#pragma unroll
                for (int sI = 0; sI < 16; ++sI) xa[sI] = *(const u32x4*)(xp + 32 * sI);
                f32x4 a0 = {0.f, 0.f, 0.f, 0.f}, a1 = {0.f, 0.f, 0.f, 0.f};
                const LAS float* w0 = wrt + li * 1024; const LAS float* w1 = w0 + 16 * 1024;
#pragma unroll
                for (int sI = 0; sI < 16; ++sI) {
                    const int grp = kh * 128 + 8 * sI + 2 * kq, g0 = (grp ^ li) * 4, g1 = ((grp + 1) ^ li) * 4;
                    const f32x4 b00 = *(const LAS f32x4*)(w0 + g0), b01 = *(const LAS f32x4*)(w0 + g1), b10 = *(const LAS f32x4*)(w1 + g0), b11 = *(const LAS f32x4*)(w1 + g1);
                    const u32x4 xw = xa[sI];
                    const float xv[8] = {bflo(xw.x), bfhi(xw.x), bflo(xw.y), bfhi(xw.y), bflo(xw.z), bfhi(xw.z), bflo(xw.w), bfhi(xw.w)};
#pragma unroll
                    for (int t = 0; t < 4; ++t) { a0 = __builtin_amdgcn_mfma_f32_16x16x4f32(b00[t], xv[t], a0, 0, 0, 0); a1 = __builtin_amdgcn_mfma_f32_16x16x4f32(b10[t], xv[t], a1, 0, 0, 0); }
#pragma unroll
                    for (int t = 0; t < 4; ++t) { a0 = __builtin_amdgcn_mfma_f32_16x16x4f32(b01[t], xv[4 + t], a0, 0, 0, 0); a1 = __builtin_amdgcn_mfma_f32_16x16x4f32(b11[t], xv[4 + t], a1, 0, 0, 0); }
                }
                cvs.issue(CR);
                LAS float* lrow = lg + (rg * 16 + li) * 32 + 4 * kq;
                if (kh == 1) { *(LAS f32x4*)lrow = a0; *(LAS f32x4*)(lrow + 16) = a1; }
                LDS_BAR();
                if (kh == 0) {
                    const float r = rsd[rg * 16 + li]; const float* rbp = RB + ((rb * 64) >> 11) * 32 + 4 * kq;
                    const f32x4 p0 = *(const LAS f32x4*)lrow, p1 = *(const LAS f32x4*)(lrow + 16), c0 = *(const f32x4*)rbp, c1 = *(const f32x4*)(rbp + 16);
                    *(LAS f32x4*)lrow = (a0 + p0) * r + c0; *(LAS f32x4*)(lrow + 16) = (a1 + p1) * r + c1;
                }
                LDS_BAR();
            }
            if (lane < 8) {
                const int rl = wave * 8 + lane, m = rb * 64 + rl;
                float l[32];
#pragma unroll
                for (int q = 0; q < 8; ++q) { const f32x4 t4 = *(const LAS f32x4*)(lg + rl * 32 + 4 * q); l[4 * q] = t4.x; l[4 * q + 1] = t4.y; l[4 * q + 2] = t4.z; l[4 * q + 3] = t4.w; }
                float tv[4]; int ti[4]; unsigned taken = 0u;
#pragma unroll
                for (int k = 0; k < 4; ++k) {
                    float best = -INFINITY; int bi = 0;
#pragma unroll
                    for (int e = 0; e < 32; ++e) { const bool ok = !((taken >> e) & 1u) && (l[e] > best); best = ok ? l[e] : best; bi = ok ? e : bi; }
                    tv[k] = best; ti[k] = bi; taken |= 1u << bi;
                }
                const float e1 = __expf(tv[1] - tv[0]), e2 = __expf(tv[2] - tv[0]), e3 = __expf(tv[3] - tv[0]); const float inv = 1.f / (1.f + e1 + e2 + e3);
                const float wv[4] = {inv, e1 * inv, e2 * inv, e3 * inv};
#pragma unroll
                for (int k = 0; k < 4; ++k) { WTS[m * 4 + k] = wv[k]; lwt[rl * 4 + k] = wv[k]; lexp[rl * 4 + k] = ti[k]; lrank[rl * 4 + k] = atomicAdd((int*)&lcnt[ti[k]], 1); }
            }
            LDS_BAR();
            if (tid < 32) lbase[tid] = (int)atomicAdd(ctl + CW_CNT + 64 * tid, (unsigned)lcnt[tid]);
            __syncthreads();
            if (tid < 256) { const int ex = lexp[tid], pos = ex * LISTCAP + lbase[ex] + lrank[tid]; LIST[pos] = (rb * 64) * 4 + tid; WL[pos] = lwt[tid]; }
            cvs.finish(CR);
            __syncthreads();
        }
        while (cvs.pending()) { CvtRegs CR2; cvs.issue(CR2); cvs.finish(CR2); }
    }
    SEAM(8);

    if (IN(9) || IN(10)) {
        LAS int* TT = (LAS int*)(lds + XTRA_OFF);
        __syncthreads();
        if (tid < NE) { const int c = (int)__hip_atomic_load(ctl + CW_CNT + 64 * tid, __ATOMIC_RELAXED, __HIP_MEMORY_SCOPE_AGENT); TT[1 + tid] = c; TT[33 + tid] = (c + 255) >> 8; }
        __syncthreads();
        {
            int pre = 0, myent = -1;
            for (int e = 0; e < NE; ++e) { const int n = TT[33 + e]; if (tid >= pre && tid < pre + n) myent = e | ((tid - pre) << 8); pre += n; }
            __syncthreads();
            if (myent >= 0) TT[64 + tid] = myent;
            if (tid == 0) TT[0] = pre;
        }
        __syncthreads();
        if (IN(9)) {
            MoeSched<true, 3> S; S.G = G; S.cv = vcu; S.TT = TT; S.A = (const char*)H2; S.Bt = (const char*)W1; S.b_estride = (size_t)2048 * 1024; S.LIST = LIST;
            EpiMoe1 E{b_e1, ACT};
            pg8::gemm_phase<EpiMoe1, MoeSched<true, 3>, true, true>(lds, 1024, S, E);
        }
        SEAM(9);
        if (IN(10)) {
            MoeSched<false, 2> S; S.G = G; S.cv = vcu; S.TT = TT; S.A = (const char*)ACT; S.Bt = (const char*)W2; S.b_estride = (size_t)1024 * 1024; S.LIST = LIST;
            EpiMoe2 E{b_e2, LIST, WL, YS};
            pg8::gemm_phase<EpiMoe2, MoeSched<false, 2>, true, true>(lds, 1024, S, E);
        }
    }
    SEAM(10);

    if (IN(11)) {
        f32x4 xn[4]; int yn[4][4];
#define P11_LOAD(m_) do { _Pragma("unroll") for (int j = 0; j < 4; ++j) { const int c_ = 4 * lane + 256 * j; { const u32x2 w_ = *(const u32x2*)(X1b + (size_t)(m_) * D + c_); xn[j] = (f32x4){bflo(w_.x), bfhi(w_.x), bflo(w_.y), bfhi(w_.y)}; } \
            _Pragma("unroll") for (int k = 0; k < 4; ++k) yn[j][k] = *(const int*)(YS + (size_t)((m_) * 4 + k) * D + c_); } } while (0)
        if (gw < M) P11_LOAD(gw);
        for (int m = gw; m < M; m += NGW) {
            const float* md = MOD + (m >> 11) * 6144 + 5 * 1024;
            f32x4 xv[4]; int yv[4][4];
#pragma unroll
            for (int j = 0; j < 4; ++j) { xv[j] = xn[j];
#pragma unroll
                for (int k = 0; k < 4; ++k) yv[j][k] = yn[j][k]; }
            if (m + NGW < M) P11_LOAD(m + NGW);
#pragma unroll
            for (int j = 0; j < 4; ++j) { const int c = 4 * lane + 256 * j;
                f32x4 s = {0.f, 0.f, 0.f, 0.f};
#pragma unroll
                for (int k = 0; k < 4; ++k) { const f32x2 lo = __builtin_amdgcn_cvt_pk_f32_fp8(yv[j][k], false), hi = __builtin_amdgcn_cvt_pk_f32_fp8(yv[j][k], true); s = s + (f32x4){lo.x, lo.y, hi.x, hi.y}; }
                s = s * (1.f / YS8_SCALE);
                const f32x4 g = *(const f32x4*)(md + c);
                *(f32x4*)(out + (size_t)m * D + c) = xv[j] + g * s; }
        }
#undef P11_LOAD
    }
#undef IN
#undef SEAM
}

extern "C" void kernel_launch(void* const* d_in, const int* in_sizes, int n_in, void* d_out, int out_size, void* d_ws, size_t ws_size, hipStream_t stream) {
    static int grid = 0;
    if (grid == 0) {
        if (n_in != 26 || out_size != M * D || ws_size < WS_END) { fprintf(stderr, "kernel_launch: unexpected shapes (n_in %d, out %d, ws %zu < %zu)\n", n_in, out_size, ws_size, (size_t)WS_END); grid = -1; return; }
        int dev = 0, cus = 0, per_cu = 0;
        if (hipGetDevice(&dev) != hipSuccess || hipDeviceGetAttribute(&cus, hipDeviceAttributeMultiprocessorCount, dev) != hipSuccess) { grid = -1; return; }
        if (hipFuncSetAttribute((const void*)fwd_kernel, hipFuncAttributeMaxDynamicSharedMemorySize, LDS_BYTES) != hipSuccess) { fprintf(stderr, "kernel_launch: hipFuncSetAttribute failed\n"); grid = -1; return; }
        if (hipOccupancyMaxActiveBlocksPerMultiprocessor(&per_cu, (const void*)fwd_kernel, 512, LDS_BYTES) != hipSuccess || per_cu < 1) fprintf(stderr, "kernel_launch: occupancy query reports %d\n", per_cu);
        (void)hipGetLastError();
        grid = cus;
    }
    if (grid < 0) return;
    (void)hipMemsetAsync((char*)d_ws + O_CTL, 0, CTL_ZERO_BYTES, stream);
    Args a{};
    for (int i = 0; i < 26; ++i) a.in[i] = (const float*)d_in[i];
    a.out = (float*)d_out; a.ws = (unsigned char*)d_ws;
    a.ph_lo = 0; a.ph_hi = NPH; hipLaunchKernelGGL(fwd_kernel, dim3(grid), dim3(512), LDS_BYTES, stream, a);
}
```

```cpp
#include <hip/hip_runtime.h>
#include <cstdio>
#include <cstdint>

#define DI __device__ __forceinline__
#define GAS __attribute__((address_space(1)))
#define LAS __attribute__((address_space(3)))
typedef unsigned short bf16_t;
typedef short bf16x8 __attribute__((ext_vector_type(8)));
typedef float f32x4 __attribute__((ext_vector_type(4)));
typedef float f32x2 __attribute__((ext_vector_type(2)));
typedef unsigned u32x4 __attribute__((ext_vector_type(4)));
typedef unsigned u32x2 __attribute__((ext_vector_type(2)));
typedef __bf16 bf16x2_t __attribute__((ext_vector_type(2)));
typedef int i32x8 __attribute__((ext_vector_type(8)));
typedef int i32x4 __attribute__((ext_vector_type(4)));


constexpr int D = 1024, NB = 8, T = 2048, LC = 256;
constexpr int M = NB * T;
constexpr int MC = NB * LC;
constexpr int MT = M + MC;
constexpr int NIN = 4864;
constexpr int CIN = 4384;
constexpr int NE = 32, TOPK = 4, DFF = 1024;
constexpr float EPS = 1e-6f;
constexpr float LOG2E = 1.4426950408889634f;
constexpr float QSCALE = 0.125f * LOG2E;
constexpr int LISTCAP = 16384;
constexpr int ACT_ROWS = 73728;

constexpr size_t al64k(size_t x) { return (x + 65535) & ~(size_t)65535; }
constexpr size_t O_CTL = 0;
constexpr size_t O_MOD = 1u << 20;
constexpr size_t CTL_ZERO_BYTES = (1u << 20) + 9 * 6144 * 4;
constexpr size_t O_ROPE = O_MOD + al64k(9 * 6144 * 4);
constexpr size_t O_WTS = O_ROPE + al64k(2 * 64 * 16 * 4);
constexpr size_t O_LIST = O_WTS + al64k(65536 * 4);
constexpr size_t O_WL = O_LIST + al64k((size_t)NE * LISTCAP * 4);
constexpr size_t O_WIN = O_WL + al64k((size_t)NE * LISTCAP * 4);
constexpr size_t O_WBA = O_WIN + al64k((size_t)NIN * 1024 * 2);
constexpr size_t O_WBG = O_WBA + al64k(1024 * 1024 * 2);
constexpr size_t O_WOUT = O_WBG + al64k(1024 * 512 * 2);
constexpr size_t O_W1 = O_WOUT + al64k(1024 * 1024 * 2);
constexpr size_t O_W2 = O_W1 + al64k((size_t)NE * 2048 * 1024 * 2);
constexpr size_t O_HN = O_W2 + al64k((size_t)NE * 1024 * 1024 * 2);
constexpr size_t O_Q = O_HN + al64k((size_t)MT * 1024 * 2);
constexpr size_t O_K = O_Q + al64k((size_t)M * 512 * 2);
constexpr size_t O_V = O_K + al64k((size_t)MT * 128 * 2);
constexpr size_t O_GQ = O_V + al64k((size_t)MT * 128 * 2);
constexpr size_t O_GK = O_GQ + al64k((size_t)M * 256 * 2);
constexpr size_t O_GV = O_GK + al64k((size_t)MT * 256 * 2);
constexpr size_t O_LAF = O_GV + al64k((size_t)MT * 512 * 2);
constexpr size_t O_LAB = O_LAF + al64k((size_t)MT * 256 * 4);
constexpr size_t O_GR = O_LAB + al64k((size_t)MT * 256 * 4);
constexpr size_t O_GA = O_GR + al64k((size_t)M * 512 * 2);
constexpr size_t O_GG = O_GA + al64k((size_t)M * 1024 * 2);
constexpr size_t O_AO = O_GG + al64k((size_t)M * 1024 * 2);
constexpr size_t O_UB = O_AO + al64k((size_t)M * 1024 * 2);
constexpr size_t O_DV = O_UB + al64k((size_t)64 * 36 * 128 * 64 * 2);
constexpr size_t O_ST = O_DV + al64k((size_t)64 * 36 * 64 * 4);
constexpr size_t O_OG = O_ST + al64k((size_t)64 * 32 * 128 * 64 * 2);
constexpr size_t O_X1 = O_OG + al64k((size_t)M * 512 * 2);
constexpr size_t O_Y = O_X1 + al64k((size_t)M * 1024 * 4);
constexpr size_t O_H2 = O_Y + al64k((size_t)M * 1024 * 2);
constexpr size_t O_ACT = O_H2 + al64k((size_t)M * 1024 * 2);
constexpr size_t O_YS = O_ACT + al64k((size_t)ACT_ROWS * 1024 * 2);
constexpr size_t WS_END = O_YS + al64k((size_t)65536 * 1024 * 2);
static_assert(WS_END <= (size_t)1 << 30, "workspace map exceeds 1 GiB");
constexpr int CW_TMO = 0;
constexpr int CW_BAR = 4096;
constexpr int CW_CNT = 16384;
constexpr int CW_MODF = 20480;
constexpr int MOD_ITEMS = 192;

constexpr int RING_BYTES = 131072;
constexpr int XTRA_OFF = RING_BYTES, XTRA_BYTES = 16384;
constexpr int MISC_OFF = XTRA_OFF + XTRA_BYTES;
constexpr int LDS_BYTES = MISC_OFF + 256;
static_assert(LDS_BYTES <= 163840, "LDS");

DI float bf2f(bf16_t h) { return __uint_as_float((unsigned)h << 16); }
DI unsigned pk2(float lo, float hi) { f32x2 v = {lo, hi}; bf16x2_t b = __builtin_convertvector(v, bf16x2_t); return __builtin_bit_cast(unsigned, b); }
DI bf16_t f2bf(float f) { return (bf16_t)(pk2(f, 0.f) & 0xffffu); }
DI float bflo(unsigned w) { return __uint_as_float(w << 16); }
DI float bfhi(unsigned w) { return __uint_as_float(w & 0xffff0000u); }
DI float sigmoidf_(float x) { return 1.f / (1.f + __expf(-x)); }
DI float clamp8(float x) { return __builtin_amdgcn_fmed3f(x, -448.f, 448.f); }
DI unsigned pk4_fp8(float a, float b, float c, float d) { int w = 0; w = __builtin_amdgcn_cvt_pk_fp8_f32(clamp8(a), clamp8(b), w, false); w = __builtin_amdgcn_cvt_pk_fp8_f32(clamp8(c), clamp8(d), w, true); return (unsigned)w; }
constexpr float W8_SCALE = 32.f, ACT8_SCALE = 4.f, YS8_SCALE = 16.f, MIX8_SCALE = 4.f;
#define DPP_ADD(v, ctrl, rmask) ((v) + __builtin_bit_cast(float, __builtin_amdgcn_update_dpp(0, __builtin_bit_cast(int, (v)), (ctrl), (rmask), 0xf, true)))
DI float wave_sum_dpp(float v) {
    v = DPP_ADD(v, 0xB1, 0xf); v = DPP_ADD(v, 0x4E, 0xf); v = DPP_ADD(v, 0x141, 0xf); v = DPP_ADD(v, 0x140, 0xf);
    v = DPP_ADD(v, 0x142, 0xa); v = DPP_ADD(v, 0x143, 0xc);
    return __builtin_bit_cast(float, __builtin_amdgcn_readlane(__builtin_bit_cast(int, v), 63));
}
DI float max_nc(float a, float b) { float r; asm("v_max_f32_e32 %0, %1, %2" : "=v"(r) : "v"(a), "v"(b)); return r; }
DI float max3_nc(float a, float b, float c) { float r; asm("v_max3_f32 %0, %1, %2, %3" : "=v"(r) : "v"(a), "v"(b), "v"(c)); return r; }
DI float xmax16(float m) { const auto r = __builtin_amdgcn_permlane16_swap(__float_as_uint(m), __float_as_uint(m), false, false); return max_nc(__uint_as_float(r[0]), __uint_as_float(r[1])); }
DI float xmax32(float m) { const auto r = __builtin_amdgcn_permlane32_swap(__float_as_uint(m), __float_as_uint(m), false, false); return max_nc(__uint_as_float(r[0]), __uint_as_float(r[1])); }
DI float xadd16(float m) { const auto r = __builtin_amdgcn_permlane16_swap(__float_as_uint(m), __float_as_uint(m), false, false); return __uint_as_float(r[0]) + __uint_as_float(r[1]); }
DI float xadd32(float m) { const auto r = __builtin_amdgcn_permlane32_swap(__float_as_uint(m), __float_as_uint(m), false, false); return __uint_as_float(r[0]) + __uint_as_float(r[1]); }
#define LDS_WAIT() asm volatile("s_waitcnt lgkmcnt(0)" ::: "memory")
#define LDS_BAR() asm volatile("s_waitcnt lgkmcnt(0)\n\ts_barrier" ::: "memory")
#define VM_WAIT() asm volatile("s_waitcnt vmcnt(0)" ::: "memory")

#define XB_TMO      128
#define XB_XCNT(j)  (256  + 64 * (j))
#define XB_XSUB(j)  (1280 + 64 * (j))
#define XB_XGEN(j)  (2304 + 64 * (j))
#define XB_TOP      3328
#define XB_TOPGEN   3392
#define XCD_BAR_WORDS 3456
#define XB_SPIN_CAP (1u << 18)
DI unsigned xb_ld(unsigned* p)              { return __hip_atomic_load(p, __ATOMIC_RELAXED, __HIP_MEMORY_SCOPE_AGENT); }
DI unsigned xb_add(unsigned* p, unsigned v) { return __hip_atomic_fetch_add(p, v, __ATOMIC_RELAXED, __HIP_MEMORY_SCOPE_AGENT); }
DI unsigned xb_xcc_id() { return (unsigned)__builtin_amdgcn_s_getreg((3 << 11) | 20) & 0xFu; }
#define XB_SPIN(cond, bar) do { unsigned _sp = 0; while (cond) { __builtin_amdgcn_s_sleep(1); \
    if ((++_sp & 255u) == 0u) { if (xb_ld(&(bar)[XB_TMO])) break; if (_sp > XB_SPIN_CAP) { atomicAdd(&(bar)[XB_TMO], 1u); break; } } } } while (0)
struct XcdBarrier { unsigned* bar; unsigned x; volatile LAS unsigned* st; };
DI XcdBarrier xcd_barrier_post(unsigned* bar, volatile LAS unsigned* st) {
    XcdBarrier b; b.bar = bar; b.x = xb_xcc_id(); b.st = st;
    if (threadIdx.x == 0) (void)xb_add(&bar[XB_XCNT(b.x)], 1u);
    return b;
}
DI void xcd_barrier_complete(unsigned* bar, unsigned x, unsigned& nloc, unsigned& nx) {
    const unsigned G = gridDim.x * gridDim.y * gridDim.z;
    unsigned sum, cnt, mine, sp = 0u;
    for (;;) {
        sum = 0u; cnt = 0u; mine = 0u;
#pragma unroll
        for (unsigned j = 0; j < 16; ++j) { const unsigned c = xb_ld(&bar[XB_XCNT(j)]); sum += c; cnt += (c > 0u) ? 1u : 0u; mine = (j == x) ? c : mine; }
        if (sum == G) break;
        __builtin_amdgcn_s_sleep(1);
        if ((++sp & 255u) == 0u) { if (xb_ld(&bar[XB_TMO])) break; if (sp > XB_SPIN_CAP) { atomicAdd(&bar[XB_TMO], 1u); break; } }
    }
    nloc = mine > 0u ? mine : 1u; nx = cnt > 0u ? cnt : 1u;
}
DI void xcd_barrier(const XcdBarrier& b) {
    asm volatile("s_waitcnt vmcnt(0)" ::: "memory");
    __syncthreads();
    if (threadIdx.x == 0) {
        unsigned* bar = b.bar;
        __builtin_amdgcn_s_waitcnt(0);
        unsigned nloc = b.st[0], nx = b.st[1];
        if (nloc == 0u) { xcd_barrier_complete(bar, b.x, nloc, nx); b.st[0] = nloc; b.st[1] = nx; }
        const unsigned old = xb_add(&bar[XB_XSUB(b.x)], 1u);
        const unsigned gen = old / nloc;
        if (old + 1u == (gen + 1u) * nloc) {
            __builtin_amdgcn_fence(__ATOMIC_RELEASE, "agent");
            asm volatile("s_waitcnt vmcnt(0)" ::: "memory");
            const unsigned og = xb_add(&bar[XB_TOP], 1u);
            const unsigned tg = og / nx;
            if (og + 1u == (tg + 1u) * nx) xb_add(&bar[XB_TOPGEN], 1u);
            else XB_SPIN(xb_ld(&bar[XB_TOPGEN]) == tg, bar);
            __builtin_amdgcn_fence(__ATOMIC_ACQUIRE, "agent");
            xb_add(&bar[XB_XGEN(b.x)], 1u);
            asm volatile("s_waitcnt vmcnt(0)" ::: "memory");
        } else {
            XB_SPIN(xb_ld(&bar[XB_XGEN(b.x)]) == gen, bar);
            __builtin_amdgcn_fence(__ATOMIC_ACQUIRE, "agent");
            asm volatile("s_waitcnt vmcnt(0)" ::: "memory");
        }
    }
    __syncthreads();
}

namespace pg8 {
constexpr int BM = 256, BK = 64, HALF = 128, HTB = HALF * BK * 2, STAGE_BYTES = 8 * HTB, NXCD = 8, WGM = 8;
__host__ __device__ __forceinline__ int lds_byte(int r, int c) { const int st = (r >> 4) * 2 + (c >> 5), rr = r & 15, cc = c & 31, ob = rr * 64 + cc * 2; return st * 1024 + (ob ^ (((ob >> 9) & 1) << 5)); }
__host__ __device__ __forceinline__ void stage_rc(int b, int& R, int& C) { const int st = b / 1024, sb = b % 1024, swz = sb ^ (((sb >> 9) & 1) << 5); R = (st >> 1) * 16 + swz / 64; C = (st & 1) * 32 + (swz % 64) / 2; }
struct Unit { int pm, pn, e, tl, cnt; };
DI void tile_order(int L, int nM, int nN, int& pm, int& pn) {
    const int nwg = nM * nN; int wgid = L;
    { const int q = nwg / NXCD, r = nwg % NXCD, xcd = wgid % NXCD, off = wgid / NXCD; wgid = (xcd < r ? xcd * (q + 1) : r * (q + 1) + (xcd - r) * q) + off; }
    const int nig = WGM * nN, gid = wgid / nig, fm = gid * WGM, gsz = (nM - fm) < WGM ? (nM - fm) : WGM;
    pm = fm + ((wgid % nig) % gsz); pn = (wgid % nig) / gsz;
}
template <class Epi, class Sched, bool ALIGN_EPI, bool FP8 = false>
DI void gemm_phase(LAS unsigned char* lds, const int K, const Sched& S, const Epi& E) {
    const int tid = threadIdx.x, wid = __builtin_amdgcn_readfirstlane(tid >> 6), lane = tid & 63, wr = wid >> 2, wc = wid & 3, fr = lane & 15, fq = lane >> 4;
    const int rowb = FP8 ? K : 2 * K;
    const int nt = rowb / 128;
    int Rr[2], Cc[2]; unsigned voffB[2];
#pragma unroll
    for (int i = 0; i < 2; ++i) { int R, C; stage_rc(tid * 16 + i * 8192, R, C); Rr[i] = R; Cc[i] = C; voffB[i] = (unsigned)(R * rowb + C * 2); }
    const size_t kstep = (size_t)(BK * 2);
    const size_t hstep = (size_t)HALF * rowb;
    const unsigned ldsw = (unsigned)wid * 1024u;
    const int aoff = lds_byte(wr * 64 + fr, fq * 8), boff = lds_byte(wc * 32 + fr, fq * 8);
#define PG8_SA(b, h) (((b) * 2 + (h)) * HTB)
#define PG8_SB(b, h) ((4 + (b) * 2 + (h)) * HTB)
#define PG8_STAGE(bufoff, gbase, voff) do { _Pragma("unroll") for (int _i = 0; _i < 2; ++_i) \
        __builtin_amdgcn_global_load_lds((const unsigned*)((const char*)(gbase) + (voff)[_i]), (LAS unsigned*)(lds + (bufoff) + ldsw + _i * 8192), 16, 0, 0); } while (0)
#define PG8_LD2(base) __builtin_shufflevector(*(const LAS i32x4*)(base), *(const LAS i32x4*)((base) + 1024), 0, 1, 2, 3, 4, 5, 6, 7)
#define PG8_LDA(dst, b, h) do { if constexpr (FP8) { _Pragma("unroll") for (int m = 0; m < 4; ++m) dst##8[m] = PG8_LD2(lds + PG8_SA(b, h) + aoff + m * 2048); } \
        else { _Pragma("unroll") for (int m = 0; m < 4; ++m) _Pragma("unroll") for (int k = 0; k < 2; ++k) dst[m][k] = *(const LAS bf16x8*)(lds + PG8_SA(b, h) + aoff + m * 2048 + k * 1024); } } while (0)
#define PG8_LDB(dst, b, h) do { if constexpr (FP8) { _Pragma("unroll") for (int n = 0; n < 2; ++n) dst##8[n] = PG8_LD2(lds + PG8_SB(b, h) + boff + n * 2048); } \
        else { _Pragma("unroll") for (int n = 0; n < 2; ++n) _Pragma("unroll") for (int k = 0; k < 2; ++k) dst[n][k] = *(const LAS bf16x8*)(lds + PG8_SB(b, h) + boff + n * 2048 + k * 1024); } } while (0)
#define PG8_CAT(x) __builtin_shufflevector(__builtin_bit_cast(i32x4, (x)[0]), __builtin_bit_cast(i32x4, (x)[1]), 0, 1, 2, 3, 4, 5, 6, 7)
#define PG8_MMA(ai, bj, At, Bt) do { __builtin_amdgcn_s_setprio(1); \
        if constexpr (FP8) { _Pragma("unroll") for (int m = 0; m < 4; ++m) _Pragma("unroll") for (int n = 0; n < 2; ++n) \
            asm volatile("v_mfma_scale_f32_16x16x128_f8f6f4 %0, %1, %2, %0, %3, %3 op_sel_hi:[0,0,0]" : "+v"(acc[ai][bj][m][n]) : "v"(Bt##8[n]), "v"(At##8[m]), "v"(sc8)); } \
        else { _Pragma("unroll") for (int m = 0; m < 4; ++m) _Pragma("unroll") for (int n = 0; n < 2; ++n) _Pragma("unroll") for (int k = 0; k < 2; ++k) \
            acc[ai][bj][m][n] = __builtin_amdgcn_mfma_f32_16x16x32_bf16(Bt[n][k], At[m][k], acc[ai][bj][m][n], 0, 0, 0); } \
        __builtin_amdgcn_s_setprio(0); } while (0)
#define PG8_WAIT_V(n) asm volatile("s_waitcnt vmcnt(" #n ")" ::: "memory")
#define PG8_WAIT_L(n) asm volatile("s_waitcnt lgkmcnt(" #n ")" ::: "memory")
#define PG8_WAIT_VX() do { if constexpr (Epi::RELAX == 8) { if (t == 0 && relax) PG8_WAIT_V(16); else PG8_WAIT_V(8); } else PG8_WAIT_V(8); } while (0)
#define PG8_BAR __builtin_amdgcn_s_barrier()
#define PG8_SCHED __builtin_amdgcn_sched_barrier(0)
    Unit cur, nxt; int ui = 0, relax = 0;
    if (!S.next(0, cur)) return;
    f32x4 acc[2][2][4][2];
#pragma unroll
    for (int a = 0; a < 2; ++a)
#pragma unroll
        for (int b = 0; b < 2; ++b)
#pragma unroll
            for (int m = 0; m < 4; ++m)
#pragma unroll
                for (int n = 0; n < 2; ++n) acc[a][b][m][n] = (f32x4){0.f, 0.f, 0.f, 0.f};
    const int sc8 = 0x7f7f7f7f;
    bf16x8 At[4][2], B0[2][2], B1[2][2]; i32x8 At8[4], B08[2], B18[2];
    unsigned oc0[2], oc1[2], on0[2], on1[2];
    S.a_offs(cur, Rr, Cc, rowb, oc0, oc1);
    const char* cA = S.a_base(cur); const char* cB = S.b_base(cur);
    PG8_STAGE(PG8_SB(0, 0), cB, voffB); PG8_STAGE(PG8_SB(0, 1), cB + hstep, voffB); PG8_STAGE(PG8_SA(0, 0), cA, oc0); PG8_STAGE(PG8_SA(0, 1), cA, oc1);
    if (wr == 1) PG8_BAR;
    PG8_WAIT_V(2); PG8_BAR;
    PG8_STAGE(PG8_SB(1, 0), cB + kstep, voffB); PG8_STAGE(PG8_SA(1, 0), cA + kstep, oc0); PG8_STAGE(PG8_SB(1, 1), cB + hstep + kstep, voffB);
    PG8_WAIT_V(6); PG8_BAR;
    for (;;) {
        const bool has_next = S.next(ui + 1, nxt);
        const char* nA = cA; const char* nB = cB;
        on0[0] = oc0[0]; on0[1] = oc0[1]; on1[0] = oc1[0]; on1[1] = oc1[1];
        if (has_next) { nA = S.a_base(nxt); nB = S.b_base(nxt); S.a_offs(nxt, Rr, Cc, rowb, on0, on1); }
        for (int t = 0; t < nt; t += 2) {
            if constexpr (Epi::MIDK != 0) { if (t == Epi::MIDK) E.mid(acc, cur, wr, wc, fr, fq); }
            const bool last = (t == nt - 2);
            const char* a1 = cA + (size_t)(t + 1) * kstep;
            const char* a2 = last ? nA : cA + (size_t)(t + 2) * kstep; const char* b2 = last ? nB : cB + (size_t)(t + 2) * kstep;
            const char* a3 = a2 + kstep; const char* b3 = b2 + kstep;
            PG8_LDB(B0, 0, 0); PG8_LDB(B1, 0, 1); PG8_SCHED; PG8_LDA(At, 0, 0); PG8_STAGE(PG8_SA(1, 1), a1, oc1);
            PG8_WAIT_VX(); PG8_WAIT_L(0); PG8_BAR; PG8_MMA(0, 0, At, B0); PG8_MMA(0, 1, At, B1); PG8_BAR; PG8_SCHED;
            PG8_LDA(At, 0, 1); PG8_STAGE(PG8_SB(0, 0), b2, voffB); PG8_STAGE(PG8_SB(0, 1), b2 + hstep, voffB); if (last) { PG8_STAGE(PG8_SA(0, 0), a2, on0); } else { PG8_STAGE(PG8_SA(0, 0), a2, oc0); }
            PG8_WAIT_VX(); PG8_WAIT_L(0); PG8_BAR; PG8_MMA(1, 0, At, B0); PG8_MMA(1, 1, At, B1); PG8_BAR; PG8_SCHED;
            PG8_LDB(B0, 1, 0); PG8_LDB(B1, 1, 1); PG8_SCHED; PG8_LDA(At, 1, 0); if (last) { PG8_STAGE(PG8_SA(0, 1), a2, on1); } else { PG8_STAGE(PG8_SA(0, 1), a2, oc1); }
            PG8_WAIT_V(8); PG8_WAIT_L(0); PG8_BAR; PG8_MMA(0, 0, At, B0); PG8_MMA(0, 1, At, B1); PG8_BAR; PG8_SCHED;
            PG8_LDA(At, 1, 1); PG8_STAGE(PG8_SB(1, 0), b3, voffB); PG8_STAGE(PG8_SB(1, 1), b3 + hstep, voffB); if (last) { PG8_STAGE(PG8_SA(1, 0), a3, on0); } else { PG8_STAGE(PG8_SA(1, 0), a3, oc0); }
            PG8_WAIT_V(8); PG8_WAIT_L(0); PG8_BAR; PG8_MMA(1, 0, At, B0); PG8_MMA(1, 1, At, B1); PG8_BAR; PG8_SCHED;
        }
        if constexpr (ALIGN_EPI) { if (wr == 0) PG8_BAR; }
        if constexpr (FP8) asm volatile("s_nop 15\n\ts_nop 15" ::: "memory");
        E(acc, cur, wr, wc, fr, fq); relax = 1;
        if (!has_next) break;
#pragma unroll
        for (int a = 0; a < 2; ++a)
#pragma unroll
            for (int b = 0; b < 2; ++b)
#pragma unroll
                for (int m = 0; m < 4; ++m)
#pragma unroll
                    for (int n = 0; n < 2; ++n) acc[a][b][m][n] = (f32x4){0.f, 0.f, 0.f, 0.f};
        cur = nxt; cA = nA; cB = nB; ++ui;
        oc0[0] = on0[0]; oc0[1] = on0[1]; oc1[0] = on1[0]; oc1[1] = on1[1];
        if constexpr (ALIGN_EPI) { if (wr == 1) PG8_BAR; }
    }
    PG8_WAIT_V(0);
    if constexpr (!ALIGN_EPI) { if (wr == 0) PG8_BAR; }
    PG8_BAR;
#undef PG8_SA
#undef PG8_SB
#undef PG8_STAGE
#undef PG8_LDA
#undef PG8_LDB
#undef PG8_MMA
#undef PG8_CAT
#undef PG8_LD2
#undef PG8_WAIT_V
#undef PG8_WAIT_L
#undef PG8_WAIT_VX
#undef PG8_BAR
#undef PG8_SCHED
}
}
using pg8::Unit;

DI int slot_std8(int L) { return (L & 0xE0) | (((L >> 2) & 1) << 4) | (((L >> 3) & 3) << 2) | (L & 3); }
DI int slot_head(int hh, int d) { return 128 * (d >> 5) + 32 * hh + (d & 31); }

struct SchedBase {
    DI void offs_plain(const int (&Rr)[2], const int (&Cc)[2], int rowb, unsigned (&o0)[2], unsigned (&o1)[2]) const {
#pragma unroll
        for (int i = 0; i < 2; ++i) { o0[i] = (unsigned)(Rr[i] * rowb + Cc[i] * 2); o1[i] = (unsigned)((Rr[i] + 128) * rowb + Cc[i] * 2); }
    }
};
struct InProjSched : SchedBase {
    int G, c; const char* A; const char* Bt;
    DI bool next(int i, Unit& u) const {
        const int L = i * G + c; if (L >= 752) return false;
        if (L < 704) pg8::tile_order(L, 64, 11, u.pm, u.pn); else { const int L2 = L - 704; u.pm = 64 + (L2 & 7); u.pn = 2 + (L2 >> 3); }
        u.e = 0; u.tl = 0; u.cnt = 0; return true;
    }
    DI const char* a_base(const Unit& u) const { return A + (size_t)u.pm * (256 * 1024 * 2); }
    DI const char* b_base(const Unit& u) const { return Bt + (size_t)u.pn * (256 * 1024 * 2); }
    DI void a_offs(const Unit&, const int (&Rr)[2], const int (&Cc)[2], int rowb, unsigned (&o0)[2], unsigned (&o1)[2]) const { offs_plain(Rr, Cc, rowb, o0, o1); }
};
struct PlainSched : SchedBase {
    int G, c, nM, nN, K, eb; const char* A; const char* Bt;
    DI bool next(int i, Unit& u) const {
        const int L = i * G + c; if (L >= nM * nN) return false;
        pg8::tile_order(L, nM, nN, u.pm, u.pn); u.e = 0; u.tl = 0; u.cnt = 0; return true;
    }
    DI const char* a_base(const Unit& u) const { return A + (size_t)u.pm * 256 * K * eb; }
    DI const char* b_base(const Unit& u) const { return Bt + (size_t)u.pn * 256 * K * eb; }
    DI void a_offs(const Unit&, const int (&Rr)[2], const int (&Cc)[2], int rowb, unsigned (&o0)[2], unsigned (&o1)[2]) const { offs_plain(Rr, Cc, rowb, o0, o1); }
};
template <bool GATHER, int LOGNPN>
struct MoeSched : SchedBase {
    int G, cv; const LAS int* TT; const char* A; const char* Bt; size_t b_estride; const int* LIST;
    DI bool next(int i, Unit& u) const {
        const int ntl = __builtin_amdgcn_readfirstlane(TT[0]);
        const int per = (G & 7) ? G : (G >> 3), xq = cv / per, rr = cv - xq * per, T8 = (G & 7) ? ntl : ((ntl + 7) >> 3);
        const int ux = i * per + rr, tt = xq * T8 + (ux >> LOGNPN);
        if ((ux >> LOGNPN) >= T8 || tt >= ntl) return false;
        const int ent = __builtin_amdgcn_readfirstlane(TT[64 + tt]);
        u.pm = tt; u.pn = ux & ((1 << LOGNPN) - 1); u.e = ent & 255; u.tl = ent >> 8; u.cnt = __builtin_amdgcn_readfirstlane(TT[1 + u.e]); return true;
    }
    DI const char* a_base(const Unit& u) const { return GATHER ? A : A + (size_t)u.pm * (256 * 1024); }
    DI const char* b_base(const Unit& u) const { return Bt + (size_t)u.e * b_estride + (size_t)u.pn * (256 * 1024); }
    DI void a_offs(const Unit& u, const int (&Rr)[2], const int (&Cc)[2], int rowb, unsigned (&o0)[2], unsigned (&o1)[2]) const {
        if constexpr (!GATHER) { offs_plain(Rr, Cc, rowb, o0, o1); }
        else {
#pragma unroll
            for (int i = 0; i < 2; ++i) {
                const int p0 = 256 * u.tl + Rr[i], p1 = p0 + 128;
                const int s0 = (p0 < u.cnt) ? LIST[u.e * LISTCAP + p0] : 0, s1 = (p1 < u.cnt) ? LIST[u.e * LISTCAP + p1] : 0;
                o0[i] = (unsigned)((s0 >> 2) * rowb + Cc[i] * 2); o1[i] = (unsigned)((s1 >> 2) * rowb + Cc[i] * 2);
            }
        }
    }
};

typedef const f32x4 (&AccRef)[2][2][4][2];
DI void st8bf(bf16_t* p, f32x4 a, f32x4 b) { u32x4 w; w.x = pk2(a.x, a.y); w.y = pk2(a.z, a.w); w.z = pk2(b.x, b.y); w.w = pk2(b.z, b.w); *(u32x4*)p = w; }
DI void st4bf(bf16_t* p, f32x4 a) { u32x2 w; w.x = pk2(a.x, a.y); w.y = pk2(a.z, a.w); *(u32x2*)p = w; }
DI f32x2 sig2(f32x2 x) { const f32x2 t = x * (-LOG2E); f32x2 e; e.x = __builtin_amdgcn_exp2f(t.x); e.y = __builtin_amdgcn_exp2f(t.y); const f32x2 d = e + 1.0f; f32x2 r; r.x = __builtin_amdgcn_rcpf(d.x); r.y = __builtin_amdgcn_rcpf(d.y); return r; }
DI f32x4 sig4p(f32x4 v) { const f32x2 a = sig2((f32x2){v.x, v.y}), b = sig2((f32x2){v.z, v.w}); return (f32x4){a.x, a.y, b.x, b.y}; }
DI f32x4 silu4p(f32x4 v) { return v * sig4p(v); }
DI float logsig16(float z) { return (fminf(z, 0.f) - __logf(1.f + __expf(-fabsf(z)))) * 0.0625f; }

struct EpiInProj {
    static constexpr int MIDK = 0, RELAX = 0;
    bf16_t *Q, *Kb, *Vb, *GQ, *GK, *GV, *GR, *GA, *GG, *LAF, *LAB;
    const float *qn, *kn, *baf, *bab, *ropec, *ropes;
    DI void operator()(AccRef acc, const Unit& u, int wr, int wc, int fr, int fq) const {
        const int pn = u.pn, rowb = u.pm * 256 + wr * 64 + fr;
        if (pn <= 2) {
            const bool isV = (pn == 2 && wc >= 2), isK = (pn == 2 && wc < 2);
            const bool rope = (u.pm < 64) && !isV;
            const float* g = isK ? kn : qn;
            f32x4 gv[2][2];
#pragma unroll
            for (int bj = 0; bj < 2; ++bj)
#pragma unroll
                for (int n = 0; n < 2; ++n) gv[bj][n] = *(const f32x4*)(g + 32 * bj + 16 * n + 4 * fq);
            bf16_t* outp; int ld, colb;
            if (pn < 2) { outp = Q; ld = 512; colb = (4 * pn + wc) * 64; } else if (isK) { outp = Kb; ld = 128; colb = wc * 64; } else { outp = Vb; ld = 128; colb = (wc - 2) * 64; }
            const float osc = (pn < 2) ? QSCALE : 1.f;
#pragma unroll
            for (int ai = 0; ai < 2; ++ai)
#pragma unroll
                for (int m = 0; m < 4; ++m) {
                    const int r = rowb + ai * 128 + m * 16;
                    f32x4 v[2][2];
#pragma unroll
                    for (int bj = 0; bj < 2; ++bj)
#pragma unroll
                        for (int n = 0; n < 2; ++n) v[bj][n] = acc[ai][bj][m][n];
                    if (!isV) {
                        float ss = 0.f;
#pragma unroll
                        for (int bj = 0; bj < 2; ++bj)
#pragma unroll
                            for (int n = 0; n < 2; ++n) ss += (v[bj][n].x * v[bj][n].x + v[bj][n].y * v[bj][n].y) + (v[bj][n].z * v[bj][n].z + v[bj][n].w * v[bj][n].w);
                        ss = xadd32(xadd16(ss));
                        const float rstd = __builtin_amdgcn_rsqf(ss * (1.f / 64.f) + EPS);
#pragma unroll
                        for (int bj = 0; bj < 2; ++bj)
#pragma unroll
                            for (int n = 0; n < 2; ++n) v[bj][n] = v[bj][n] * rstd * gv[bj][n];
                        if (rope) {
                            const int t = r & (T - 1);
#pragma unroll
                            for (int bj = 0; bj < 2; ++bj) {
                                const int pos = bj ? (t & 63) : (t >> 6);
                                const f32x4 cs = *(const f32x4*)(ropec + pos * 16 + 4 * fq), sn = *(const f32x4*)(ropes + pos * 16 + 4 * fq);
                                const f32x4 x1 = v[bj][0], x2 = v[bj][1];
                                v[bj][0] = x1 * cs - x2 * sn; v[bj][1] = x2 * cs + x1 * sn;
                            }
                        }
#pragma unroll
                        for (int bj = 0; bj < 2; ++bj)
#pragma unroll
                            for (int n = 0; n < 2; ++n) v[bj][n] = v[bj][n] * osc;
                    }
                    bf16_t* rp = outp + (size_t)r * ld + colb + 4 * fq;
#pragma unroll
                    for (int bj = 0; bj < 2; ++bj)
#pragma unroll
                        for (int n = 0; n < 2; ++n) st4bf(rp + 32 * bj + 16 * n, v[bj][n]);
                }
            return;
        }
        const int lcol = 32 * wc + 8 * fq;
        if (pn == 6 || pn == 7) {
            bf16_t* outp = (pn == 6) ? LAF : LAB; const float* bb = (pn == 6) ? baf : bab;
            f32x4 bv[2][2];
#pragma unroll
            for (int bj = 0; bj < 2; ++bj)
#pragma unroll
                for (int n = 0; n < 2; ++n) bv[bj][n] = *(const f32x4*)(bb + 128 * bj + lcol + 4 * n);
#pragma unroll
            for (int ai = 0; ai < 2; ++ai)
#pragma unroll
                for (int m = 0; m < 4; ++m) {
                    const int r = rowb + ai * 128 + m * 16;
#pragma unroll
                    for (int bj = 0; bj < 2; ++bj) {
                        const f32x4 z0 = acc[ai][bj][m][0] + bv[bj][0], z1 = acc[ai][bj][m][1] + bv[bj][1];
                        st8bf(outp + (size_t)r * 256 + 128 * bj + lcol, (f32x4){logsig16(z0.x), logsig16(z0.y), logsig16(z0.z), logsig16(z0.w)}, (f32x4){logsig16(z1.x), logsig16(z1.y), logsig16(z1.z), logsig16(z1.w)});
                    }
                }
            return;
        }
        bf16_t* outp; int ld, colb, mode;
        if (pn == 3) { outp = GK; ld = 256; colb = 0; mode = 0; }
        else if (pn <= 5) { outp = GV; ld = 512; colb = 256 * (pn - 4); mode = 0; }
        else if (pn == 8) { outp = GQ; ld = 256; colb = 0; mode = 1; }
        else if (pn <= 10) { outp = GR; ld = 512; colb = 256 * (pn - 9); mode = 2; }
        else if (pn <= 14) { outp = GA; ld = 1024; colb = 256 * (pn - 11); mode = 3; }
        else { outp = GG; ld = 1024; colb = 256 * (pn - 15); mode = 3; }
#pragma unroll
        for (int ai = 0; ai < 2; ++ai)
#pragma unroll
            for (int m = 0; m < 4; ++m) {
                const int r = rowb + ai * 128 + m * 16;
#pragma unroll
                for (int bj = 0; bj < 2; ++bj) {
                    f32x4 a = acc[ai][bj][m][0], b = acc[ai][bj][m][1];
                    if (mode == 1) { a = a * 0.125f; b = b * 0.125f; }
                    else if (mode == 2) { a = silu4p(a); b = silu4p(b); }
                    else if (mode == 3) { a = sig4p(a); b = sig4p(b); }
                    st8bf(outp + (size_t)r * ld + colb + 128 * bj + lcol, a, b);
                }
            }
    }
};

struct EpiGates {
    static constexpr int MIDK = 0, RELAX = 0;
    bf16_t *GA, *GG;
    DI void operator()(AccRef acc, const Unit& u, int wr, int wc, int fr, int fq) const {
        const int rowb = u.pm * 256 + wr * 64 + fr, lcol = 32 * wc + 8 * fq;
        bf16_t* outp = (u.pn < 4 ? GA : GG) + 256 * (u.pn & 3);
#pragma unroll
        for (int ai = 0; ai < 2; ++ai)
#pragma unroll
            for (int m = 0; m < 4; ++m) {
                const int r = rowb + ai * 128 + m * 16;
#pragma unroll
                for (int bj = 0; bj < 2; ++bj)
                    st8bf(outp + (size_t)r * 1024 + 128 * bj + lcol, sig4p(acc[ai][bj][m][0] * (1.f / W8_SCALE)), sig4p(acc[ai][bj][m][1] * (1.f / W8_SCALE)));
            }
    }
};

struct EpiMerge1 {
    static constexpr int MIDK = 4, RELAX = 0;
    const bf16_t *GA, *GG; unsigned char* Y;
    DI void mid(f32x4 (&acc)[2][2][4][2], const Unit& u, int wr, int wc, int fr, int fq) const {
        unsigned z; asm volatile("v_mov_b32 %0, 0" : "=v"(z));
        const unsigned base = (unsigned)((u.pm * 256 + wr * 64 + fr) * 1024 + u.pn * 256 + 32 * wc + 8 * fq) * 2u + z;
#pragma unroll
        for (int ai = 0; ai < 2; ++ai)
#pragma unroll
            for (int m = 0; m < 4; ++m) {
#pragma unroll
                for (int bj = 0; bj < 2; ++bj) {
                    const unsigned off = base + (unsigned)((ai * 128 + m * 16) * 1024 + 128 * bj) * 2u;
                    const u32x4 aw = *(const u32x4*)((const char*)GA + off), gw = *(const u32x4*)((const char*)GG + off);
                    const f32x4 a0 = {bflo(aw.x), bfhi(aw.x), bflo(aw.y), bfhi(aw.y)}, a1 = {bflo(aw.z), bfhi(aw.z), bflo(aw.w), bfhi(aw.w)};
                    const f32x4 g0 = {bflo(gw.x), bfhi(gw.x), bflo(gw.y), bfhi(gw.y)}, g1 = {bflo(gw.z), bfhi(gw.z), bflo(gw.w), bfhi(gw.w)};
#pragma unroll
                    for (int e = 0; e < 4; ++e) { acc[ai][bj][m][0][e] *= a0[e] * __builtin_amdgcn_rcpf(fmaxf(g0[e], 1e-30f)); acc[ai][bj][m][1][e] *= a1[e] * __builtin_amdgcn_rcpf(fmaxf(g1[e], 1e-30f)); }
                }
                asm volatile("" ::: "memory");
            }
    }
    DI void operator()(AccRef acc, const Unit& u, int wr, int wc, int fr, int fq) const {
        const int rowb = u.pm * 256 + wr * 64 + fr, colb = u.pn * 256 + 32 * wc + 8 * fq;
#pragma unroll
        for (int ai = 0; ai < 2; ++ai)
#pragma unroll
            for (int m = 0; m < 4; ++m) {
                const int r = rowb + ai * 128 + m * 16;
#pragma unroll
                for (int bj = 0; bj < 2; ++bj) {
                    const size_t off = (size_t)r * 1024 + colb + 128 * bj;
                    const u32x4 gw = *(const u32x4*)(GG + off);
                    const f32x4 g0 = {bflo(gw.x), bfhi(gw.x), bflo(gw.y), bfhi(gw.y)}, g1 = {bflo(gw.z), bfhi(gw.z), bflo(gw.w), bfhi(gw.w)};
                    { const f32x4 a = acc[ai][bj][m][0] * g0 * (MIX8_SCALE / (W8_SCALE * MIX8_SCALE)), b = acc[ai][bj][m][1] * g1 * (MIX8_SCALE / (W8_SCALE * MIX8_SCALE));
                      u32x2 w; w.x = pk4_fp8(a.x, a.y, a.z, a.w); w.y = pk4_fp8(b.x, b.y, b.z, b.w); *(u32x2*)(Y + off) = w; }
                }
            }
    }
};

struct EpiMerge2 {
    static constexpr int MIDK = 0, RELAX = 0;
    const float* x; const float* MOD; bf16_t* X1;
    DI void operator()(AccRef acc, const Unit& u, int wr, int wc, int fr, int fq) const {
        const int rowb = u.pm * 256 + wr * 64 + fr, colb = u.pn * 256 + 32 * wc + 8 * fq;
        const int b = (u.pm * 256) >> 11;
        f32x4 gt[2][2];
#pragma unroll
        for (int bj = 0; bj < 2; ++bj)
#pragma unroll
            for (int n = 0; n < 2; ++n) gt[bj][n] = *(const f32x4*)(MOD + b * 6144 + 2048 + colb + 128 * bj + 4 * n);
#pragma unroll
        for (int ai = 0; ai < 2; ++ai)
#pragma unroll
            for (int m = 0; m < 4; ++m) {
                const int r = rowb + ai * 128 + m * 16;
#pragma unroll
                for (int bj = 0; bj < 2; ++bj) {
                    const size_t off = (size_t)r * 1024 + colb + 128 * bj;
                    const f32x4 x0 = *(const f32x4*)(x + off), x1 = *(const f32x4*)(x + off + 4);
                    st8bf(X1 + off, x0 + gt[bj][0] * acc[ai][bj][m][0] * (1.f / (W8_SCALE * MIX8_SCALE)), x1 + gt[bj][1] * acc[ai][bj][m][1] * (1.f / (W8_SCALE * MIX8_SCALE)));
                }
            }
    }
};

struct EpiMoe1 {
    static constexpr int MIDK = 0, RELAX = 8;
    const float* b1; unsigned char* ACT;
    DI void operator()(AccRef acc, const Unit& u, int wr, int wc, int fr, int fq) const {
        const int rowb = u.pm * 256 + wr * 64 + fr, f0 = 128 * u.pn + 32 * wc + 8 * fq;
        f32x4 bg[2], bu[2];
#pragma unroll
        for (int n = 0; n < 2; ++n) { bg[n] = *(const f32x4*)(b1 + (size_t)u.e * 2048 + f0 + 4 * n); bu[n] = *(const f32x4*)(b1 + (size_t)u.e * 2048 + 1024 + f0 + 4 * n); }
#pragma unroll
        for (int ai = 0; ai < 2; ++ai)
#pragma unroll
            for (int m = 0; m < 4; ++m) {
                const int r = rowb + ai * 128 + m * 16;
                f32x4 o[2];
#pragma unroll
                for (int n = 0; n < 2; ++n) {
                    const f32x4 gt = acc[ai][0][m][n] * (1.f / W8_SCALE) + bg[n], up = acc[ai][1][m][n] * (1.f / W8_SCALE) + bu[n];
#pragma unroll
                    for (int hh = 0; hh < 2; ++hh) {
                        const f32x2 g = __builtin_elementwise_min((f32x2){gt[2 * hh], gt[2 * hh + 1]}, (f32x2){7.f, 7.f});
                        const f32x2 uu = __builtin_elementwise_min(__builtin_elementwise_max((f32x2){up[2 * hh], up[2 * hh + 1]}, (f32x2){-7.f, -7.f}), (f32x2){7.f, 7.f});
                        const f32x2 r = (g * sig2(g * 1.702f)) * (uu * ACT8_SCALE + ACT8_SCALE);
                        o[n][2 * hh] = r.x; o[n][2 * hh + 1] = r.y;
                    }
                }
                u32x2 w;
                { int w0 = 0, w1 = 0; w0 = __builtin_amdgcn_cvt_pk_fp8_f32(o[0].x, o[0].y, w0, false); w0 = __builtin_amdgcn_cvt_pk_fp8_f32(o[0].z, o[0].w, w0, true);
                  w1 = __builtin_amdgcn_cvt_pk_fp8_f32(o[1].x, o[1].y, w1, false); w1 = __builtin_amdgcn_cvt_pk_fp8_f32(o[1].z, o[1].w, w1, true); w.x = (unsigned)w0; w.y = (unsigned)w1; }
                *(u32x2*)(ACT + (size_t)r * 1024 + f0) = w;
            }
    }
};

struct EpiMoe2 {
    static constexpr int MIDK = 0, RELAX = 0;
    const float* b2; const int* LIST; const float* WL; unsigned char* YS;
    DI void operator()(AccRef acc, const Unit& u, int wr, int wc, int fr, int fq) const {
        const int colb = u.pn * 256 + 64 * wc + 16 * fq;
        f32x4 bv[2][2];
#pragma unroll
        for (int bj = 0; bj < 2; ++bj)
#pragma unroll
            for (int n = 0; n < 2; ++n) bv[bj][n] = *(const f32x4*)(b2 + (size_t)u.e * 1024 + colb + 8 * bj + 4 * n);
        constexpr float SC = 1.f / (W8_SCALE * ACT8_SCALE);
#pragma unroll
        for (int ai = 0; ai < 2; ++ai) {
            int slot[4]; float wgt[4];
#pragma unroll
            for (int m = 0; m < 4; ++m) { const int p = 256 * u.tl + ai * 128 + wr * 64 + m * 16 + fr; const bool ok = p < u.cnt;
                slot[m] = ok ? LIST[u.e * LISTCAP + p] : -1; wgt[m] = ok ? WL[u.e * LISTCAP + p] * YS8_SCALE : 0.f; }
#pragma unroll
            for (int m = 0; m < 4; ++m) {
                if (slot[m] >= 0) {
                    const float w = wgt[m];
                    u32x4 o;
                    { const f32x4 a = (acc[ai][0][m][0] * SC + bv[0][0]) * w, b = (acc[ai][0][m][1] * SC + bv[0][1]) * w, c = (acc[ai][1][m][0] * SC + bv[1][0]) * w, d = (acc[ai][1][m][1] * SC + bv[1][1]) * w;
                      o.x = pk4_fp8(a.x, a.y, a.z, a.w); o.y = pk4_fp8(b.x, b.y, b.z, b.w); o.z = pk4_fp8(c.x, c.y, c.z, c.w); o.w = pk4_fp8(d.x, d.y, d.z, d.w); }
                    *(u32x4*)(YS + (size_t)slot[m] * 1024 + colb) = o;
                }
            }
        }
    }
};

constexpr int ATT_KS = 72;
constexpr int ATT_BUF = 2 * 64 * ATT_KS * 2;
DI void attn_unit(int b, int kvh, int qb, const bf16_t* Qb, const bf16_t* Kb, const bf16_t* Vb, bf16_t* AO, const float* attn_sink, LAS unsigned char* lds, int tid, int lane, int wave) {
    const int g = lane >> 4, l15 = lane & 15, hq = wave >> 1, xh = wave & 1, h = kvh * 4 + hq;
    const int q0 = qb * 128, qw0 = q0 + xh * 64;
    bf16x8 qf[4][2];
#pragma unroll
    for (int qg = 0; qg < 4; ++qg)
#pragma unroll
        for (int ks = 0; ks < 2; ++ks) qf[qg][ks] = *(const bf16x8*)(Qb + (size_t)(b * T + qw0 + 16 * qg + l15) * 512 + h * 64 + 32 * ks + 8 * g);
    const float sink2 = attn_sink[h] * LOG2E;
    float mrow[4], lrow[4]; f32x4 o[4][4];
#pragma unroll
    for (int qg = 0; qg < 4; ++qg) { mrow[qg] = sink2; lrow[qg] = (g == 0) ? 1.f : 0.f;
#pragma unroll
        for (int dt = 0; dt < 4; ++dt) o[dt][qg] = (f32x4){0.f, 0.f, 0.f, 0.f}; }
    const int jlo = (qb == 0) ? 2 : 0, jhi = (qb == 15) ? 3 : 5, nloc = jhi - jlo + 1, ntile = nloc + 4;
    const int srow = tid & 63, sch = tid >> 6;
    u32x4 kreg, vreg;
#define ATT_ROW0(s) (((s) < nloc) ? (b * T + q0 - 128 + 64 * (jlo + (s))) : (M + b * LC + 64 * ((s) - nloc)))
#define ATT_LOAD(s) do { const size_t _o = (size_t)(ATT_ROW0(s) + srow) * 128 + kvh * 64 + 8 * sch; kreg = *(const u32x4*)(Kb + _o); vreg = *(const u32x4*)(Vb + _o); } while (0)
#define ATT_WRITE(buf) do { LAS bf16_t* _k = (LAS bf16_t*)(lds + (buf) * ATT_BUF); LAS bf16_t* _v = _k + 64 * ATT_KS; \
        *(LAS u32x4*)(_k + srow * ATT_KS + 8 * sch) = kreg; \
        _v[(8 * sch + 0) * ATT_KS + srow] = (bf16_t)(vreg.x & 0xffffu); _v[(8 * sch + 1) * ATT_KS + srow] = (bf16_t)(vreg.x >> 16); \
        _v[(8 * sch + 2) * ATT_KS + srow] = (bf16_t)(vreg.y & 0xffffu); _v[(8 * sch + 3) * ATT_KS + srow] = (bf16_t)(vreg.y >> 16); \
        _v[(8 * sch + 4) * ATT_KS + srow] = (bf16_t)(vreg.z & 0xffffu); _v[(8 * sch + 5) * ATT_KS + srow] = (bf16_t)(vreg.z >> 16); \
        _v[(8 * sch + 6) * ATT_KS + srow] = (bf16_t)(vreg.w & 0xffffu); _v[(8 * sch + 7) * ATT_KS + srow] = (bf16_t)(vreg.w >> 16); } while (0)
    ATT_LOAD(0); ATT_WRITE(0);
    LDS_BAR();
    for (int s = 0; s < ntile; ++s) {
        if (s + 1 < ntile) ATT_LOAD(s + 1);
        const bool isloc = s < nloc; const int j = jlo + s;
        const bool need = !isloc || (xh == 0 ? (j <= 4) : (j >= 1));
        if (need) {
            const bool partial = isloc && (xh == 0 ? (j == 0 || j == 4) : (j == 1 || j == 5));
            const LAS bf16_t* Kt = (const LAS bf16_t*)(lds + (s & 1) * ATT_BUF); const LAS bf16_t* Vt = Kt + 64 * ATT_KS;
            f32x4 sc[4][4];
#pragma unroll
            for (int kt = 0; kt < 4; ++kt) {
                const bf16x8 k0 = *(const LAS bf16x8*)(Kt + (16 * kt + l15) * ATT_KS + 8 * g), k1 = *(const LAS bf16x8*)(Kt + (16 * kt + l15) * ATT_KS + 32 + 8 * g);
#pragma unroll
                for (int qg = 0; qg < 4; ++qg) {
                    f32x4 a = __builtin_amdgcn_mfma_f32_16x16x32_bf16(k0, qf[qg][0], (f32x4){0.f, 0.f, 0.f, 0.f}, 0, 0, 0);
                    sc[kt][qg] = __builtin_amdgcn_mfma_f32_16x16x32_bf16(k1, qf[qg][1], a, 0, 0, 0);
                }
            }
            asm volatile("s_nop 15" : "+v"(sc[3][0]), "+v"(sc[3][1]), "+v"(sc[3][2]), "+v"(sc[3][3]));
            if (partial) {
                const int kb = q0 - 128 + 64 * j;
#pragma unroll
                for (int kt = 0; kt < 4; ++kt)
#pragma unroll
                    for (int qg = 0; qg < 4; ++qg)
#pragma unroll
                        for (int r = 0; r < 4; ++r) { const int dk = (kb + 16 * kt + 4 * g + r) - (qw0 + 16 * qg + l15); if (dk > 128 || dk < -128) sc[kt][qg][r] = -INFINITY; }
            }
            bf16x8 pf[4][2];
#pragma unroll
            for (int qg = 0; qg < 4; ++qg) {
                float mx = max3_nc(sc[0][qg][0], sc[0][qg][1], sc[0][qg][2]);
                mx = max3_nc(mx, sc[0][qg][3], sc[1][qg][0]); mx = max3_nc(mx, sc[1][qg][1], sc[1][qg][2]); mx = max3_nc(mx, sc[1][qg][3], sc[2][qg][0]); mx = max3_nc(mx, sc[2][qg][1], sc[2][qg][2]);
                mx = max3_nc(mx, sc[2][qg][3], sc[3][qg][0]); mx = max3_nc(mx, sc[3][qg][1], sc[3][qg][2]); mx = max_nc(mx, sc[3][qg][3]);
                mx = xmax32(xmax16(mx));
                const float mold = mrow[qg], mnew = max_nc(mold, mx);
                mrow[qg] = mnew;
                const bool grew = __any(mnew > mold);
                const float scl = grew ? __builtin_amdgcn_exp2f(mold - mnew) : 1.f;
                float ls = 0.f;
#pragma unroll
                for (int kt = 0; kt < 4; ++kt)
#pragma unroll
                    for (int r = 0; r < 4; ++r) { const float p = __builtin_amdgcn_exp2f(sc[kt][qg][r] - mnew); sc[kt][qg][r] = p; ls += p; }
                lrow[qg] = lrow[qg] * scl + ls;
                if (grew) {
#pragma unroll
                    for (int dt = 0; dt < 4; ++dt) o[dt][qg] = o[dt][qg] * scl;
                }
#pragma unroll
                for (int s2 = 0; s2 < 2; ++s2) { u32x4 w; w.x = pk2(sc[2 * s2][qg][0], sc[2 * s2][qg][1]); w.y = pk2(sc[2 * s2][qg][2], sc[2 * s2][qg][3]);
                    w.z = pk2(sc[2 * s2 + 1][qg][0], sc[2 * s2 + 1][qg][1]); w.w = pk2(sc[2 * s2 + 1][qg][2], sc[2 * s2 + 1][qg][3]); pf[qg][s2] = __builtin_bit_cast(bf16x8, w); }
            }
#pragma unroll
            for (int dt = 0; dt < 4; ++dt)
#pragma unroll
                for (int s2 = 0; s2 < 2; ++s2) {
                    const LAS bf16_t* vp = Vt + (16 * dt + l15) * ATT_KS + 32 * s2 + 4 * g;
                    const u32x2 vlo = *(const LAS u32x2*)vp, vhi = *(const LAS u32x2*)(vp + 16);
                    const bf16x8 vf = __builtin_bit_cast(bf16x8, (u32x4){vlo.x, vlo.y, vhi.x, vhi.y});
#pragma unroll
                    for (int qg = 0; qg < 4; ++qg) o[dt][qg] = __builtin_amdgcn_mfma_f32_16x16x32_bf16(vf, pf[qg][s2], o[dt][qg], 0, 0, 0);
                }
        }
        if (s + 1 < ntile) ATT_WRITE((s + 1) & 1);
        LDS_BAR();
    }
#undef ATT_ROW0
#undef ATT_LOAD
#undef ATT_WRITE
#pragma unroll
    for (int qg = 0; qg < 4; ++qg) {
        const float l = xadd32(xadd16(lrow[qg]));
        const float inv = __builtin_amdgcn_rcpf(l);
        unsigned char* op = (unsigned char*)AO + (size_t)(b * T + qw0 + 16 * qg + l15) * 1024 + h * 64 + 4 * g;
#pragma unroll
        for (int dt = 0; dt < 4; ++dt) { const f32x4 v = o[dt][qg] * (inv * MIX8_SCALE); *(unsigned*)(op + 16 * dt) = pk4_fp8(v.x, v.y, v.z, v.w); }
    }
}


constexpr int GL_KS = 72;
constexpr int GL_VP = 144;
typedef short v4i16_t __attribute__((ext_vector_type(4)));
DI u32x2 lds_tr4(const LAS bf16_t* blk, int pitch, int l15) { return __builtin_bit_cast(u32x2, __builtin_amdgcn_ds_read_tr16_b64_v4i16((LAS v4i16_t*)(blk + (l15 >> 2) * pitch + 4 * (l15 & 3)))); }
struct CvtRegs { f32x4 v[16]; };
struct GlaRegs { u32x4 k, q; u32x4 laf, lab; u32x4 v[2]; u32x4 st[2][2]; };
template <bool G3>
DI void gla_issue(GlaRegs& R, int row0, int h, int seq0, int c, const bf16_t* GQ, const bf16_t* GK, const bf16_t* GV, const bf16_t* LAF, const bf16_t* LAB, const bf16_t* ST, int tid) {
    const int j = tid >> 3, dch = tid & 7;
    R.k = *(const u32x4*)(GK + (size_t)(row0 + j) * 256 + h * 64 + 8 * dch);
    R.laf = *(const u32x4*)(LAF + (size_t)(row0 + j) * 256 + h * 64 + 8 * dch); R.lab = *(const u32x4*)(LAB + (size_t)(row0 + j) * 256 + h * 64 + 8 * dch);
    if constexpr (G3) R.q = *(const u32x4*)(GQ + (size_t)(row0 + j) * 256 + h * 64 + 8 * dch);
#pragma unroll
    for (int i = 0; i < 2; ++i) { const int idx = tid + 512 * i, jj = idx >> 4, c4 = idx & 15;
        R.v[i] = *(const u32x4*)(GV + (size_t)(row0 + jj) * 512 + h * 128 + 8 * c4); }
    if constexpr (G3) {
#pragma unroll
        for (int dir = 0; dir < 2; ++dir)
#pragma unroll
            for (int i = 0; i < 2; ++i) { const int idx = tid + 512 * i, e = idx >> 3, ch = idx & 7; R.st[dir][i] = *(const u32x4*)(ST + ((size_t)((seq0 + dir) * 32 + c) * 128 + e) * 64 + 8 * ch); }
    }
}
DI void gla_commit(const GlaRegs& R, LAS float* Lf, LAS float* Lb, LAS bf16_t* Vt, int tid) {
    { const int j = tid >> 3, dch = tid & 7; LAS float* pf = Lf + j * 64 + 8 * dch; LAS float* pb = Lb + j * 64 + 8 * dch;
      *(LAS f32x4*)pf = (f32x4){bflo(R.laf.x), bfhi(R.laf.x), bflo(R.laf.y), bfhi(R.laf.y)}; *(LAS f32x4*)(pf + 4) = (f32x4){bflo(R.laf.z), bfhi(R.laf.z), bflo(R.laf.w), bfhi(R.laf.w)};
      *(LAS f32x4*)pb = (f32x4){bflo(R.lab.x), bfhi(R.lab.x), bflo(R.lab.y), bfhi(R.lab.y)}; *(LAS f32x4*)(pb + 4) = (f32x4){bflo(R.lab.z), bfhi(R.lab.z), bflo(R.lab.w), bfhi(R.lab.w)}; }
#pragma unroll
    for (int i = 0; i < 2; ++i) { const int idx = tid + 512 * i, jj = idx >> 4, c4 = idx & 15; *(LAS u32x4*)(Vt + jj * GL_VP + 8 * c4) = R.v[i]; }
}
DI float gla_cumsum2(LAS float* Lf, LAS float* Lb, LAS float* segtot, int tid) {
    const int dir = tid >> 8, d = tid & 63, seg = (tid >> 6) & 3; LAS float* L = (dir ? Lb : Lf) + (16 * seg) * 64 + d;
    float x[16];
#pragma unroll
    for (int i = 0; i < 16; ++i) x[i] = L[i * 64];
    if (!dir) {
#pragma unroll
        for (int i = 1; i < 16; ++i) x[i] += x[i - 1];
    } else {
#pragma unroll
        for (int i = 14; i >= 0; --i) x[i] += x[i + 1];
    }
    segtot[(dir * 4 + seg) * 64 + d] = dir ? x[0] : x[15];
    LDS_BAR();
    const float s0 = segtot[(dir * 4 + 0) * 64 + d], s1 = segtot[(dir * 4 + 1) * 64 + d], s2 = segtot[(dir * 4 + 2) * 64 + d], s3 = segtot[(dir * 4 + 3) * 64 + d];
    const float off = dir ? ((seg < 1 ? s1 : 0.f) + (seg < 2 ? s2 : 0.f) + (seg < 3 ? s3 : 0.f)) : ((seg > 0 ? s0 : 0.f) + (seg > 1 ? s1 : 0.f) + (seg > 2 ? s2 : 0.f));
#pragma unroll
    for (int i = 0; i < 16; ++i) L[i * 64] = x[i] + off;
    return (s0 + s1) + (s2 + s3);
}
#define G1_DECODE(u, b_, h_, c_, r_) const int b_ = (u) / 144, h_ = ((u) / 36) & 3, c_ = (u) % 36, r_ = (c_ < 4) ? M + b_ * LC + 64 * c_ : b_ * T + 64 * (c_ - 4)
template <class CS> DI void gla_g1_unit2(CS& cs, GlaRegs& RC, int uidx, int G, const bf16_t* GK, const bf16_t* GV, const bf16_t* LAF, const bf16_t* LAB, bf16_t* UB, float* DV, LAS unsigned char* lds, int tid, int lane, int wave) {
    LAS float* Lf = (LAS float*)lds; LAS float* Lb = Lf + 4096; LAS float* tot = Lb + 4096; LAS float* segtot = tot + 128;
    LAS bf16_t* Vt = (LAS bf16_t*)(segtot + 512); LAS bf16_t* Kh = Vt + 64 * GL_VP;
    const int j = tid >> 3, dch = tid & 7, g = lane >> 4, l15 = lane & 15;
    G1_DECODE(uidx, b, h, c36, row0); (void)row0;
    const int seq0 = (b * 4 + h) * 2;
    const u32x4 kreg = RC.k;
    gla_commit(RC, Lf, Lb, Vt, tid);
    const int nidx = uidx + 2 * G;
    if (nidx < NB * 4 * 36) { G1_DECODE(nidx, nb, nh, nc, nr); (void)nb; (void)nc; gla_issue<false>(RC, nr, nh, 0, 0, nullptr, GK, GV, LAF, LAB, nullptr, tid); }
    CvtRegs CR; cs.issue(CR);
    LDS_BAR();
    { const float ctot = gla_cumsum2(Lf, Lb, segtot, tid);
      if (((tid >> 6) & 3) == 0) { const int dir = tid >> 8, d = tid & 63; tot[dir * 64 + d] = ctot; DV[(size_t)((seq0 + dir) * 36 + c36) * 64 + d] = __expf(ctot); } }
    LDS_BAR();
    { const float kv[8] = {bflo(kreg.x), bfhi(kreg.x), bflo(kreg.y), bfhi(kreg.y), bflo(kreg.z), bfhi(kreg.z), bflo(kreg.w), bfhi(kreg.w)};
#pragma unroll
      for (int dir = 0; dir < 2; ++dir) { const LAS float* L = (dir ? Lb : Lf) + j * 64 + 8 * dch; const LAS float* tp = tot + dir * 64 + 8 * dch;
        const f32x4 b0 = *(const LAS f32x4*)L, b1 = *(const LAS f32x4*)(L + 4), t0 = *(const LAS f32x4*)tp, t1 = *(const LAS f32x4*)(tp + 4);
        u32x4 w; w.x = pk2(kv[0] * __expf(t0.x - b0.x), kv[1] * __expf(t0.y - b0.y)); w.y = pk2(kv[2] * __expf(t0.z - b0.z), kv[3] * __expf(t0.w - b0.w));
        w.z = pk2(kv[4] * __expf(t1.x - b1.x), kv[5] * __expf(t1.y - b1.y)); w.w = pk2(kv[6] * __expf(t1.z - b1.z), kv[7] * __expf(t1.w - b1.w));
        *(LAS u32x4*)(Kh + (dir * 64 + j) * GL_KS + 8 * dch) = w; } }
    LDS_BAR();
    asm volatile("" : "+v"(RC.k), "+v"(RC.laf), "+v"(RC.lab), "+v"(RC.v[0]), "+v"(RC.v[1]));
    { const int dt = wave & 3, eh = wave >> 2;
#pragma unroll
      for (int dir = 0; dir < 2; ++dir) {
        bf16x8 af[2];
#pragma unroll
        for (int s2 = 0; s2 < 2; ++s2) { const LAS bf16_t* kb = Kh + (dir * 64 + 32 * s2 + 8 * g) * GL_KS + 16 * dt; const u32x2 lo = lds_tr4(kb, GL_KS, l15), hi = lds_tr4(kb + 4 * GL_KS, GL_KS, l15);
            af[s2] = __builtin_bit_cast(bf16x8, (u32x4){lo.x, lo.y, hi.x, hi.y}); }
        bf16_t* ub = UB + (size_t)((seq0 + dir) * 36 + c36) * (128 * 64);
#pragma unroll
        for (int et = 0; et < 4; ++et) {
            f32x4 acc = {0.f, 0.f, 0.f, 0.f};
#pragma unroll
            for (int s2 = 0; s2 < 2; ++s2) { const LAS bf16_t* vb = Vt + (32 * s2 + 8 * g) * GL_VP + 64 * eh + 16 * et; const u32x2 lo = lds_tr4(vb, GL_VP, l15), hi = lds_tr4(vb + 4 * GL_VP, GL_VP, l15);
                acc = __builtin_amdgcn_mfma_f32_16x16x32_bf16(af[s2], __builtin_bit_cast(bf16x8, (u32x4){lo.x, lo.y, hi.x, hi.y}), acc, 0, 0, 0); }
            st4bf(ub + (size_t)(64 * eh + 16 * et + l15) * 64 + 16 * dt + 4 * g, acc);
        }
      } }
    cs.finish(CR);
    LDS_BAR();
}
template <class CS> DI void gla_g1_phase(CS& cs, int G, int bx, const bf16_t* GK, const bf16_t* GV, const bf16_t* LAF, const bf16_t* LAB, bf16_t* UB, float* DV, LAS unsigned char* lds, int tid, int lane, int wave) {
    constexpr int NU = NB * 4 * 36;
    int uidx = bx; if (uidx >= NU) return;
    GlaRegs Ra, Rb;
    { G1_DECODE(uidx, b0, h0, c0, r0); (void)b0; (void)c0; gla_issue<false>(Ra, r0, h0, 0, 0, nullptr, GK, GV, LAF, LAB, nullptr, tid); }
    if (uidx + G < NU) { G1_DECODE(uidx + G, b1, h1, c1, r1); (void)b1; (void)c1; gla_issue<false>(Rb, r1, h1, 0, 0, nullptr, GK, GV, LAF, LAB, nullptr, tid); }
    for (;;) {
        gla_g1_unit2(cs, Ra, uidx, G, GK, GV, LAF, LAB, UB, DV, lds, tid, lane, wave);
        uidx += G; if (uidx >= NU) break;
        gla_g1_unit2(cs, Rb, uidx, G, GK, GV, LAF, LAB, UB, DV, lds, tid, lane, wave);
        uidx += G; if (uidx >= NU) break;
    }
}
#undef G1_DECODE
template <class CS> DI void gla_g3_phase(CS& cs, int G, int bx, const bf16_t* GQ, const bf16_t* GK, const bf16_t* GV, const bf16_t* LAF, const bf16_t* LAB, const bf16_t* ST, const bf16_t* GR, const float* gla_norm, bf16_t* OG,
                     LAS unsigned char* lds, int tid, int lane, int wave) {
    LAS float* Lf = (LAS float*)lds; LAS float* Lb = Lf + 4096;
    LAS bf16_t* Qt = (LAS bf16_t*)(Lb + 4096);
    LAS bf16_t* Kt = Qt + 2 * 64 * GL_KS;
    LAS bf16_t* Vt = Kt + 2 * 64 * GL_KS;
    LAS bf16_t* St = Vt + 64 * GL_VP;
    LAS float* ssx = (LAS float*)(St + 2 * 128 * GL_KS);
    LAS float* segtot = ssx + 128;
    const int j = tid >> 3, dch = tid & 7, g = lane >> 4, l15 = lane & 15;
    int uidx = bx; if (uidx >= NB * 4 * 32) return;
    f32x4 gnv[4];
#pragma unroll
    for (int et = 0; et < 4; ++et) gnv[et] = *(const f32x4*)(gla_norm + 64 * (wave >> 2) + 16 * et + 4 * g);
    GlaRegs R;
    gla_issue<true>(R, (uidx >> 7) * T + 64 * (uidx & 31), (uidx >> 5) & 3, ((uidx >> 7) * 4 + ((uidx >> 5) & 3)) * 2, uidx & 31, GQ, GK, GV, LAF, LAB, ST, tid);
    for (;;) {
        const int b = uidx >> 7, h = (uidx >> 5) & 3, c = uidx & 31, row0 = b * T + 64 * c;
        const u32x4 qreg = R.q, kreg = R.k;
        gla_commit(R, Lf, Lb, Vt, tid);
#pragma unroll
        for (int dir = 0; dir < 2; ++dir)
#pragma unroll
            for (int i = 0; i < 2; ++i) { const int idx = tid + 512 * i, e = idx >> 3, ch = idx & 7; *(LAS u32x4*)(St + (dir * 128 + e) * GL_KS + 8 * ch) = R.st[dir][i]; }
        const int nidx = uidx + G; const bool has_next = nidx < NB * 4 * 32;
        if (has_next) gla_issue<true>(R, (nidx >> 7) * T + 64 * (nidx & 31), (nidx >> 5) & 3, ((nidx >> 7) * 4 + ((nidx >> 5) & 3)) * 2, nidx & 31, GQ, GK, GV, LAF, LAB, ST, tid);
        LDS_BAR();
        (void)gla_cumsum2(Lf, Lb, segtot, tid);
        LDS_BAR();
        { const float qv[8] = {bflo(qreg.x), bfhi(qreg.x), bflo(qreg.y), bfhi(qreg.y), bflo(qreg.z), bfhi(qreg.z), bflo(qreg.w), bfhi(qreg.w)};
          const float kv[8] = {bflo(kreg.x), bfhi(kreg.x), bflo(kreg.y), bfhi(kreg.y), bflo(kreg.z), bfhi(kreg.z), bflo(kreg.w), bfhi(kreg.w)};
#pragma unroll
          for (int dir = 0; dir < 2; ++dir) { const LAS float* L = (dir ? Lb : Lf) + j * 64 + 8 * dch;
            const f32x4 b0 = *(const LAS f32x4*)L, b1 = *(const LAS f32x4*)(L + 4);
            const float bb[8] = {b0.x, b0.y, b0.z, b0.w, b1.x, b1.y, b1.z, b1.w};
            float qt[8], kt[8];
#pragma unroll
            for (int i = 0; i < 8; ++i) { const float ex = __expf(bb[i]); qt[i] = qv[i] * ex; kt[i] = kv[i] * __builtin_amdgcn_rcpf(ex); }
            u32x4 qw, kw; qw.x = pk2(qt[0], qt[1]); qw.y = pk2(qt[2], qt[3]); qw.z = pk2(qt[4], qt[5]); qw.w = pk2(qt[6], qt[7]);
            kw.x = pk2(kt[0], kt[1]); kw.y = pk2(kt[2], kt[3]); kw.z = pk2(kt[4], kt[5]); kw.w = pk2(kt[6], kt[7]);
            *(LAS u32x4*)(Qt + (dir * 64 + j) * GL_KS + 8 * dch) = qw; *(LAS u32x4*)(Kt + (dir * 64 + j) * GL_KS + 8 * dch) = kw; } }
        LDS_BAR();
        const int it = wave & 3, eh = wave >> 2;
        u32x2 grv[4];
#pragma unroll
        for (int et = 0; et < 4; ++et) grv[et] = *(const u32x2*)(GR + (size_t)(row0 + 16 * it + l15) * 512 + h * 128 + 64 * eh + 16 * et + 4 * g);
        f32x4 o[4];
#pragma unroll
        for (int et = 0; et < 4; ++et) o[et] = (f32x4){0.f, 0.f, 0.f, 0.f};
#pragma unroll
        for (int dir = 0; dir < 2; ++dir) {
            bf16x8 qf[2];
#pragma unroll
            for (int s2 = 0; s2 < 2; ++s2) qf[s2] = *(const LAS bf16x8*)(Qt + (dir * 64 + 16 * it + l15) * GL_KS + 32 * s2 + 8 * g);
#pragma unroll
            for (int et = 0; et < 4; ++et)
#pragma unroll
                for (int s2 = 0; s2 < 2; ++s2) { const bf16x8 a = *(const LAS bf16x8*)(St + (dir * 128 + 64 * eh + 16 * et + l15) * GL_KS + 32 * s2 + 8 * g); o[et] = __builtin_amdgcn_mfma_f32_16x16x32_bf16(a, qf[s2], o[et], 0, 0, 0); }
            f32x4 at[4];
#pragma unroll
            for (int jt = 0; jt < 4; ++jt) { at[jt] = (f32x4){0.f, 0.f, 0.f, 0.f};
#pragma unroll
                for (int s2 = 0; s2 < 2; ++s2) { const bf16x8 kf = *(const LAS bf16x8*)(Kt + (dir * 64 + 16 * jt + l15) * GL_KS + 32 * s2 + 8 * g); at[jt] = __builtin_amdgcn_mfma_f32_16x16x32_bf16(kf, qf[s2], at[jt], 0, 0, 0); }
#pragma unroll
                for (int r = 0; r < 4; ++r) { const int jj = 16 * jt + 4 * g + r, ii = 16 * it + l15; const bool keep = dir ? (jj >= ii) : (jj <= ii); if (!keep) at[jt][r] = 0.f; } }
#pragma unroll
            for (int s2 = 0; s2 < 2; ++s2) {
                u32x4 w; w.x = pk2(at[2 * s2][0], at[2 * s2][1]); w.y = pk2(at[2 * s2][2], at[2 * s2][3]); w.z = pk2(at[2 * s2 + 1][0], at[2 * s2 + 1][1]); w.w = pk2(at[2 * s2 + 1][2], at[2 * s2 + 1][3]);
                const bf16x8 pf = __builtin_bit_cast(bf16x8, w);
#pragma unroll
                for (int et = 0; et < 4; ++et) { const LAS bf16_t* vb = Vt + (32 * s2 + 4 * g) * GL_VP + 64 * eh + 16 * et;
                    const u32x2 vlo = lds_tr4(vb, GL_VP, l15), vhi = lds_tr4(vb + 16 * GL_VP, GL_VP, l15);
                    o[et] = __builtin_amdgcn_mfma_f32_16x16x32_bf16(__builtin_bit_cast(bf16x8, (u32x4){vlo.x, vlo.y, vhi.x, vhi.y}), pf, o[et], 0, 0, 0); }
            }
        }
        float ss = 0.f;
#pragma unroll
        for (int et = 0; et < 4; ++et) ss += (o[et].x * o[et].x + o[et].y * o[et].y) + (o[et].z * o[et].z + o[et].w * o[et].w);
        asm volatile("" : "+v"(R.k), "+v"(R.q), "+v"(R.laf), "+v"(R.lab), "+v"(R.v[0]), "+v"(R.v[1]), "+v"(R.st[0][0]), "+v"(R.st[0][1]), "+v"(R.st[1][0]), "+v"(R.st[1][1]));
        ss = xadd32(xadd16(ss));
        if (g == 0) ssx[eh * 64 + 16 * it + l15] = ss;
        LDS_BAR();
        { const float rstd = rsqrtf((ssx[16 * it + l15] + ssx[64 + 16 * it + l15]) * (1.f / 128.f) + EPS);
          const size_t ro = (size_t)(row0 + 16 * it + l15) * 512 + h * 128, ro2 = (size_t)(row0 + 16 * it + l15) * 1024 + h * 128;
#pragma unroll
          for (int et = 0; et < 4; ++et) { const int e0 = 64 * eh + 16 * et + 4 * g; const f32x4 gn = gnv[et]; const u32x2 gr = grv[et]; (void)ro;
              const f32x4 v = o[et] * (rstd * MIX8_SCALE) * gn * (f32x4){bflo(gr.x), bfhi(gr.x), bflo(gr.y), bfhi(gr.y)}; *(unsigned*)((unsigned char*)OG + ro2 + e0) = pk4_fp8(v.x, v.y, v.z, v.w); } }
        LDS_BAR();
        if (!has_next) break;
        uidx = nidx;
    }
}

struct Args { const float* in[26]; float* out; unsigned char* ws; int ph_lo, ph_hi, li, flags; };
constexpr int NPH = 12;

template <bool FP8, int NB, class Dest>
DI void cvt_item(const float* W, int ldw, int ncols, int k0, int s0, void* WT, int Kd, Dest dest, float scale, int lane) {
    const int g = lane >> 4, c0 = s0 + 4 * (lane & 15);
    if (c0 >= ncols) return;
    const float* src = W + (size_t)(k0 + 16 * g) * ldw + c0;
    int dr[4];
#pragma unroll
    for (int c = 0; c < 4; ++c) dr[c] = dest(c0 + c);
#pragma unroll
    for (int kb = 0; kb < NB * 64; kb += 64) {
        f32x4 v[16];
#pragma unroll
        for (int i = 0; i < 16; ++i) v[i] = *(const f32x4*)(src + (size_t)(kb + i) * ldw);
#pragma unroll
        for (int c = 0; c < 4; ++c) {
            if (dr[c] >= 0) {
            if constexpr (FP8) {
                u32x4 o; o.x = pk4_fp8(v[0][c] * scale, v[1][c] * scale, v[2][c] * scale, v[3][c] * scale); o.y = pk4_fp8(v[4][c] * scale, v[5][c] * scale, v[6][c] * scale, v[7][c] * scale);
                o.z = pk4_fp8(v[8][c] * scale, v[9][c] * scale, v[10][c] * scale, v[11][c] * scale); o.w = pk4_fp8(v[12][c] * scale, v[13][c] * scale, v[14][c] * scale, v[15][c] * scale);
                *(u32x4*)((unsigned char*)WT + (size_t)dr[c] * Kd + k0 + kb + 16 * g) = o;
            } else {
                u32x4 o0, o1; o0.x = pk2(v[0][c], v[1][c]); o0.y = pk2(v[2][c], v[3][c]); o0.z = pk2(v[4][c], v[5][c]); o0.w = pk2(v[6][c], v[7][c]);
                o1.x = pk2(v[8][c], v[9][c]); o1.y = pk2(v[10][c], v[11][c]); o1.z = pk2(v[12][c], v[13][c]); o1.w = pk2(v[14][c], v[15][c]);
                bf16_t* dp = (bf16_t*)WT + (size_t)dr[c] * Kd + k0 + kb + 16 * g; *(u32x4*)dp = o0; *(u32x4*)(dp + 8) = o1;
            }
            }
        }
    }
}
DI void sincos_d(double a, double& s, double& c) {
    const double q = __builtin_rint(a * 0.63661977236758134308), f = a - q * 1.57079632679489661923, f2 = f * f;
    const double sp = f * (1.0 + f2 * (-1.0 / 6 + f2 * (1.0 / 120 + f2 * (-1.0 / 5040 + f2 * (1.0 / 362880 + f2 * (-1.0 / 39916800 + f2 * (1.0 / 6227020800.0)))))));
    const double cp = 1.0 + f2 * (-0.5 + f2 * (1.0 / 24 + f2 * (-1.0 / 720 + f2 * (1.0 / 40320 + f2 * (-1.0 / 3628800 + f2 * (1.0 / 479001600 + f2 * (-1.0 / 87178291200.0)))))));
    const int qi = ((int)q) & 3;
    s = (qi == 0) ? sp : (qi == 1) ? cp : (qi == 2) ? -sp : -cp;
    c = (qi == 0) ? cp : (qi == 1) ? -sp : (qi == 2) ? -cp : sp;
}
DI int dest_win(int s) {
    if (s < 512) { const int head = s >> 6, d = s & 63; return (head >> 2) * 256 + slot_head(head & 3, d); }
    if (s < 640) { const int x = s - 512; return 2 * 256 + slot_head(x >> 6, x & 63); }
    if (s < 768) { const int x = s - 640; return 2 * 256 + slot_head(2 + (x >> 6), x & 63); }
    if (s < 1024) return 8 * 256 + slot_std8(s - 768);
    if (s < 1280) return 3 * 256 + slot_std8(s - 1024);
    if (s < 1792) { const int x = s - 1280; return (4 + (x >> 8)) * 256 + slot_std8(x & 255); }
    if (s < 2304) { const int x = s - 1792; return (9 + (x >> 8)) * 256 + slot_std8(x & 255); }
    if (s < 2336) return -1;
    if (s < 3360) { const int x = s - 2336; return (11 + (x >> 8)) * 256 + slot_std8(x & 255); }
    { const int x = s - 3360; return (15 + (x >> 8)) * 256 + slot_std8(x & 255); }
}
DI int dest_std8(int s) { return (s & ~255) + slot_std8(s & 255); }
DI int dest_win_lo(int s) { return s < 2336 ? dest_win(s) : -1; }
DI int dest_gate(int s) { return s < 2336 ? -1 : dest_std8(s - 2336); }
DI int dest_std16(int s) { const int L = s & 255; return (s & ~255) + 128 * ((L >> 3) & 1) + 32 * (L >> 6) + 16 * ((L >> 2) & 1) + 4 * ((L >> 4) & 3) + (L & 3); }
DI int dest_w1(int s) { const int g = s >> 10, f = s & 1023, t = f >> 7, fl = f & 127; return t * 256 + 128 * g + (fl & 0x60) + (((fl >> 2) & 1) << 4) + (((fl >> 3) & 3) << 2) + (fl & 3); }

constexpr int CVT_I_W1 = 32 * 32 * 8, CVT_I_W2 = 32 * 16 * 8, CVT_NBATCH = 2 * (CVT_I_W1 + CVT_I_W2);
struct CvtStream {
    const float* w_e1; const float* w_e2; unsigned char* W1; unsigned char* W2; int gw, ngw, seq, lane;
    DI bool pending() const { return seq * ngw + gw < CVT_NBATCH; }
    DI void issue(CvtRegs& C) const {
        const int id = seq * ngw + gw; if (id >= CVT_NBATCH) return;
        const int item = id >> 1, half = id & 1, g = lane >> 4;
        const float* src;  int ldw;
        if (item < CVT_I_W1) { const int e = item >> 8, q = item & 255; ldw = 2048; src = w_e1 + (size_t)e * 1024 * 2048 + (size_t)((q >> 5) * 128 + half * 64 + 16 * g) * 2048 + (q & 31) * 64 + 4 * (lane & 15); }
        else { const int it2 = item - CVT_I_W1, e = it2 >> 7, q = it2 & 127; ldw = 1024; src = w_e2 + (size_t)e * 1024 * 1024 + (size_t)((q >> 4) * 128 + half * 64 + 16 * g) * 1024 + (q & 15) * 64 + 4 * (lane & 15); }
#pragma unroll
        for (int i = 0; i < 16; ++i) C.v[i] = __builtin_nontemporal_load((const f32x4*)(src + (size_t)i * ldw));
    }
    DI void finish(const CvtRegs& C) {
        const int id = seq * ngw + gw; if (id >= CVT_NBATCH) return;
        ++seq;
        const int item = id >> 1, half = id & 1, g = lane >> 4;
        unsigned char* dst; int c0; bool isw1 = item < CVT_I_W1;
        if (isw1) { const int e = item >> 8, q = item & 255; dst = W1 + (size_t)e * 2048 * 1024 + (q >> 5) * 128 + half * 64 + 16 * g; c0 = (q & 31) * 64 + 4 * (lane & 15); }
        else { const int it2 = item - CVT_I_W1, e = it2 >> 7, q = it2 & 127; dst = W2 + (size_t)e * 1024 * 1024 + (q >> 4) * 128 + half * 64 + 16 * g; c0 = (q & 15) * 64 + 4 * (lane & 15); }
#pragma unroll
        for (int c = 0; c < 4; ++c) {
            const int dr = isw1 ? dest_w1(c0 + c) : dest_std16(c0 + c);
            u32x4 o; o.x = pk4_fp8(C.v[0][c] * W8_SCALE, C.v[1][c] * W8_SCALE, C.v[2][c] * W8_SCALE, C.v[3][c] * W8_SCALE); o.y = pk4_fp8(C.v[4][c] * W8_SCALE, C.v[5][c] * W8_SCALE, C.v[6][c] * W8_SCALE, C.v[7][c] * W8_SCALE);
            o.z = pk4_fp8(C.v[8][c] * W8_SCALE, C.v[9][c] * W8_SCALE, C.v[10][c] * W8_SCALE, C.v[11][c] * W8_SCALE); o.w = pk4_fp8(C.v[12][c] * W8_SCALE, C.v[13][c] * W8_SCALE, C.v[14][c] * W8_SCALE, C.v[15][c] * W8_SCALE);
            *(u32x4*)(dst + (size_t)dr * 1024) = o;
        }
    }
};

__global__ void __launch_bounds__(512, 2) fwd_kernel(Args args) {
    extern __shared__ __attribute__((aligned(16))) unsigned char lds_raw[];
    LAS unsigned char* lds = (LAS unsigned char*)lds_raw;
    volatile LAS unsigned* MISC = (volatile LAS unsigned*)(lds + MISC_OFF);
    const int tid = threadIdx.x, lane = tid & 63, wave = __builtin_amdgcn_readfirstlane(tid >> 6);
    const int G = gridDim.x, bx = blockIdx.x;
    const int vcu = (G % 8 == 0) ? (bx % 8) * (G / 8) + bx / 8 : bx;
    const int gw = vcu * 8 + wave, NGW = G * 8;
    unsigned char* ws = args.ws;
    unsigned* ctl = (unsigned*)(ws + O_CTL);
    CvtStream cvs; cvs.w_e1 = args.in[22]; cvs.w_e2 = args.in[24]; cvs.W1 = ws + O_W1; cvs.W2 = ws + O_W2; cvs.gw = gw; cvs.ngw = NGW; cvs.lane = lane;
    cvs.seq = (args.ph_lo > 3) ? 1 << 20 : 0;
    const float* x = args.in[0]; const float* cvec = args.in[1]; const float* ctx = args.in[2]; const float* c_ctx = args.in[3];
    const float* w_mod = args.in[4]; const float* b_mod = args.in[5]; const float* norm1 = args.in[6]; const float* norm2 = args.in[7];
    const float* w_in = args.in[8]; const float* q_norm = args.in[9]; const float* k_norm = args.in[10]; const float* attn_sink = args.in[11];
    const float* w_alpha_f = args.in[12]; const float* b_alpha_f = args.in[13]; const float* w_alpha_b = args.in[14]; const float* b_alpha_b = args.in[15];
    const float* gla_norm = args.in[16]; const float* w_battn = args.in[17]; const float* w_bgla = args.in[18]; const float* w_out = args.in[19];
    const float* w_router = args.in[20]; const float* b_router = args.in[21]; const float* w_e1 = args.in[22]; const float* b_e1 = args.in[23];
    const float* w_e2 = args.in[24]; const float* b_e2 = args.in[25];
    float* out = args.out;
    float* MOD = (float*)(ws + O_MOD); float* ROPEC = (float*)(ws + O_ROPE); float* ROPES = ROPEC + 1024;
    float* WTS = (float*)(ws + O_WTS); int* LIST = (int*)(ws + O_LIST); float* WL = (float*)(ws + O_WL);
    bf16_t* WIN = (bf16_t*)(ws + O_WIN); bf16_t* WBA = (bf16_t*)(ws + O_WBA); bf16_t* WBG = (bf16_t*)(ws + O_WBG); bf16_t* WOUT = (bf16_t*)(ws + O_WOUT);
    unsigned char* WIN8 = ws + O_WIN + (size_t)11 * 256 * 1024 * 2; unsigned char* HN8 = ws + O_ACT;
    unsigned char* W1 = ws + O_W1; unsigned char* W2 = ws + O_W2;
    bf16_t* HN = (bf16_t*)(ws + O_HN); bf16_t* Qb = (bf16_t*)(ws + O_Q); bf16_t* Kb = (bf16_t*)(ws + O_K); bf16_t* Vb = (bf16_t*)(ws + O_V);
    bf16_t* GQ = (bf16_t*)(ws + O_GQ); bf16_t* GK = (bf16_t*)(ws + O_GK); bf16_t* GV = (bf16_t*)(ws + O_GV);
    bf16_t* LAF = (bf16_t*)(ws + O_LAF); bf16_t* LAB = (bf16_t*)(ws + O_LAB);
    bf16_t* GR = (bf16_t*)(ws + O_GR); bf16_t* GA = (bf16_t*)(ws + O_GA); bf16_t* GG = (bf16_t*)(ws + O_GG);
    bf16_t* AO = (bf16_t*)(ws + O_AO); bf16_t* UB = (bf16_t*)(ws + O_UB); float* DV = (float*)(ws + O_DV); bf16_t* ST = (bf16_t*)(ws + O_ST); bf16_t* OG = (bf16_t*)((unsigned char*)AO + 512);
    bf16_t* X1b = (bf16_t*)(ws + O_X1); bf16_t* Yb = (bf16_t*)(ws + O_Y); unsigned char* H2 = ws + O_H2;
    unsigned char* ACT = ws + O_ACT; unsigned char* YS = ws + O_YS;

    for (int u = tid; u < 64; u += 512) MISC[u] = 0u;
    __syncthreads();
    XcdBarrier bar; bar.bar = ctl + CW_BAR + args.li * XCD_BAR_WORDS; bar.x = 0; bar.st = nullptr;
    bar = xcd_barrier_post(ctl + CW_BAR + args.li * XCD_BAR_WORDS, MISC + 8);
    const int lo = args.ph_lo, hi = args.ph_hi;
#define IN(k) (lo <= (k) && (k) < hi)
#define SEAM(k) do { if (IN(k) && IN((k) + 1)) xcd_barrier(bar); } while (0)

    if (IN(0)) {
        for (int it = bx; it < MOD_ITEMS; it += G) {
            LAS float* scT = (LAS float*)lds;
            LAS float* part = scT + 1024 * 12;
            int zz; asm volatile("v_mov_b32 %0, 0" : "=v"(zz));
            const int lz = lane + zz, r8 = lz >> 3, c4 = lz & 7;
            float cv[18];
#pragma unroll
            for (int q = 0; q < 18; ++q) { const int k = tid + 512 * (q & 1); cv[q] = (q < 16) ? cvec[(q >> 1) * 1024 + k] : c_ctx[k]; }
            f32x4 w[16];
            const float* wp = w_mod + (size_t)(wave * 128 + r8) * 6144 + it * 32 + 4 * c4;
#pragma unroll
            for (int i = 0; i < 16; ++i) w[i] = *(const f32x4*)(wp + (size_t)(i * 8) * 6144);
#pragma unroll
            for (int q = 0; q < 18; ++q) { const int k = tid + 512 * (q & 1); scT[k * 12 + (q >> 1)] = cv[q] * sigmoidf_(cv[q]); }
            LDS_BAR();
            f32x4 ac[9];
#pragma unroll
            for (int r = 0; r < 9; ++r) ac[r] = (f32x4){0.f, 0.f, 0.f, 0.f};
#pragma unroll
            for (int i = 0; i < 16; ++i) {
                const LAS float* sp = scT + (wave * 128 + i * 8 + r8) * 12;
                const f32x4 s0 = *(const LAS f32x4*)sp, s1 = *(const LAS f32x4*)(sp + 4); const float s2 = sp[8];
                ac[0] += w[i] * s0.x; ac[1] += w[i] * s0.y; ac[2] += w[i] * s0.z; ac[3] += w[i] * s0.w;
                ac[4] += w[i] * s1.x; ac[5] += w[i] * s1.y; ac[6] += w[i] * s1.z; ac[7] += w[i] * s1.w; ac[8] += w[i] * s2;
            }
#pragma unroll
            for (int r = 0; r < 9; ++r)
#pragma unroll
                for (int c = 0; c < 4; ++c) { float v = ac[r][c]; v = DPP_ADD(v, 0x128, 0xf); v = xadd16(v); v = xadd32(v); ac[r][c] = v; }
            if (lane < 8) {
#pragma unroll
                for (int r = 0; r < 9; ++r) *(LAS f32x4*)(part + (wave * 9 + r) * 32 + 4 * c4) = ac[r];
            }
            LDS_BAR();
            if (tid < 288) { const int r = tid >> 5, l = tid & 31; float sm = b_mod[it * 32 + l];
#pragma unroll
                for (int w8 = 0; w8 < 8; ++w8) sm += part[(w8 * 9 + r) * 32 + l];
                __hip_atomic_store(MOD + r * 6144 + it * 32 + l, sm, __ATOMIC_RELAXED, __HIP_MEMORY_SCOPE_AGENT); }
            asm volatile("s_waitcnt vmcnt(0)" ::: "memory");
            __syncthreads();
            if (tid == 0) (void)__hip_atomic_fetch_add(ctl + CW_MODF, 1u, __ATOMIC_RELAXED, __HIP_MEMORY_SCOPE_AGENT);
        }
        if (bx == G - 1) {
            for (int idx = tid; idx < 1024; idx += 512) { const int pos = idx >> 4, i = idx & 15; double inv = 1.0; for (int j = 0; j < i; ++j) inv *= 0.56234132519034908039;
                double s, c; sincos_d((double)pos * inv, s, c); ROPEC[idx] = (float)c; ROPES[idx] = (float)s; }
        }
        LAS float* scr = (LAS float*)(lds + wave * 16384);
        constexpr int I_EFF = 128, I_WIN = 69 * 16, I_BA = 16 * 8, I_BG = 16 * 8, I_OUT = 16 * 16;
        constexpr int NITEMS = I_EFF + I_WIN + I_BA + I_BG + I_OUT;
        const int nfree = (G > MOD_ITEMS) ? G - MOD_ITEMS : 0, nbusy = G - nfree, FIT = (3 * nfree * 8 < NITEMS) ? 3 * nfree * 8 : NITEMS;
        const bool isfree = bx >= MOD_ITEMS;
        const int it_lo = isfree ? (bx - MOD_ITEMS) * 8 + wave : FIT + bx * 8 + wave, it_hi = isfree ? FIT : NITEMS, it_st = isfree ? nfree * 8 : nbusy * 8;
        for (int it = it_lo; it < it_hi; it += it_st) {
            int r = it;
            if (r < I_EFF) {
                const int dir = r >> 6, kb = (r >> 2) & 15, p = r & 3; const float* wa = dir ? w_alpha_b : w_alpha_f;
                { const float* lrp = w_in + (size_t)(kb * 64 + lane) * CIN + 2304 + 16 * dir;
#pragma unroll
                  for (int q4 = 0; q4 < 4; ++q4) *(LAS f32x4*)(scr + lane * 16 + 4 * q4) = *(const f32x4*)(lrp + 4 * q4); }
                LDS_WAIT(); asm volatile("" ::: "memory");
                {
                    const int n = p * 64 + lane; float al[16];
#pragma unroll
                    for (int q = 0; q < 16; ++q) al[q] = wa[q * 256 + n];
                    bf16_t* dst = WIN + (size_t)((6 + dir) * 256 + slot_std8(n)) * 1024 + kb * 64;
#pragma unroll 2
                    for (int g8 = 0; g8 < 8; ++g8) {
                        float sv[8];
#pragma unroll
                        for (int j = 0; j < 8; ++j) { const LAS float* lr = scr + (g8 * 8 + j) * 16; float sm = 0.f;
#pragma unroll
                            for (int q4 = 0; q4 < 4; ++q4) { const f32x4 l4 = *(const LAS f32x4*)(lr + 4 * q4); sm += (l4.x * al[4 * q4] + l4.y * al[4 * q4 + 1]) + (l4.z * al[4 * q4 + 2] + l4.w * al[4 * q4 + 3]); }
                            sv[j] = sm; }
                        u32x4 o; o.x = pk2(sv[0], sv[1]); o.y = pk2(sv[2], sv[3]); o.z = pk2(sv[4], sv[5]); o.w = pk2(sv[6], sv[7]);
                        *(u32x4*)(dst + g8 * 8) = o;
                    }
                }
                LDS_WAIT(); asm volatile("" ::: "memory");
                continue; } r -= I_EFF;
            if (r < I_WIN) { const int cb = r % 69, kb = r / 69;
                if (cb <= 36) cvt_item<false, 1>(w_in, CIN, CIN, kb * 64, cb * 64, WIN, 1024, [](int s) { return dest_win_lo(s); }, 1.f, lane);
                if (cb >= 36) cvt_item<true, 1>(w_in, CIN, CIN, kb * 64, cb * 64, WIN8, 1024, [](int s) { return dest_gate(s); }, W8_SCALE, lane);
                continue; } r -= I_WIN;
            if (r < I_BA) { cvt_item<true, 1>(w_battn, 1024, 1024, (r >> 4) * 64, (r & 15) * 64, WBA, 1024, [](int s) { return dest_std8(s); }, W8_SCALE, lane); continue; } r -= I_BA;
            if (r < I_BG) { cvt_item<true, 1>(w_bgla, 1024, 1024, (r >> 4) * 64, (r & 15) * 64, (unsigned char*)WBA + 512, 1024, [](int s) { return dest_std8(s); }, W8_SCALE, lane); continue; } r -= I_BG;
            cvt_item<true, 1>(w_out, 1024, 1024, (r >> 4) * 64, (r & 15) * 64, WOUT, 1024, [](int s) { return dest_std8(s); }, W8_SCALE, lane);
        }
        f32x4 vn[4];
#define P1_LOAD(m_) do { const float* xr_ = ((m_) < M) ? x + (size_t)(m_) * D : ctx + (size_t)((m_) - M) * D; _Pragma("unroll") for (int j = 0; j < 4; ++j) vn[j] = *(const f32x4*)(xr_ + 4 * lane + 256 * j); } while (0)
        if (gw < MT) P1_LOAD(gw);
        if (wave == 0) { unsigned spins = 0;
          for (;;) {
              unsigned f = 0; if (lane == 0) f = __hip_atomic_load(ctl + CW_MODF, __ATOMIC_RELAXED, __HIP_MEMORY_SCOPE_AGENT);
              if ((unsigned)__builtin_amdgcn_readfirstlane(f) >= (unsigned)MOD_ITEMS) break;
              __builtin_amdgcn_s_sleep(8); if (++spins > (1u << 21)) { if (lane == 0) __hip_atomic_store(ctl + CW_TMO, 1u, __ATOMIC_RELAXED, __HIP_MEMORY_SCOPE_AGENT); break; } }
          __builtin_amdgcn_fence(__ATOMIC_ACQUIRE, "agent"); }
        __syncthreads();

        for (int m = gw; m < MT; m += NGW) {
            const float* md = MOD + ((m < M) ? (m >> 11) : 8) * 6144;
            f32x4 v[4]; float ss = 0.f;
#pragma unroll
            for (int j = 0; j < 4; ++j) { v[j] = vn[j]; ss += (v[j].x * v[j].x + v[j].y * v[j].y) + (v[j].z * v[j].z + v[j].w * v[j].w); }
            if (m + NGW < MT) P1_LOAD(m + NGW);
            const float rstd = rsqrtf(wave_sum_dpp(ss) * (1.f / D) + EPS);
#pragma unroll
            for (int j = 0; j < 4; ++j) { const int c = 4 * lane + 256 * j;
                const f32x4 g = *(const f32x4*)(norm1 + c), sh = *(const f32x4*)(md + c), sc = *(const f32x4*)(md + 1024 + c);
                const f32x4 h = (v[j] * rstd * g) * (sc + 1.f) + sh;
                st4bf(HN + (size_t)m * D + c, h);
                if (m < M) *(unsigned*)(HN8 + (size_t)m * D + c) = pk4_fp8(h.x, h.y, h.z, h.w); }
        }
#undef P1_LOAD
    }
    SEAM(1);

    if (IN(2)) {
        InProjSched S; S.G = G; S.c = bx; S.A = (const char*)HN; S.Bt = (const char*)WIN;
        EpiInProj E{Qb, Kb, Vb, GQ, GK, GV, GR, GA, GG, LAF, LAB, q_norm, k_norm, b_alpha_f, b_alpha_b, ROPEC, ROPES};
        pg8::gemm_phase<EpiInProj, InProjSched, true>(lds, 1024, S, E);
        PlainSched S2; S2.G = G; S2.c = bx; S2.nM = 64; S2.nN = 8; S2.K = 1024; S2.eb = 1; S2.A = (const char*)HN8; S2.Bt = (const char*)WIN8;
        EpiGates E2{GA, GG};
        pg8::gemm_phase<EpiGates, PlainSched, true, true>(lds, 1024, S2, E2);
    }
    SEAM(2);

    if (IN(3)) {
        for (int uidx = bx; uidx < 256; uidx += G) attn_unit(uidx >> 5, (uidx >> 4) & 1, uidx & 15, Qb, Kb, Vb, AO, attn_sink, lds, tid, lane, wave);
        gla_g1_phase(cvs, G, bx, GK, GV, LAF, LAB, UB, DV, lds, tid, lane, wave);
    }
    SEAM(3);

    if (IN(4)) {
        if (bx < NB) {
            const float* mdr = MOD + bx * 6144 + 3 * 1024; float s4[4] = {0.f, 0.f, 0.f, 0.f};
            for (int i = 0; i < 16; ++i) { const int c = lane + 64 * i; const float sh = mdr[c]; const f32x4 w = *(const f32x4*)(w_router + (size_t)c * 32 + 4 * wave);
                s4[0] += sh * w.x; s4[1] += sh * w.y; s4[2] += sh * w.z; s4[3] += sh * w.w; }
#pragma unroll
            for (int j = 0; j < 4; ++j) { const float tot = wave_sum_dpp(s4[j]); if (lane == 0) ((float*)(ws + O_ROPE + 16384))[bx * 32 + 4 * wave + j] = tot + b_router[4 * wave + j]; }
        }
        for (int gid = bx * 512 + tid; gid < 64 * 128 * 16; gid += G * 512) {
            const int seq = gid >> 11, e = (gid >> 4) & 127, dq = gid & 15, dir = seq & 1;
            f32x4 S = {0.f, 0.f, 0.f, 0.f};
            const bf16_t* ub = UB + ((size_t)seq * 36 * 128 + e) * 64 + 4 * dq; const float* dvp = DV + (size_t)seq * 36 * 64 + 4 * dq;
            bf16_t* stp = ST + ((size_t)seq * 32 * 128 + e) * 64 + 4 * dq;
            u32x2 ua[6], ub2[6]; f32x4 da[6], db[6];
#define G2_LOAD(U_, D_, p0_) do { _Pragma("unroll") for (int i = 0; i < 6; ++i) { const int p = (p0_) + i, cc = dir ? (p < 4 ? 3 - p : 39 - p) : p; \
                U_[i] = *(const u32x2*)(ub + cc * (128 * 64)); D_[i] = *(const f32x4*)(dvp + cc * 64); } } while (0)
#define G2_SCAN(U_, D_, p0_) do { _Pragma("unroll") for (int i = 0; i < 6; ++i) { const int p = (p0_) + i, cc = dir ? (p < 4 ? 3 - p : 39 - p) : p; \
                if (cc >= 4) st4bf(stp + (cc - 4) * (128 * 64), S); \
                S = D_[i] * S + (f32x4){bflo(U_[i].x), bfhi(U_[i].x), bflo(U_[i].y), bfhi(U_[i].y)}; } } while (0)
            G2_LOAD(ua, da, 0);
#pragma unroll 1
            for (int p0 = 0; p0 < 36; p0 += 12) {
                G2_LOAD(ub2, db, p0 + 6);
                CvtRegs CR; cvs.issue(CR);
                G2_SCAN(ua, da, p0);
                if (p0 + 12 < 36) G2_LOAD(ua, da, p0 + 12);
                G2_SCAN(ub2, db, p0 + 6);
                cvs.finish(CR);
            }
#undef G2_LOAD
#undef G2_SCAN
        }
    }
    SEAM(4);

    if (IN(5)) {
        gla_g3_phase(cvs, G, bx, GQ, GK, GV, LAF, LAB, ST, GR, gla_norm, OG, lds, tid, lane, wave);
    }
    SEAM(5);

    if (IN(6)) {
        PlainSched S; S.G = G; S.c = bx; S.nM = 64; S.nN = 4; S.K = 1024; S.eb = 1; S.A = (const char*)AO; S.Bt = (const char*)WBA;
        EpiMerge1 E{GA, GG, (unsigned char*)Yb};
        pg8::gemm_phase<EpiMerge1, PlainSched, true, true>(lds, 1024, S, E);
    }
    SEAM(6);

    if (IN(7)) {
        PlainSched S; S.G = G; S.c = bx; S.nM = 64; S.nN = 4; S.K = 1024; S.eb = 1; S.A = (const char*)Yb; S.Bt = (const char*)WOUT;
        EpiMerge2 E{x, MOD, X1b};
        pg8::gemm_phase<EpiMerge2, PlainSched, true, true>(lds, 1024, S, E);
    }
    SEAM(7);

    if (IN(8)) {
        LAS float* wrt = (LAS float*)lds;
        LAS int* lcnt = (LAS int*)(lds + XTRA_OFF);
        LAS int* lbase = lcnt + 32; LAS int* lexp = lcnt + 64; LAS int* lrank = lexp + 256; LAS float* lwt = (LAS float*)(lrank + 256);
        LAS float* rsd = (LAS float*)(lds + XTRA_OFF + 3584);
        LAS float* lg = (LAS float*)(lds + XTRA_OFF + 4096);
        const float* RB = (const float*)(ws + O_ROPE + 16384);
        for (int rb = bx; rb < M / 64; rb += G) {
            const float* md = MOD + ((rb * 64) >> 11) * 6144;
            int zz; asm volatile("v_mov_b32 %0, 0" : "=v"(zz));
            const int tz = tid + zz, lz = lane + zz;
            CvtRegs CR; cvs.issue(CR);
            if (tid < 32) lcnt[tid] = 0;
#pragma unroll
            for (int cc = 0; cc < 2; ++cc) {
                const int col = tz + 512 * cc; const float gsc = norm2[col] * (1.f + md[4 * 1024 + col]);
#pragma unroll
                for (int q = 0; q < 8; ++q) { const f32x4 w = *(const f32x4*)(w_router + (size_t)col * 32 + 4 * q);
#pragma unroll
                    for (int j = 0; j < 4; ++j) { const int e = 4 * q + j; wrt[e * 1024 + (col ^ ((e & 15) << 2))] = w[j] * gsc; } }
            }
            cvs.finish(CR);
            LDS_BAR();
            cvs.issue(CR);
            {
                f32x4 Gc[4], Sh[4];
#pragma unroll
                for (int j = 0; j < 4; ++j) { const int c = 4 * lz + 256 * j; const f32x4 g = *(const f32x4*)(norm2 + c), sc = *(const f32x4*)(md + 4 * 1024 + c); Sh[j] = *(const f32x4*)(md + 3 * 1024 + c); Gc[j] = g * (sc + 1.f); }
                u32x2 vn[4];
#pragma unroll
                for (int j = 0; j < 4; ++j) vn[j] = *(const u32x2*)(X1b + (size_t)(rb * 64 + wave * 8) * D + 4 * lane + 256 * j);
#pragma unroll 2
                for (int i = 0; i < 8; ++i) {
                    const int rl = wave * 8 + i, m = rb * 64 + rl;
                    f32x4 v[4]; float ss = 0.f;
#pragma unroll
                    for (int j = 0; j < 4; ++j) { v[j] = (f32x4){bflo(vn[j].x), bfhi(vn[j].x), bflo(vn[j].y), bfhi(vn[j].y)}; ss += (v[j].x * v[j].x + v[j].y * v[j].y) + (v[j].z * v[j].z + v[j].w * v[j].w); }
                    if (i < 7) {
#pragma unroll
                        for (int j = 0; j < 4; ++j) vn[j] = *(const u32x2*)(X1b + (size_t)(m + 1) * D + 4 * lane + 256 * j);
                    }
                    const float rstd = rsqrtf(wave_sum_dpp(ss) * (1.f / D) + EPS);
                    if (lane == 0) rsd[rl] = rstd;
#pragma unroll
                    for (int j = 0; j < 4; ++j) { const f32x4 h = (v[j] * rstd) * Gc[j] + Sh[j]; *(unsigned*)(H2 + (size_t)m * D + 4 * lane + 256 * j) = pk4_fp8(h.x, h.y, h.z, h.w); }
                }
            }
            cvs.finish(CR);
            {
                const int rg = wave & 3, kh = wave >> 2, li = lz & 15, kq = lz >> 4;
                const bf16_t* xp = X1b + (size_t)(rb * 64 + rg * 16 + li) * D + kh * 512 + 8 * kq;
                u32x4 xa[16];
#pragma unroll
                for (int sI = 0; sI < 16; ++sI) xa[sI] = *(const u32x4*)(xp + 32 * sI);
                f32x4 a0 = {0.f, 0.f, 0.f, 0.f}, a1 = {0.f, 0.f, 0.f, 0.f};
                const LAS float* w0 = wrt + li * 1024; const LAS float* w1 = w0 + 16 * 1024;
#pragma unroll
                for (int sI = 0; sI < 16; ++sI) {
                    const int grp = kh * 128 + 8 * sI + 2 * kq, g0 = (grp ^ li) * 4, g1 = ((grp + 1) ^ li) * 4;
                    const f32x4 b00 = *(const LAS f32x4*)(w0 + g0), b01 = *(const LAS f32x4*)(w0 + g1), b10 = *(const LAS f32x4*)(w1 + g0), b11 = *(const LAS f32x4*)(w1 + g1);
                    const u32x4 xw = xa[sI];
                    const float xv[8] = {bflo(xw.x), bfhi(xw.x), bflo(xw.y), bfhi(xw.y), bflo(xw.z), bfhi(xw.z), bflo(xw.w), bfhi(xw.w)};
#pragma unroll
                    for (int t = 0; t < 4; ++t) { a0 = __builtin_amdgcn_mfma_f32_16x16x4f32(b00[t], xv[t], a0, 0, 0, 0); a1 = __builtin_amdgcn_mfma_f32_16x16x4f32(b10[t], xv[t], a1, 0, 0, 0); }
#pragma unroll
                    for (int t = 0; t < 4; ++t) { a0 = __builtin_amdgcn_mfma_f32_16x16x4f32(b01[t], xv[4 + t], a0, 0, 0, 0); a1 = __builtin_amdgcn_mfma_f32_16x16x4f32(b11[t], xv[4 + t], a1, 0, 0, 0); }
                }
                cvs.issue(CR);
                LAS float* lrow = lg + (rg * 16 + li) * 32 + 4 * kq;
                if (kh == 1) { *(LAS f32x4*)lrow = a0; *(LAS f32x4*)(lrow + 16) = a1; }
                LDS_BAR();
                if (kh == 0) {
                    const float r = rsd[rg * 16 + li]; const float* rbp = RB + ((rb * 64) >> 11) * 32 + 4 * kq;
                    const f32x4 p0 = *(const LAS f32x4*)lrow, p1 = *(const LAS f32x4*)(lrow + 16), c0 = *(const f32x4*)rbp, c1 = *(const f32x4*)(rbp + 16);
                    *(LAS f32x4*)lrow = (a0 + p0) * r + c0; *(LAS f32x4*)(lrow + 16) = (a1 + p1) * r + c1;
                }
                LDS_BAR();
            }
            if (lane < 8) {
                const int rl = wave * 8 + lane, m = rb * 64 + rl;
                float l[32];
#pragma unroll
                for (int q = 0; q < 8; ++q) { const f32x4 t4 = *(const LAS f32x4*)(lg + rl * 32 + 4 * q); l[4 * q] = t4.x; l[4 * q + 1] = t4.y; l[4 * q + 2] = t4.z; l[4 * q + 3] = t4.w; }
                float tv[4]; int ti[4]; unsigned taken = 0u;
#pragma unroll
                for (int k = 0; k < 4; ++k) {
                    float best = -INFINITY; int bi = 0;
#pragma unroll
                    for (int e = 0; e < 32; ++e) { const bool ok = !((taken >> e) & 1u) && (l[e] > best); best = ok ? l[e] : best; bi = ok ? e : bi; }
                    tv[k] = best; ti[k] = bi; taken |= 1u << bi;
                }
                const float e1 = __expf(tv[1] - tv[0]), e2 = __expf(tv[2] - tv[0]), e3 = __expf(tv[3] - tv[0]); const float inv = 1.f / (1.f + e1 + e2 + e3);
                const float wv[4] = {inv, e1 * inv, e2 * inv, e3 * inv};
#pragma unroll
                for (int k = 0; k < 4; ++k) { WTS[m * 4 + k] = wv[k]; lwt[rl * 4 + k] = wv[k]; lexp[rl * 4 + k] = ti[k]; lrank[rl * 4 + k] = atomicAdd((int*)&lcnt[ti[k]], 1); }
            }
            LDS_BAR();
            if (tid < 32) lbase[tid] = (int)atomicAdd(ctl + CW_CNT + 64 * tid, (unsigned)lcnt[tid]);
            __syncthreads();
            if (tid < 256) { const int ex = lexp[tid], pos = ex * LISTCAP + lbase[ex] + lrank[tid]; LIST[pos] = (rb * 64) * 4 + tid; WL[pos] = lwt[tid]; }
            cvs.finish(CR);
            __syncthreads();
        }
        while (cvs.pending()) { CvtRegs CR2; cvs.issue(CR2); cvs.finish(CR2); }
    }
    SEAM(8);

    if (IN(9) || IN(10)) {
        LAS int* TT = (LAS int*)(lds + XTRA_OFF);
        __syncthreads();
        if (tid < NE) { const int c = (int)__hip_atomic_load(ctl + CW_CNT + 64 * tid, __ATOMIC_RELAXED, __HIP_MEMORY_SCOPE_AGENT); TT[1 + tid] = c; TT[33 + tid] = (c + 255) >> 8; }
        __syncthreads();
        {
            int pre = 0, myent = -1;
            for (int e = 0; e < NE; ++e) { const int n = TT[33 + e]; if (tid >= pre && tid < pre + n) myent = e | ((tid - pre) << 8); pre += n; }
            __syncthreads();
            if (myent >= 0) TT[64 + tid] = myent;
            if (tid == 0) TT[0] = pre;
        }
        __syncthreads();
        if (IN(9)) {
            MoeSched<true, 3> S; S.G = G; S.cv = vcu; S.TT = TT; S.A = (const char*)H2; S.Bt = (const char*)W1; S.b_estride = (size_t)2048 * 1024; S.LIST = LIST;
            EpiMoe1 E{b_e1, ACT};
            pg8::gemm_phase<EpiMoe1, MoeSched<true, 3>, true, true>(lds, 1024, S, E);
        }
        SEAM(9);
        if (IN(10)) {
            MoeSched<false, 2> S; S.G = G; S.cv = vcu; S.TT = TT; S.A = (const char*)ACT; S.Bt = (const char*)W2; S.b_estride = (size_t)1024 * 1024; S.LIST = LIST;
            EpiMoe2 E{b_e2, LIST, WL, YS};
            pg8::gemm_phase<EpiMoe2, MoeSched<false, 2>, true, true>(lds, 1024, S, E);
        }
    }
    SEAM(10);

    if (IN(11)) {
        f32x4 xn[4]; int yn[4][4];
#define P11_LOAD(m_) do { _Pragma("unroll") for (int j = 0; j < 4; ++j) { const int c_ = 4 * lane + 256 * j; { const u32x2 w_ = *(const u32x2*)(X1b + (size_t)(m_) * D + c_); xn[j] = (f32x4){bflo(w_.x), bfhi(w_.x), bflo(w_.y), bfhi(w_.y)}; } \
            _Pragma("unroll") for (int k = 0; k < 4; ++k) yn[j][k] = *(const int*)(YS + (size_t)((m_) * 4 + k) * D + c_); } } while (0)
        if (gw < M) P11_LOAD(gw);
        for (int m = gw; m < M; m += NGW) {
            const float* md = MOD + (m >> 11) * 6144 + 5 * 1024;
            f32x4 xv[4]; int yv[4][4];
#pragma unroll
            for (int j = 0; j < 4; ++j) { xv[j] = xn[j];
#pragma unroll
                for (int k = 0; k < 4; ++k) yv[j][k] = yn[j][k]; }
            if (m + NGW < M) P11_LOAD(m + NGW);
#pragma unroll
            for (int j = 0; j < 4; ++j) { const int c = 4 * lane + 256 * j;
                f32x4 s = {0.f, 0.f, 0.f, 0.f};
#pragma unroll
                for (int k = 0; k < 4; ++k) { const f32x2 lo = __builtin_amdgcn_cvt_pk_f32_fp8(yv[j][k], false), hi = __builtin_amdgcn_cvt_pk_f32_fp8(yv[j][k], true); s = s + (f32x4){lo.x, lo.y, hi.x, hi.y}; }
                s = s * (1.f / YS8_SCALE);
                const f32x4 g = *(const f32x4*)(md + c);
                *(f32x4*)(out + (size_t)m * D + c) = xv[j] + g * s; }
        }
#undef P11_LOAD
    }
#undef IN
#undef SEAM
}

extern "C" void kernel_launch(void* const* d_in, const int* in_sizes, int n_in, void* d_out, int out_size, void* d_ws, size_t ws_size, hipStream_t stream) {
    static int grid = 0;
    if (grid == 0) {
        if (n_in != 26 || out_size != M * D || ws_size < WS_END) { fprintf(stderr, "kernel_launch: unexpected shapes (n_in %d, out %d, ws %zu < %zu)\n", n_in, out_size, ws_size, (size_t)WS_END); grid = -1; return; }
        int dev = 0, cus = 0, per_cu = 0;
        if (hipGetDevice(&dev) != hipSuccess || hipDeviceGetAttribute(&cus, hipDeviceAttributeMultiprocessorCount, dev) != hipSuccess) { grid = -1; return; }
        if (hipFuncSetAttribute((const void*)fwd_kernel, hipFuncAttributeMaxDynamicSharedMemorySize, LDS_BYTES) != hipSuccess) { fprintf(stderr, "kernel_launch: hipFuncSetAttribute failed\n"); grid = -1; return; }
        if (hipOccupancyMaxActiveBlocksPerMultiprocessor(&per_cu, (const void*)fwd_kernel, 512, LDS_BYTES) != hipSuccess || per_cu < 1) fprintf(stderr, "kernel_launch: occupancy query reports %d\n", per_cu);
        (void)hipGetLastError();
        grid = cus;
    }
    if (grid < 0) return;
    (void)hipMemsetAsync((char*)d_ws + O_CTL, 0, CTL_ZERO_BYTES, stream);
    Args a{};
    for (int i = 0; i < 26; ++i) a.in[i] = (const float*)d_in[i];
    a.out = (float*)d_out; a.ws = (unsigned char*)d_ws;
    a.ph_lo = 0; a.ph_hi = NPH; hipLaunchKernelGGL(fwd_kernel, dim3(grid), dim3(512), LDS_BYTES, stream, a);
}
```

```cpp
#include <hip/hip_runtime.h>
#include <cstdio>
#include <cstdint>

#define DI __device__ __forceinline__
#define GAS __attribute__((address_space(1)))
#define LAS __attribute__((address_space(3)))
typedef unsigned short bf16_t;
typedef short bf16x8 __attribute__((ext_vector_type(8)));
typedef float f32x4 __attribute__((ext_vector_type(4)));
typedef float f32x2 __attribute__((ext_vector_type(2)));
typedef unsigned u32x4 __attribute__((ext_vector_type(4)));
typedef unsigned u32x2 __attribute__((ext_vector_type(2)));
typedef __bf16 bf16x2_t __attribute__((ext_vector_type(2)));
typedef int i32x8 __attribute__((ext_vector_type(8)));
typedef int i32x4 __attribute__((ext_vector_type(4)));


constexpr int D = 1024, NB = 8, T = 2048, LC = 256;
constexpr int M = NB * T;
constexpr int MC = NB * LC;
constexpr int MT = M + MC;
constexpr int NIN = 4864;
constexpr int CIN = 4384;
constexpr int NE = 32, TOPK = 4, DFF = 1024;
constexpr float EPS = 1e-6f;
constexpr float LOG2E = 1.4426950408889634f;
constexpr float QSCALE = 0.125f * LOG2E;
constexpr int LISTCAP = 16384;
constexpr int ACT_ROWS = 73728;

constexpr size_t al64k(size_t x) { return (x + 65535) & ~(size_t)65535; }
constexpr size_t O_CTL = 0;
constexpr size_t O_MOD = 1u << 20;
constexpr size_t CTL_ZERO_BYTES = (1u << 20) + 9 * 6144 * 4;
constexpr size_t O_ROPE = O_MOD + al64k(9 * 6144 * 4);
constexpr size_t O_WTS = O_ROPE + al64k(2 * 64 * 16 * 4);
constexpr size_t O_LIST = O_WTS + al64k(65536 * 4);
constexpr size_t O_WL = O_LIST + al64k((size_t)NE * LISTCAP * 4);
constexpr size_t O_WIN = O_WL + al64k((size_t)NE * LISTCAP * 4);
constexpr size_t O_WBA = O_WIN + al64k((size_t)NIN * 1024 * 2);
constexpr size_t O_WBG = O_WBA + al64k(1024 * 1024 * 2);
constexpr size_t O_WOUT = O_WBG + al64k(1024 * 512 * 2);
constexpr size_t O_W1 = O_WOUT + al64k(1024 * 1024 * 2);
constexpr size_t O_W2 = O_W1 + al64k((size_t)NE * 2048 * 1024 * 2);
constexpr size_t O_HN = O_W2 + al64k((size_t)NE * 1024 * 1024 * 2);
constexpr size_t O_Q = O_HN + al64k((size_t)MT * 1024 * 2);
constexpr size_t O_K = O_Q + al64k((size_t)M * 512 * 2);
constexpr size_t O_V = O_K + al64k((size_t)MT * 128 * 2);
constexpr size_t O_GQ = O_V + al64k((size_t)MT * 128 * 2);
constexpr size_t O_GK = O_GQ + al64k((size_t)M * 256 * 2);
constexpr size_t O_GV = O_GK + al64k((size_t)MT * 256 * 2);
constexpr size_t O_LAF = O_GV + al64k((size_t)MT * 512 * 2);
constexpr size_t O_LAB = O_LAF + al64k((size_t)MT * 256 * 4);
constexpr size_t O_GR = O_LAB + al64k((size_t)MT * 256 * 4);
constexpr size_t O_GA = O_GR + al64k((size_t)M * 512 * 2);
constexpr size_t O_GG = O_GA + al64k((size_t)M * 1024 * 2);
constexpr size_t O_AO = O_GG + al64k((size_t)M * 1024 * 2);
constexpr size_t O_UB = O_AO + al64k((size_t)M * 1024 * 2);
constexpr size_t O_DV = O_UB + al64k((size_t)64 * 36 * 128 * 64 * 2);
constexpr size_t O_ST = O_DV + al64k((size_t)64 * 36 * 64 * 4);
constexpr size_t O_OG = O_ST + al64k((size_t)64 * 32 * 128 * 64 * 2);
constexpr size_t O_X1 = O_OG + al64k((size_t)M * 512 * 2);
constexpr size_t O_Y = O_X1 + al64k((size_t)M * 1024 * 4);
constexpr size_t O_H2 = O_Y + al64k((size_t)M * 1024 * 2);
constexpr size_t O_ACT = O_H2 + al64k((size_t)M * 1024 * 2);
constexpr size_t O_YS = O_ACT + al64k((size_t)ACT_ROWS * 1024 * 2);
constexpr size_t WS_END = O_YS + al64k((size_t)65536 * 1024 * 2);
static_assert(WS_END <= (size_t)1 << 30, "workspace map exceeds 1 GiB");
constexpr int CW_TMO = 0;
constexpr int CW_BAR = 4096;
constexpr int CW_CNT = 16384;
constexpr int CW_MODF = 20480;
constexpr int MOD_ITEMS = 192;

constexpr int RING_BYTES = 131072;
constexpr int XTRA_OFF = RING_BYTES, XTRA_BYTES = 16384;
constexpr int MISC_OFF = XTRA_OFF + XTRA_BYTES;
constexpr int LDS_BYTES = MISC_OFF + 256;
static_assert(LDS_BYTES <= 163840, "LDS");

DI float bf2f(bf16_t h) { return __uint_as_float((unsigned)h << 16); }
DI unsigned pk2(float lo, float hi) { f32x2 v = {lo, hi}; bf16x2_t b = __builtin_convertvector(v, bf16x2_t); return __builtin_bit_cast(unsigned, b); }
DI bf16_t f2bf(float f) { return (bf16_t)(pk2(f, 0.f) & 0xffffu); }
DI float bflo(unsigned w) { return __uint_as_float(w << 16); }
DI float bfhi(unsigned w) { return __uint_as_float(w & 0xffff0000u); }
DI float sigmoidf_(float x) { return 1.f / (1.f + __expf(-x)); }
DI float clamp8(float x) { return __builtin_amdgcn_fmed3f(x, -448.f, 448.f); }
DI unsigned pk4_fp8(float a, float b, float c, float d) { int w = 0; w = __builtin_amdgcn_cvt_pk_fp8_f32(clamp8(a), clamp8(b), w, false); w = __builtin_amdgcn_cvt_pk_fp8_f32(clamp8(c), clamp8(d), w, true); return (unsigned)w; }
constexpr float W8_SCALE = 32.f, ACT8_SCALE = 4.f, YS8_SCALE = 16.f, MIX8_SCALE = 4.f;
#define DPP_ADD(v, ctrl, rmask) ((v) + __builtin_bit_cast(float, __builtin_amdgcn_update_dpp(0, __builtin_bit_cast(int, (v)), (ctrl), (rmask), 0xf, true)))
DI float wave_sum_dpp(float v) {
    v = DPP_ADD(v, 0xB1, 0xf); v = DPP_ADD(v, 0x4E, 0xf); v = DPP_ADD(v, 0x141, 0xf); v = DPP_ADD(v, 0x140, 0xf);
    v = DPP_ADD(v, 0x142, 0xa); v = DPP_ADD(v, 0x143, 0xc);
    return __builtin_bit_cast(float, __builtin_amdgcn_readlane(__builtin_bit_cast(int, v), 63));
}
DI float max_nc(float a, float b) { float r; asm("v_max_f32_e32 %0, %1, %2" : "=v"(r) : "v"(a), "v"(b)); return r; }
DI float max3_nc(float a, float b, float c) { float r; asm("v_max3_f32 %0, %1, %2, %3" : "=v"(r) : "v"(a), "v"(b), "v"(c)); return r; }
DI float xmax16(float m) { const auto r = __builtin_amdgcn_permlane16_swap(__float_as_uint(m), __float_as_uint(m), false, false); return max_nc(__uint_as_float(r[0]), __uint_as_float(r[1])); }
DI float xmax32(float m) { const auto r = __builtin_amdgcn_permlane32_swap(__float_as_uint(m), __float_as_uint(m), false, false); return max_nc(__uint_as_float(r[0]), __uint_as_float(r[1])); }
DI float xadd16(float m) { const auto r = __builtin_amdgcn_permlane16_swap(__float_as_uint(m), __float_as_uint(m), false, false); return __uint_as_float(r[0]) + __uint_as_float(r[1]); }
DI float xadd32(float m) { const auto r = __builtin_amdgcn_permlane32_swap(__float_as_uint(m), __float_as_uint(m), false, false); return __uint_as_float(r[0]) + __uint_as_float(r[1]); }
#define LDS_WAIT() asm volatile("s_waitcnt lgkmcnt(0)" ::: "memory")
#define LDS_BAR() asm volatile("s_waitcnt lgkmcnt(0)\n\ts_barrier" ::: "memory")
#define VM_WAIT() asm volatile("s_waitcnt vmcnt(0)" ::: "memory")

#define XB_TMO      128
#define XB_XCNT(j)  (256  + 64 * (j))
#define XB_XSUB(j)  (1280 + 64 * (j))
#define XB_XGEN(j)  (2304 + 64 * (j))
#define XB_TOP      3328
#define XB_TOPGEN   3392
#define XCD_BAR_WORDS 3456
#define XB_SPIN_CAP (1u << 18)
DI unsigned xb_ld(unsigned* p)              { return __hip_atomic_load(p, __ATOMIC_RELAXED, __HIP_MEMORY_SCOPE_AGENT); }
DI unsigned xb_add(unsigned* p, unsigned v) { return __hip_atomic_fetch_add(p, v, __ATOMIC_RELAXED, __HIP_MEMORY_SCOPE_AGENT); }
DI unsigned xb_xcc_id() { return (unsigned)__builtin_amdgcn_s_getreg((3 << 11) | 20) & 0xFu; }
#define XB_SPIN(cond, bar) do { unsigned _sp = 0; while (cond) { __builtin_amdgcn_s_sleep(1); \
    if ((++_sp & 255u) == 0u) { if (xb_ld(&(bar)[XB_TMO])) break; if (_sp > XB_SPIN_CAP) { atomicAdd(&(bar)[XB_TMO], 1u); break; } } } } while (0)
struct XcdBarrier { unsigned* bar; unsigned x; volatile LAS unsigned* st; };
DI XcdBarrier xcd_barrier_post(unsigned* bar, volatile LAS unsigned* st) {
    XcdBarrier b; b.bar = bar; b.x = xb_xcc_id(); b.st = st;
    if (threadIdx.x == 0) (void)xb_add(&bar[XB_XCNT(b.x)], 1u);
    return b;
}
DI void xcd_barrier_complete(unsigned* bar, unsigned x, unsigned& nloc, unsigned& nx) {
    const unsigned G = gridDim.x * gridDim.y * gridDim.z;
    unsigned sum, cnt, mine, sp = 0u;
    for (;;) {
        sum = 0u; cnt = 0u; mine = 0u;
#pragma unroll
        for (unsigned j = 0; j < 16; ++j) { const unsigned c = xb_ld(&bar[XB_XCNT(j)]); sum += c; cnt += (c > 0u) ? 1u : 0u; mine = (j == x) ? c : mine; }
        if (sum == G) break;
        __builtin_amdgcn_s_sleep(1);
        if ((++sp & 255u) == 0u) { if (xb_ld(&bar[XB_TMO])) break; if (sp > XB_SPIN_CAP) { atomicAdd(&bar[XB_TMO], 1u); break; } }
    }
    nloc = mine > 0u ? mine : 1u; nx = cnt > 0u ? cnt : 1u;
}
DI void xcd_barrier(const XcdBarrier& b) {
    asm volatile("s_waitcnt vmcnt(0)" ::: "memory");
    __syncthreads();
    if (threadIdx.x == 0) {
        unsigned* bar = b.bar;
        __builtin_amdgcn_s_waitcnt(0);
        unsigned nloc = b.st[0], nx = b.st[1];
        if (nloc == 0u) { xcd_barrier_complete(bar, b.x, nloc, nx); b.st[0] = nloc; b.st[1] = nx; }
        const unsigned old = xb_add(&bar[XB_XSUB(b.x)], 1u);
        const unsigned gen = old / nloc;
        if (old + 1u == (gen + 1u) * nloc) {
            __builtin_amdgcn_fence(__ATOMIC_RELEASE, "agent");
            asm volatile("s_waitcnt vmcnt(0)" ::: "memory");
            const unsigned og = xb_add(&bar[XB_TOP], 1u);
            const unsigned tg = og / nx;
            if (og + 1u != (tg + 1u) * nx) XB_SPIN(xb_ld(&bar[XB_TOP]) < (tg + 1u) * nx, bar);
            __builtin_amdgcn_fence(__ATOMIC_ACQUIRE, "agent");
            xb_add(&bar[XB_XGEN(b.x)], 1u);
            asm volatile("s_waitcnt vmcnt(0)" ::: "memory");
        } else {
            XB_SPIN(xb_ld(&bar[XB_XGEN(b.x)]) == gen, bar);
            asm volatile("buffer_inv sc0" ::: "memory");
            asm volatile("s_waitcnt vmcnt(0)" ::: "memory");
        }
    }
    __syncthreads();
}

namespace pg8 {
constexpr int BM = 256, BK = 64, HALF = 128, HTB = HALF * BK * 2, STAGE_BYTES = 8 * HTB, NXCD = 8, WGM = 8;
__host__ __device__ __forceinline__ int lds_byte(int r, int c) { const int st = (r >> 4) * 2 + (c >> 5), rr = r & 15, cc = c & 31, ob = rr * 64 + cc * 2; return st * 1024 + (ob ^ (((ob >> 9) & 1) << 5)); }
__host__ __device__ __forceinline__ void stage_rc(int b, int& R, int& C) { const int st = b / 1024, sb = b % 1024, swz = sb ^ (((sb >> 9) & 1) << 5); R = (st >> 1) * 16 + swz / 64; C = (st & 1) * 32 + (swz % 64) / 2; }
struct Unit { int pm, pn, e, tl, cnt; };
DI void tile_order(int L, int nM, int nN, int& pm, int& pn) {
    const int nwg = nM * nN; int wgid = L;
    { const int q = nwg / NXCD, r = nwg % NXCD, xcd = wgid % NXCD, off = wgid / NXCD; wgid = (xcd < r ? xcd * (q + 1) : r * (q + 1) + (xcd - r) * q) + off; }
    const int nig = WGM * nN, gid = wgid / nig, fm = gid * WGM, gsz = (nM - fm) < WGM ? (nM - fm) : WGM;
    pm = fm + ((wgid % nig) % gsz); pn = (wgid % nig) / gsz;
}
template <class Epi, class Sched, bool ALIGN_EPI, bool FP8 = false>
DI void gemm_phase(LAS unsigned char* lds, const int K, const Sched& S, const Epi& E) {
    const int tid = threadIdx.x, wid = __builtin_amdgcn_readfirstlane(tid >> 6), lane = tid & 63, wr = wid >> 2, wc = wid & 3, fr = lane & 15, fq = lane >> 4;
    const int rowb = FP8 ? K : 2 * K;
    const int nt = rowb / 128;
    int Rr[2], Cc[2]; unsigned voffB[2];
#pragma unroll
    for (int i = 0; i < 2; ++i) { int R, C; stage_rc(tid * 16 + i * 8192, R, C); Rr[i] = R; Cc[i] = C; voffB[i] = (unsigned)(R * rowb + C * 2); }
    const size_t kstep = (size_t)(BK * 2);
    const size_t hstep = (size_t)HALF * rowb;
    const unsigned ldsw = (unsigned)wid * 1024u;
    const int aoff = lds_byte(wr * 64 + fr, fq * 8), boff = lds_byte(wc * 32 + fr, fq * 8);
#define PG8_SA(b, h) (((b) * 2 + (h)) * HTB)
#define PG8_SB(b, h) ((4 + (b) * 2 + (h)) * HTB)
#define PG8_STAGE(bufoff, gbase, voff) do { _Pragma("unroll") for (int _i = 0; _i < 2; ++_i) \
        __builtin_amdgcn_global_load_lds((const unsigned*)((const char*)(gbase) + (voff)[_i]), (LAS unsigned*)(lds + (bufoff) + ldsw + _i * 8192), 16, 0, 0); } while (0)
#define PG8_LD2(base) __builtin_shufflevector(*(const LAS i32x4*)(base), *(const LAS i32x4*)((base) + 1024), 0, 1, 2, 3, 4, 5, 6, 7)
#define PG8_LDA(dst, b, h) do { if constexpr (FP8) { _Pragma("unroll") for (int m = 0; m < 4; ++m) dst##8[m] = PG8_LD2(lds + PG8_SA(b, h) + aoff + m * 2048); } \
        else { _Pragma("unroll") for (int m = 0; m < 4; ++m) _Pragma("unroll") for (int k = 0; k < 2; ++k) dst[m][k] = *(const LAS bf16x8*)(lds + PG8_SA(b, h) + aoff + m * 2048 + k * 1024); } } while (0)
#define PG8_LDB(dst, b, h) do { if constexpr (FP8) { _Pragma("unroll") for (int n = 0; n < 2; ++n) dst##8[n] = PG8_LD2(lds + PG8_SB(b, h) + boff + n * 2048); } \
        else { _Pragma("unroll") for (int n = 0; n < 2; ++n) _Pragma("unroll") for (int k = 0; k < 2; ++k) dst[n][k] = *(const LAS bf16x8*)(lds + PG8_SB(b, h) + boff + n * 2048 + k * 1024); } } while (0)
#define PG8_CAT(x) __builtin_shufflevector(__builtin_bit_cast(i32x4, (x)[0]), __builtin_bit_cast(i32x4, (x)[1]), 0, 1, 2, 3, 4, 5, 6, 7)
#define PG8_MMA(ai, bj, At, Bt) do { __builtin_amdgcn_s_setprio(1); \
        if constexpr (FP8) { _Pragma("unroll") for (int m = 0; m < 4; ++m) _Pragma("unroll") for (int n = 0; n < 2; ++n) \
            asm volatile("v_mfma_scale_f32_16x16x128_f8f6f4 %0, %1, %2, %0, %3, %3 op_sel_hi:[0,0,0]" : "+v"(acc[ai][bj][m][n]) : "v"(Bt##8[n]), "v"(At##8[m]), "v"(sc8)); } \
        else { _Pragma("unroll") for (int m = 0; m < 4; ++m) _Pragma("unroll") for (int n = 0; n < 2; ++n) _Pragma("unroll") for (int k = 0; k < 2; ++k) \
            acc[ai][bj][m][n] = __builtin_amdgcn_mfma_f32_16x16x32_bf16(Bt[n][k], At[m][k], acc[ai][bj][m][n], 0, 0, 0); } \
        __builtin_amdgcn_s_setprio(0); } while (0)
#define PG8_WAIT_V(n) asm volatile("s_waitcnt vmcnt(" #n ")" ::: "memory")
#define PG8_WAIT_L(n) asm volatile("s_waitcnt lgkmcnt(" #n ")" ::: "memory")
#define PG8_WAIT_VX() do { if constexpr (Epi::RELAX == 8) { if (t == 0 && relax) PG8_WAIT_V(16); else PG8_WAIT_V(8); } else if constexpr (Epi::RELAX == 4) { if (t == 0 && relax) PG8_WAIT_V(12); else PG8_WAIT_V(8); } else if constexpr (Epi::RELAX == 16) { if (t == 0 && relax) PG8_WAIT_V(24); else PG8_WAIT_V(8); } else PG8_WAIT_V(8); } while (0)
#define PG8_BAR __builtin_amdgcn_s_barrier()
#define PG8_SCHED __builtin_amdgcn_sched_barrier(0)
    Unit cur, nxt; int ui = 0, relax = 0;
    if (!S.next(0, cur)) return;
    f32x4 acc[2][2][4][2];
#pragma unroll
    for (int a = 0; a < 2; ++a)
#pragma unroll
        for (int b = 0; b < 2; ++b)
#pragma unroll
            for (int m = 0; m < 4; ++m)
#pragma unroll
                for (int n = 0; n < 2; ++n) acc[a][b][m][n] = (f32x4){0.f, 0.f, 0.f, 0.f};
    const int sc8 = 0x7f7f7f7f;
    bf16x8 At[4][2], B0[2][2], B1[2][2]; i32x8 At8[4], B08[2], B18[2];
    unsigned oc0[2], oc1[2], on0[2], on1[2];
    S.a_offs(cur, Rr, Cc, rowb, oc0, oc1);
    const char* cA = S.a_base(cur); const char* cB = S.b_base(cur);
    PG8_STAGE(PG8_SB(0, 0), cB, voffB); PG8_STAGE(PG8_SB(0, 1), cB + hstep, voffB); PG8_STAGE(PG8_SA(0, 0), cA, oc0); PG8_STAGE(PG8_SA(0, 1), cA, oc1);
    if (wr == 1) PG8_BAR;
    PG8_WAIT_V(2); PG8_BAR;
    PG8_STAGE(PG8_SB(1, 0), cB + kstep, voffB); PG8_STAGE(PG8_SA(1, 0), cA + kstep, oc0); PG8_STAGE(PG8_SB(1, 1), cB + hstep + kstep, voffB);
    PG8_WAIT_V(6); PG8_BAR;
    for (;;) {
        const bool has_next = S.next(ui + 1, nxt);
        const char* nA = cA; const char* nB = cB;
        on0[0] = oc0[0]; on0[1] = oc0[1]; on1[0] = oc1[0]; on1[1] = oc1[1];
        if (has_next) { nA = S.a_base(nxt); nB = S.b_base(nxt); S.a_offs(nxt, Rr, Cc, rowb, on0, on1); }
        for (int t = 0; t < nt; t += 2) {
            if constexpr (Epi::MIDK != 0) { if (t == Epi::MIDK) E.mid(acc, cur, wr, wc, fr, fq); }
            const bool last = (t == nt - 2);
            const char* a1 = cA + (size_t)(t + 1) * kstep;
            const char* a2 = last ? nA : cA + (size_t)(t + 2) * kstep; const char* b2 = last ? nB : cB + (size_t)(t + 2) * kstep;
            const char* a3 = a2 + kstep; const char* b3 = b2 + kstep;
            PG8_LDB(B0, 0, 0); PG8_LDB(B1, 0, 1); PG8_SCHED; PG8_LDA(At, 0, 0); PG8_STAGE(PG8_SA(1, 1), a1, oc1);
            PG8_WAIT_VX(); PG8_WAIT_L(0); PG8_BAR; PG8_MMA(0, 0, At, B0); PG8_MMA(0, 1, At, B1); PG8_BAR; PG8_SCHED;
            PG8_LDA(At, 0, 1); PG8_STAGE(PG8_SB(0, 0), b2, voffB); PG8_STAGE(PG8_SB(0, 1), b2 + hstep, voffB); if (last) { PG8_STAGE(PG8_SA(0, 0), a2, on0); } else { PG8_STAGE(PG8_SA(0, 0), a2, oc0); }
            PG8_WAIT_VX(); PG8_WAIT_L(0); PG8_BAR; PG8_MMA(1, 0, At, B0); PG8_MMA(1, 1, At, B1); PG8_BAR; PG8_SCHED;
            PG8_LDB(B0, 1, 0); PG8_LDB(B1, 1, 1); PG8_SCHED; PG8_LDA(At, 1, 0); if (last) { PG8_STAGE(PG8_SA(0, 1), a2, on1); } else { PG8_STAGE(PG8_SA(0, 1), a2, oc1); }
            PG8_WAIT_V(8); PG8_WAIT_L(0); PG8_BAR; PG8_MMA(0, 0, At, B0); PG8_MMA(0, 1, At, B1); PG8_BAR; PG8_SCHED;
            PG8_LDA(At, 1, 1); PG8_STAGE(PG8_SB(1, 0), b3, voffB); PG8_STAGE(PG8_SB(1, 1), b3 + hstep, voffB); if (last) { PG8_STAGE(PG8_SA(1, 0), a3, on0); } else { PG8_STAGE(PG8_SA(1, 0), a3, oc0); }
            PG8_WAIT_V(8); PG8_WAIT_L(0); PG8_BAR; PG8_MMA(1, 0, At, B0); PG8_MMA(1, 1, At, B1); PG8_BAR; PG8_SCHED;
        }
        if constexpr (ALIGN_EPI) { if (wr == 0) PG8_BAR; }
        if constexpr (FP8) asm volatile("s_nop 15\n\ts_nop 15" ::: "memory");
        E(acc, cur, wr, wc, fr, fq); relax = 1;
        if (!has_next) break;
#pragma unroll
        for (int a = 0; a < 2; ++a)
#pragma unroll
            for (int b = 0; b < 2; ++b)
#pragma unroll
                for (int m = 0; m < 4; ++m)
#pragma unroll
                    for (int n = 0; n < 2; ++n) acc[a][b][m][n] = (f32x4){0.f, 0.f, 0.f, 0.f};
        cur = nxt; cA = nA; cB = nB; ++ui;
        oc0[0] = on0[0]; oc0[1] = on0[1]; oc1[0] = on1[0]; oc1[1] = on1[1];
        if constexpr (ALIGN_EPI) { if (wr == 1) PG8_BAR; }
    }
    PG8_WAIT_V(0);
    if constexpr (!ALIGN_EPI) { if (wr == 0) PG8_BAR; }
    PG8_BAR;
#undef PG8_SA
#undef PG8_SB
#undef PG8_STAGE
#undef PG8_LDA
#undef PG8_LDB
#undef PG8_MMA
#undef PG8_CAT
#undef PG8_LD2
#undef PG8_WAIT_V
#undef PG8_WAIT_L
#undef PG8_WAIT_VX
#undef PG8_BAR
#undef PG8_SCHED
}
}
using pg8::Unit;

DI int slot_std8(int L) { return (L & 0xE0) | (((L >> 2) & 1) << 4) | (((L >> 3) & 3) << 2) | (L & 3); }
DI int slot_head(int hh, int d) { return 128 * (d >> 5) + 32 * hh + (d & 31); }

struct SchedBase {
    DI void offs_plain(const int (&Rr)[2], const int (&Cc)[2], int rowb, unsigned (&o0)[2], unsigned (&o1)[2]) const {
#pragma unroll
        for (int i = 0; i < 2; ++i) { o0[i] = (unsigned)(Rr[i] * rowb + Cc[i] * 2); o1[i] = (unsigned)((Rr[i] + 128) * rowb + Cc[i] * 2); }
    }
};
struct InProjSched : SchedBase {
    int G, c; const char* A; const char* Bt;
    DI bool next(int i, Unit& u) const {
        const int L = i * G + c; if (L >= 752) return false;
        if (L < 704) pg8::tile_order(L, 64, 11, u.pm, u.pn); else { const int L2 = L - 704; u.pm = 64 + (L2 & 7); u.pn = 2 + (L2 >> 3); }
        u.e = 0; u.tl = 0; u.cnt = 0; return true;
    }
    DI const char* a_base(const Unit& u) const { return A + (size_t)u.pm * (256 * 1024 * 2); }
    DI const char* b_base(const Unit& u) const { return Bt + (size_t)u.pn * (256 * 1024 * 2); }
    DI void a_offs(const Unit&, const int (&Rr)[2], const int (&Cc)[2], int rowb, unsigned (&o0)[2], unsigned (&o1)[2]) const { offs_plain(Rr, Cc, rowb, o0, o1); }
};
struct PlainSched : SchedBase {
    int G, c, nM, nN, K, eb, split = 0; const char* A; const char* Bt;
    DI bool next(int i, Unit& u) const {
        int L;
        if (split) { if (c >= 80) { if (i >= 3) return false; L = (c - 80) + 144 * i; } else { if (i >= 1) return false; L = 432 + c; } }
        else L = i * G + c;
        if (L >= nM * nN) return false;
        pg8::tile_order(L, nM, nN, u.pm, u.pn); u.e = 0; u.tl = 0; u.cnt = 0; return true;
    }
    DI const char* a_base(const Unit& u) const { return A + (size_t)u.pm * 256 * K * eb; }
    DI const char* b_base(const Unit& u) const { return Bt + (size_t)u.pn * 256 * K * eb; }
    DI void a_offs(const Unit&, const int (&Rr)[2], const int (&Cc)[2], int rowb, unsigned (&o0)[2], unsigned (&o1)[2]) const { offs_plain(Rr, Cc, rowb, o0, o1); }
};
template <bool GATHER, int LOGNPN>
struct MoeSched : SchedBase {
    int G, cv; const LAS int* TT; const char* A; const char* Bt; size_t b_estride; const int* LIST;
    DI bool next(int i, Unit& u) const {
        const int ntl = __builtin_amdgcn_readfirstlane(TT[0]);
        const int per = (G & 7) ? G : (G >> 3), xq = cv / per, rr = cv - xq * per, T8 = (G & 7) ? ntl : ((ntl + 7) >> 3);
        const int ux = i * per + rr, tt = xq * T8 + (ux >> LOGNPN);
        if ((ux >> LOGNPN) >= T8 || tt >= ntl) return false;
        const int ent = __builtin_amdgcn_readfirstlane(TT[64 + tt]);
        u.pm = tt; u.pn = ux & ((1 << LOGNPN) - 1); u.e = ent & 255; u.tl = ent >> 8; u.cnt = __builtin_amdgcn_readfirstlane(TT[1 + u.e]); return true;
    }
    DI const char* a_base(const Unit& u) const { return GATHER ? A : A + (size_t)u.pm * (256 * 1024); }
    DI const char* b_base(const Unit& u) const { return Bt + (size_t)u.e * b_estride + (size_t)u.pn * (256 * 1024); }
    DI void a_offs(const Unit& u, const int (&Rr)[2], const int (&Cc)[2], int rowb, unsigned (&o0)[2], unsigned (&o1)[2]) const {
        if constexpr (!GATHER) { offs_plain(Rr, Cc, rowb, o0, o1); }
        else {
#pragma unroll
            for (int i = 0; i < 2; ++i) {
                const int p0 = 256 * u.tl + Rr[i], p1 = p0 + 128;
                const int l0 = LIST[u.e * LISTCAP + (p0 < u.cnt ? p0 : 0)], l1 = LIST[u.e * LISTCAP + (p1 < u.cnt ? p1 : 0)];
                const int s0 = (p0 < u.cnt) ? l0 : 0, s1 = (p1 < u.cnt) ? l1 : 0;
                o0[i] = (unsigned)((s0 >> 2) * rowb + Cc[i] * 2); o1[i] = (unsigned)((s1 >> 2) * rowb + Cc[i] * 2);
            }
        }
    }
};

typedef const f32x4 (&AccRef)[2][2][4][2];
DI void st8bf(bf16_t* p, f32x4 a, f32x4 b) { u32x4 w; w.x = pk2(a.x, a.y); w.y = pk2(a.z, a.w); w.z = pk2(b.x, b.y); w.w = pk2(b.z, b.w); *(u32x4*)p = w; }
DI void st4bf(bf16_t* p, f32x4 a) { u32x2 w; w.x = pk2(a.x, a.y); w.y = pk2(a.z, a.w); *(u32x2*)p = w; }
DI f32x2 sig2(f32x2 x) { const f32x2 t = x * (-LOG2E); f32x2 e; e.x = __builtin_amdgcn_exp2f(t.x); e.y = __builtin_amdgcn_exp2f(t.y); const f32x2 d = e + 1.0f; f32x2 r; r.x = __builtin_amdgcn_rcpf(d.x); r.y = __builtin_amdgcn_rcpf(d.y); return r; }
DI f32x4 sig4p(f32x4 v) { const f32x2 a = sig2((f32x2){v.x, v.y}), b = sig2((f32x2){v.z, v.w}); return (f32x4){a.x, a.y, b.x, b.y}; }
DI f32x4 silu4p(f32x4 v) { return v * sig4p(v); }
DI float logsig16(float z) { return (fminf(z, 0.f) - __logf(1.f + __expf(-fabsf(z)))) * 0.0625f; }

struct EpiInProj {
    static constexpr int MIDK = 0, RELAX = 0;
    bf16_t *Q, *Kb, *Vb, *GQ, *GK, *GV, *GR, *GA, *GG, *LAF, *LAB;
    const float *qn, *kn, *baf, *bab, *ropec, *ropes;
    DI void operator()(AccRef acc, const Unit& u, int wr, int wc, int fr, int fq) const {
        const int pn = u.pn, rowb = u.pm * 256 + wr * 64 + fr;
        if (pn <= 2) {
            const bool isV = (pn == 2 && wc >= 2), isK = (pn == 2 && wc < 2);
            const bool rope = (u.pm < 64) && !isV;
            const float* g = isK ? kn : qn;
            f32x4 gv[2][2];
#pragma unroll
            for (int bj = 0; bj < 2; ++bj)
#pragma unroll
                for (int n = 0; n < 2; ++n) gv[bj][n] = *(const f32x4*)(g + 32 * bj + 16 * n + 4 * fq);
            bf16_t* outp; int ld, colb;
            if (pn < 2) { outp = Q; ld = 512; colb = (4 * pn + wc) * 64; } else if (isK) { outp = Kb; ld = 128; colb = wc * 64; } else { outp = Vb; ld = 128; colb = (wc - 2) * 64; }
            const float osc = (pn < 2) ? QSCALE : 1.f;
#pragma unroll
            for (int ai = 0; ai < 2; ++ai) {
                f32x4 rcs[4][2], rsn[4][2];
                if (rope) {
#pragma unroll
                    for (int m = 0; m < 4; ++m) { const int t = (rowb + ai * 128 + m * 16) & (T - 1);
#pragma unroll
                        for (int bj = 0; bj < 2; ++bj) { const int pos = bj ? (t & 63) : (t >> 6); rcs[m][bj] = *(const f32x4*)(ropec + pos * 16 + 4 * fq); rsn[m][bj] = *(const f32x4*)(ropes + pos * 16 + 4 * fq); } }
                }
#pragma unroll
                for (int m = 0; m < 4; ++m) {
                    const int r = rowb + ai * 128 + m * 16;
                    f32x4 v[2][2];
#pragma unroll
                    for (int bj = 0; bj < 2; ++bj)
#pragma unroll
                        for (int n = 0; n < 2; ++n) v[bj][n] = acc[ai][bj][m][n];
                    if (!isV) {
                        float ss = 0.f;
#pragma unroll
                        for (int bj = 0; bj < 2; ++bj)
#pragma unroll
                            for (int n = 0; n < 2; ++n) ss += (v[bj][n].x * v[bj][n].x + v[bj][n].y * v[bj][n].y) + (v[bj][n].z * v[bj][n].z + v[bj][n].w * v[bj][n].w);
                        ss = xadd32(xadd16(ss));
                        const float rstd = __builtin_amdgcn_rsqf(ss * (1.f / 64.f) + EPS);
#pragma unroll
                        for (int bj = 0; bj < 2; ++bj)
#pragma unroll
                            for (int n = 0; n < 2; ++n) v[bj][n] = v[bj][n] * rstd * gv[bj][n];
                        if (rope) {
#pragma unroll
                            for (int bj = 0; bj < 2; ++bj) {
                                const f32x4 cs = rcs[m][bj], sn = rsn[m][bj];
                                const f32x4 x1 = v[bj][0], x2 = v[bj][1];
                                v[bj][0] = x1 * cs - x2 * sn; v[bj][1] = x2 * cs + x1 * sn;
                            }
                        }
#pragma unroll
                        for (int bj = 0; bj < 2; ++bj)
#pragma unroll
                            for (int n = 0; n < 2; ++n) v[bj][n] = v[bj][n] * osc;
                    }
                    bf16_t* rp = outp + (size_t)r * ld + colb + 4 * fq;
#pragma unroll
                    for (int bj = 0; bj < 2; ++bj)
#pragma unroll
                        for (int n = 0; n < 2; ++n) st4bf(rp + 32 * bj + 16 * n, v[bj][n]);
                }
            }
            return;
        }
        const int lcol = 32 * wc + 8 * fq;
        if (pn == 6 || pn == 7) {
            bf16_t* outp = (pn == 6) ? LAF : LAB; const float* bb = (pn == 6) ? baf : bab;
            f32x4 bv[2][2];
#pragma unroll
            for (int bj = 0; bj < 2; ++bj)
#pragma unroll
                for (int n = 0; n < 2; ++n) bv[bj][n] = *(const f32x4*)(bb + 128 * bj + lcol + 4 * n);
#pragma unroll
            for (int ai = 0; ai < 2; ++ai)
#pragma unroll
                for (int m = 0; m < 4; ++m) {
                    const int r = rowb + ai * 128 + m * 16;
#pragma unroll
                    for (int bj = 0; bj < 2; ++bj) {
                        const f32x4 z0 = acc[ai][bj][m][0] + bv[bj][0], z1 = acc[ai][bj][m][1] + bv[bj][1];
                        st8bf(outp + (size_t)r * 256 + 128 * bj + lcol, (f32x4){logsig16(z0.x), logsig16(z0.y), logsig16(z0.z), logsig16(z0.w)}, (f32x4){logsig16(z1.x), logsig16(z1.y), logsig16(z1.z), logsig16(z1.w)});
                    }
                }
            return;
        }
        bf16_t* outp; int ld, colb, mode;
        if (pn == 3) { outp = GK; ld = 256; colb = 0; mode = 0; }
        else if (pn <= 5) { outp = GV; ld = 512; colb = 256 * (pn - 4); mode = 0; }
        else if (pn == 8) { outp = GQ; ld = 256; colb = 0; mode = 1; }
        else if (pn <= 10) { outp = GR; ld = 512; colb = 256 * (pn - 9); mode = 2; }
        else if (pn <= 14) { outp = GA; ld = 1024; colb = 256 * (pn - 11); mode = 3; }
        else { outp = GG; ld = 1024; colb = 256 * (pn - 15); mode = 3; }
#pragma unroll
        for (int ai = 0; ai < 2; ++ai)
#pragma unroll
            for (int m = 0; m < 4; ++m) {
                const int r = rowb + ai * 128 + m * 16;
#pragma unroll
                for (int bj = 0; bj < 2; ++bj) {
                    f32x4 a = acc[ai][bj][m][0], b = acc[ai][bj][m][1];
                    if (mode == 1) { a = a * 0.125f; b = b * 0.125f; }
                    else if (mode == 2) { a = silu4p(a); b = silu4p(b); }
                    else if (mode == 3) { a = sig4p(a); b = sig4p(b); }
                    st8bf(outp + (size_t)r * ld + colb + 128 * bj + lcol, a, b);
                }
            }
    }
};

struct EpiGates {
    static constexpr int MIDK = 0, RELAX = 16;
    bf16_t *GA, *GG;
    DI void operator()(AccRef acc, const Unit& u, int wr, int wc, int fr, int fq) const {
        const int rowb = u.pm * 256 + wr * 64 + fr, colb = u.pn * 128 + 32 * wc + 8 * fq;
#pragma unroll
        for (int ai = 0; ai < 2; ++ai)
#pragma unroll
            for (int m = 0; m < 4; ++m) {
                const int r = rowb + ai * 128 + m * 16;
                f32x4 rr[2], gg[2];
#pragma unroll
                for (int n = 0; n < 2; ++n)
#pragma unroll
                    for (int e = 0; e < 4; ++e) {
                        const float ea = __builtin_amdgcn_exp2f(acc[ai][0][m][n][e] * (-LOG2E / W8_SCALE)), eg = __builtin_amdgcn_exp2f(fminf(acc[ai][1][m][n][e] * (-LOG2E / W8_SCALE), 80.f));
                        rr[n][e] = (1.f + eg) * __builtin_amdgcn_rcpf(1.f + ea); gg[n][e] = __builtin_amdgcn_rcpf(1.f + eg);
                    }
                st8bf(GA + (size_t)r * 1024 + colb, rr[0], rr[1]);
                st8bf(GG + (size_t)r * 1024 + colb, gg[0], gg[1]);
            }
    }
};

struct EpiMerge1 {
    static constexpr int MIDK = 4, RELAX = 16;
    const bf16_t *GA, *GG; unsigned char* Y;
    DI void mid(f32x4 (&acc)[2][2][4][2], const Unit& u, int wr, int wc, int fr, int fq) const {
        unsigned z; asm volatile("v_mov_b32 %0, 0" : "=v"(z));
        const unsigned base = (unsigned)((u.pm * 256 + wr * 64 + fr) * 1024 + u.pn * 256 + 32 * wc + 8 * fq) * 2u + z;
#pragma unroll
        for (int ai = 0; ai < 2; ++ai) {
            u32x4 rw[4][2];
#pragma unroll
            for (int m = 0; m < 4; ++m)
#pragma unroll
                for (int bj = 0; bj < 2; ++bj) rw[m][bj] = *(const u32x4*)((const char*)GA + (base + (unsigned)((ai * 128 + m * 16) * 1024 + 128 * bj) * 2u));
#pragma unroll
            for (int m = 0; m < 4; ++m)
#pragma unroll
                for (int bj = 0; bj < 2; ++bj) {
                    const u32x4 aw = rw[m][bj];
                    acc[ai][bj][m][0] *= (f32x4){bflo(aw.x), bfhi(aw.x), bflo(aw.y), bfhi(aw.y)}; acc[ai][bj][m][1] *= (f32x4){bflo(aw.z), bfhi(aw.z), bflo(aw.w), bfhi(aw.w)};
                }
            asm volatile("" ::: "memory");
        }
    }
    DI void operator()(AccRef acc, const Unit& u, int wr, int wc, int fr, int fq) const {
        const int rowb = u.pm * 256 + wr * 64 + fr, colb = u.pn * 256 + 32 * wc + 8 * fq;
        u32x4 gwv[2][4][2];
#pragma unroll
        for (int ai = 0; ai < 2; ++ai)
#pragma unroll
            for (int m = 0; m < 4; ++m)
#pragma unroll
                for (int bj = 0; bj < 2; ++bj) gwv[ai][m][bj] = *(const u32x4*)(GG + (size_t)(rowb + ai * 128 + m * 16) * 1024 + colb + 128 * bj);
#pragma unroll
        for (int ai = 0; ai < 2; ++ai)
#pragma unroll
            for (int m = 0; m < 4; ++m) {
                const int r = rowb + ai * 128 + m * 16;
#pragma unroll
                for (int bj = 0; bj < 2; ++bj) {
                    const size_t off = (size_t)r * 1024 + colb + 128 * bj;
                    const u32x4 gw = gwv[ai][m][bj];
                    const f32x4 g0 = {bflo(gw.x), bfhi(gw.x), bflo(gw.y), bfhi(gw.y)}, g1 = {bflo(gw.z), bfhi(gw.z), bflo(gw.w), bfhi(gw.w)};
                    { const f32x4 a = acc[ai][bj][m][0] * g0 * (MIX8_SCALE / (W8_SCALE * MIX8_SCALE)), b = acc[ai][bj][m][1] * g1 * (MIX8_SCALE / (W8_SCALE * MIX8_SCALE));
                      u32x2 w; w.x = pk4_fp8(a.x, a.y, a.z, a.w); w.y = pk4_fp8(b.x, b.y, b.z, b.w); *(u32x2*)(Y + off) = w; }
                }
            }
    }
};

struct EpiMerge2 {
    static constexpr int MIDK = 0, RELAX = 0;
    const float* x; const float* MOD; bf16_t* X1;
    DI void operator()(AccRef acc, const Unit& u, int wr, int wc, int fr, int fq) const {
        const int rowb = u.pm * 256 + wr * 64 + fr, colb = u.pn * 256 + 32 * wc + 8 * fq;
        const int b = (u.pm * 256) >> 11;
        f32x4 gt[2][2];
#pragma unroll
        for (int bj = 0; bj < 2; ++bj)
#pragma unroll
            for (int n = 0; n < 2; ++n) gt[bj][n] = *(const f32x4*)(MOD + b * 6144 + 2048 + colb + 128 * bj + 4 * n);
#pragma unroll
        for (int ai = 0; ai < 2; ++ai) {
            f32x4 xv[4][2][2];
#pragma unroll
            for (int m = 0; m < 4; ++m)
#pragma unroll
                for (int bj = 0; bj < 2; ++bj) { const size_t off = (size_t)(rowb + ai * 128 + m * 16) * 1024 + colb + 128 * bj; xv[m][bj][0] = *(const f32x4*)(x + off); xv[m][bj][1] = *(const f32x4*)(x + off + 4); }
#pragma unroll
            for (int m = 0; m < 4; ++m) {
                const int r = rowb + ai * 128 + m * 16;
#pragma unroll
                for (int bj = 0; bj < 2; ++bj) {
                    const size_t off = (size_t)r * 1024 + colb + 128 * bj;
                    st8bf(X1 + off, xv[m][bj][0] + gt[bj][0] * acc[ai][bj][m][0] * (1.f / (W8_SCALE * MIX8_SCALE)), xv[m][bj][1] + gt[bj][1] * acc[ai][bj][m][1] * (1.f / (W8_SCALE * MIX8_SCALE)));
                }
            }
        }
    }
};

struct EpiMoe1 {
    static constexpr int MIDK = 0, RELAX = 4;
    const float* b1; unsigned char* ACT;
    DI void operator()(AccRef acc, const Unit& u, int wr, int wc, int fr, int fq) const {
        const int rowb = u.pm * 256 + wr * 64 + fr, f0 = 128 * u.pn + 32 * wc + 8 * fq, odd = fq & 1;
        f32x4 bg[2], bu[2];
#pragma unroll
        for (int n = 0; n < 2; ++n) { bg[n] = *(const f32x4*)(b1 + (size_t)u.e * 2048 + f0 + 4 * n); bu[n] = *(const f32x4*)(b1 + (size_t)u.e * 2048 + 1024 + f0 + 4 * n); }
#pragma unroll
        for (int ai = 0; ai < 2; ++ai)
#pragma unroll
            for (int mp = 0; mp < 2; ++mp) {
                u32x2 wv[2];
#pragma unroll
                for (int mm = 0; mm < 2; ++mm) {
                    const int m = 2 * mp + mm;
                    f32x4 o[2];
#pragma unroll
                    for (int n = 0; n < 2; ++n) {
                        const f32x4 gt = acc[ai][0][m][n] * (1.f / W8_SCALE) + bg[n], up = acc[ai][1][m][n] * (1.f / W8_SCALE) + bu[n];
#pragma unroll
                        for (int hh = 0; hh < 2; ++hh) {
                            const f32x2 g = __builtin_elementwise_min((f32x2){gt[2 * hh], gt[2 * hh + 1]}, (f32x2){7.f, 7.f});
                            const f32x2 uu = __builtin_elementwise_min(__builtin_elementwise_max((f32x2){up[2 * hh], up[2 * hh + 1]}, (f32x2){-7.f, -7.f}), (f32x2){7.f, 7.f});
                            const f32x2 r = (g * sig2(g * 1.702f)) * (uu * ACT8_SCALE + ACT8_SCALE);
                            o[n][2 * hh] = r.x; o[n][2 * hh + 1] = r.y;
                        }
                    }
                    int w0 = 0, w1 = 0; w0 = __builtin_amdgcn_cvt_pk_fp8_f32(o[0].x, o[0].y, w0, false); w0 = __builtin_amdgcn_cvt_pk_fp8_f32(o[0].z, o[0].w, w0, true);
                    w1 = __builtin_amdgcn_cvt_pk_fp8_f32(o[1].x, o[1].y, w1, false); w1 = __builtin_amdgcn_cvt_pk_fp8_f32(o[1].z, o[1].w, w1, true); wv[mm].x = (unsigned)w0; wv[mm].y = (unsigned)w1;
                }
                const auto sx = __builtin_amdgcn_permlane16_swap(wv[0].x, wv[1].x, false, false), sy = __builtin_amdgcn_permlane16_swap(wv[0].y, wv[1].y, false, false);
                const u32x4 ov = {sx[0], sy[0], sx[1], sy[1]};
                const int r = rowb + ai * 128 + (2 * mp + odd) * 16;
                *(u32x4*)(ACT + (size_t)r * 1024 + f0 - 8 * odd) = ov;
            }
    }
};

struct EpiMoe2 {
    static constexpr int MIDK = 0, RELAX = 0;
    const float* b2; const int* LIST; const float* WL; unsigned char* YS;
    DI void operator()(AccRef acc, const Unit& u, int wr, int wc, int fr, int fq) const {
        const int colb = u.pn * 256 + 64 * wc + 16 * fq;
        f32x4 bv[2][2];
#pragma unroll
        for (int bj = 0; bj < 2; ++bj)
#pragma unroll
            for (int n = 0; n < 2; ++n) bv[bj][n] = *(const f32x4*)(b2 + (size_t)u.e * 1024 + colb + 8 * bj + 4 * n);
        constexpr float SC = 1.f / (W8_SCALE * ACT8_SCALE);
        int slot2[2][4]; float wgt2[2][4];
#pragma unroll
        for (int ai = 0; ai < 2; ++ai)
#pragma unroll
            for (int m = 0; m < 4; ++m) { const int p = 256 * u.tl + ai * 128 + wr * 64 + m * 16 + fr; const int pc = p < u.cnt ? p : 0;
                slot2[ai][m] = LIST[u.e * LISTCAP + pc]; wgt2[ai][m] = WL[u.e * LISTCAP + pc]; }
#pragma unroll
        for (int ai = 0; ai < 2; ++ai) {
            int slot[4]; float wgt[4];
#pragma unroll
            for (int m = 0; m < 4; ++m) { const int p = 256 * u.tl + ai * 128 + wr * 64 + m * 16 + fr; const bool ok = p < u.cnt;
                slot[m] = ok ? slot2[ai][m] : -1; wgt[m] = ok ? wgt2[ai][m] * YS8_SCALE : 0.f; }
#pragma unroll
            for (int m = 0; m < 4; ++m) {
                if (slot[m] >= 0) {
                    const float w = wgt[m];
                    u32x4 o;
                    { const f32x4 a = (acc[ai][0][m][0] * SC + bv[0][0]) * w, b = (acc[ai][0][m][1] * SC + bv[0][1]) * w, c = (acc[ai][1][m][0] * SC + bv[1][0]) * w, d = (acc[ai][1][m][1] * SC + bv[1][1]) * w;
                      o.x = pk4_fp8(a.x, a.y, a.z, a.w); o.y = pk4_fp8(b.x, b.y, b.z, b.w); o.z = pk4_fp8(c.x, c.y, c.z, c.w); o.w = pk4_fp8(d.x, d.y, d.z, d.w); }
                    *(u32x4*)(YS + (size_t)slot[m] * 1024 + colb) = o;
                }
            }
        }
    }
};

constexpr int ATT_KS = 72;
constexpr int ATT_BUF = 2 * 64 * ATT_KS * 2;
DI void attn_unit(int b, int kvh, int qb, const bf16_t* Qb, const bf16_t* Kb, const bf16_t* Vb, bf16_t* AO, const float* attn_sink, LAS unsigned char* lds, int tid, int lane, int wave) {
    const int g = lane >> 4, l15 = lane & 15, hq = wave >> 1, xh = wave & 1, h = kvh * 4 + hq;
    const int q0 = qb * 128, qw0 = q0 + xh * 64;
    bf16x8 qf[4][2];
#pragma unroll
    for (int qg = 0; qg < 4; ++qg)
#pragma unroll
        for (int ks = 0; ks < 2; ++ks) qf[qg][ks] = *(const bf16x8*)(Qb + (size_t)(b * T + qw0 + 16 * qg + l15) * 512 + h * 64 + 32 * ks + 8 * g);
    const float sink2 = attn_sink[h] * LOG2E;
    float mrow[4], lrow[4]; f32x4 o[4][4];
#pragma unroll
    for (int qg = 0; qg < 4; ++qg) { mrow[qg] = sink2; lrow[qg] = (g == 0) ? 1.f : 0.f;
#pragma unroll
        for (int dt = 0; dt < 4; ++dt) o[dt][qg] = (f32x4){0.f, 0.f, 0.f, 0.f}; }
    const int jlo = (qb == 0) ? 2 : 0, jhi = (qb == 15) ? 3 : 5, nloc = jhi - jlo + 1, ntile = nloc + 4;
    const int srow = tid & 63, sch = tid >> 6;
    u32x4 kreg, vreg;
#define ATT_ROW0(s) (((s) < nloc) ? (b * T + q0 - 128 + 64 * (jlo + (s))) : (M + b * LC + 64 * ((s) - nloc)))
#define ATT_LOAD(s) do { const size_t _o = (size_t)(ATT_ROW0(s) + srow) * 128 + kvh * 64 + 8 * sch; kreg = *(const u32x4*)(Kb + _o); vreg = *(const u32x4*)(Vb + _o); } while (0)
#define ATT_WRITE(buf) do { LAS bf16_t* _k = (LAS bf16_t*)(lds + (buf) * ATT_BUF); LAS bf16_t* _v = _k + 64 * ATT_KS; \
        *(LAS u32x4*)(_k + srow * ATT_KS + 8 * sch) = kreg; \
        _v[(8 * sch + 0) * ATT_KS + srow] = (bf16_t)(vreg.x & 0xffffu); _v[(8 * sch + 1) * ATT_KS + srow] = (bf16_t)(vreg.x >> 16); \
        _v[(8 * sch + 2) * ATT_KS + srow] = (bf16_t)(vreg.y & 0xffffu); _v[(8 * sch + 3) * ATT_KS + srow] = (bf16_t)(vreg.y >> 16); \
        _v[(8 * sch + 4) * ATT_KS + srow] = (bf16_t)(vreg.z & 0xffffu); _v[(8 * sch + 5) * ATT_KS + srow] = (bf16_t)(vreg.z >> 16); \
        _v[(8 * sch + 6) * ATT_KS + srow] = (bf16_t)(vreg.w & 0xffffu); _v[(8 * sch + 7) * ATT_KS + srow] = (bf16_t)(vreg.w >> 16); } while (0)
    ATT_LOAD(0); ATT_WRITE(0);
    LDS_BAR();
    for (int s = 0; s < ntile; ++s) {
        if (s + 1 < ntile) ATT_LOAD(s + 1);
        const bool isloc = s < nloc; const int j = jlo + s;
        const bool need = !isloc || (xh == 0 ? (j <= 4) : (j >= 1));
        if (need) {
            const bool partial = isloc && (xh == 0 ? (j == 0 || j == 4) : (j == 1 || j == 5));
            const LAS bf16_t* Kt = (const LAS bf16_t*)(lds + (s & 1) * ATT_BUF); const LAS bf16_t* Vt = Kt + 64 * ATT_KS;
            f32x4 sc[4][4];
#pragma unroll
            for (int kt = 0; kt < 4; ++kt) {
                const bf16x8 k0 = *(const LAS bf16x8*)(Kt + (16 * kt + l15) * ATT_KS + 8 * g), k1 = *(const LAS bf16x8*)(Kt + (16 * kt + l15) * ATT_KS + 32 + 8 * g);
#pragma unroll
                for (int qg = 0; qg < 4; ++qg) {
                    f32x4 a = __builtin_amdgcn_mfma_f32_16x16x32_bf16(k0, qf[qg][0], (f32x4){0.f, 0.f, 0.f, 0.f}, 0, 0, 0);
                    sc[kt][qg] = __builtin_amdgcn_mfma_f32_16x16x32_bf16(k1, qf[qg][1], a, 0, 0, 0);
                }
            }
            asm volatile("s_nop 15" : "+v"(sc[3][0]), "+v"(sc[3][1]), "+v"(sc[3][2]), "+v"(sc[3][3]));
            if (partial) {
                const int kb = q0 - 128 + 64 * j;
#pragma unroll
                for (int kt = 0; kt < 4; ++kt)
#pragma unroll
                    for (int qg = 0; qg < 4; ++qg)
#pragma unroll
                        for (int r = 0; r < 4; ++r) { const int dk = (kb + 16 * kt + 4 * g + r) - (qw0 + 16 * qg + l15); if (dk > 128 || dk < -128) sc[kt][qg][r] = -INFINITY; }
            }
            bf16x8 pf[4][2];
#pragma unroll
            for (int qg = 0; qg < 4; ++qg) {
                float mx = max3_nc(sc[0][qg][0], sc[0][qg][1], sc[0][qg][2]);
                mx = max3_nc(mx, sc[0][qg][3], sc[1][qg][0]); mx = max3_nc(mx, sc[1][qg][1], sc[1][qg][2]); mx = max3_nc(mx, sc[1][qg][3], sc[2][qg][0]); mx = max3_nc(mx, sc[2][qg][1], sc[2][qg][2]);
                mx = max3_nc(mx, sc[2][qg][3], sc[3][qg][0]); mx = max3_nc(mx, sc[3][qg][1], sc[3][qg][2]); mx = max_nc(mx, sc[3][qg][3]);
                mx = xmax32(xmax16(mx));
                const float mold = mrow[qg], mnew = max_nc(mold, mx);
                mrow[qg] = mnew;
                const bool grew = __any(mnew > mold);
                const float scl = grew ? __builtin_amdgcn_exp2f(mold - mnew) : 1.f;
                float ls = 0.f;
#pragma unroll
                for (int kt = 0; kt < 4; ++kt)
#pragma unroll
                    for (int r = 0; r < 4; ++r) { const float p = __builtin_amdgcn_exp2f(sc[kt][qg][r] - mnew); sc[kt][qg][r] = p; ls += p; }
                lrow[qg] = lrow[qg] * scl + ls;
                if (grew) {
#pragma unroll
                    for (int dt = 0; dt < 4; ++dt) o[dt][qg] = o[dt][qg] * scl;
                }
#pragma unroll
                for (int s2 = 0; s2 < 2; ++s2) { u32x4 w; w.x = pk2(sc[2 * s2][qg][0], sc[2 * s2][qg][1]); w.y = pk2(sc[2 * s2][qg][2], sc[2 * s2][qg][3]);
                    w.z = pk2(sc[2 * s2 + 1][qg][0], sc[2 * s2 + 1][qg][1]); w.w = pk2(sc[2 * s2 + 1][qg][2], sc[2 * s2 + 1][qg][3]); pf[qg][s2] = __builtin_bit_cast(bf16x8, w); }
            }
#pragma unroll
            for (int dt = 0; dt < 4; ++dt)
#pragma unroll
                for (int s2 = 0; s2 < 2; ++s2) {
                    const LAS bf16_t* vp = Vt + (16 * dt + l15) * ATT_KS + 32 * s2 + 4 * g;
                    const u32x2 vlo = *(const LAS u32x2*)vp, vhi = *(const LAS u32x2*)(vp + 16);
                    const bf16x8 vf = __builtin_bit_cast(bf16x8, (u32x4){vlo.x, vlo.y, vhi.x, vhi.y});
#pragma unroll
                    for (int qg = 0; qg < 4; ++qg) o[dt][qg] = __builtin_amdgcn_mfma_f32_16x16x32_bf16(vf, pf[qg][s2], o[dt][qg], 0, 0, 0);
                }
        }
        if (s + 1 < ntile) ATT_WRITE((s + 1) & 1);
        LDS_BAR();
    }
#undef ATT_ROW0
#undef ATT_LOAD
#undef ATT_WRITE
#pragma unroll
    for (int qg = 0; qg < 4; ++qg) {
        const float l = xadd32(xadd16(lrow[qg]));
        const float inv = __builtin_amdgcn_rcpf(l);
        unsigned char* op = (unsigned char*)AO + (size_t)(b * T + qw0 + 16 * qg + l15) * 1024 + h * 64 + 4 * g;
#pragma unroll
        for (int dt = 0; dt < 4; ++dt) { const f32x4 v = o[dt][qg] * (inv * MIX8_SCALE); *(unsigned*)(op + 16 * dt) = pk4_fp8(v.x, v.y, v.z, v.w); }
    }
}


constexpr int GL_KS = 72;
constexpr int GL_VP = 144;
typedef short v4i16_t __attribute__((ext_vector_type(4)));
DI u32x2 lds_tr4(const LAS bf16_t* blk, int pitch, int l15) { return __builtin_bit_cast(u32x2, __builtin_amdgcn_ds_read_tr16_b64_v4i16((LAS v4i16_t*)(blk + (l15 >> 2) * pitch + 4 * (l15 & 3)))); }
struct CvtRegs { f32x4 v[16]; };
struct GlaRegs { u32x4 k, q; u32x4 laf, lab; u32x4 v[2]; u32x4 st[2][2]; };
template <bool G3>
DI void gla_issue(GlaRegs& R, int row0, int h, int seq0, int c, const bf16_t* GQ, const bf16_t* GK, const bf16_t* GV, const bf16_t* LAF, const bf16_t* LAB, const bf16_t* ST, int tid) {
    const int j = tid >> 3, dch = tid & 7;
    R.k = *(const u32x4*)(GK + (size_t)(row0 + j) * 256 + h * 64 + 8 * dch);
    R.laf = *(const u32x4*)(LAF + (size_t)(row0 + j) * 256 + h * 64 + 8 * dch); R.lab = *(const u32x4*)(LAB + (size_t)(row0 + j) * 256 + h * 64 + 8 * dch);
    if constexpr (G3) R.q = *(const u32x4*)(GQ + (size_t)(row0 + j) * 256 + h * 64 + 8 * dch);
#pragma unroll
    for (int i = 0; i < 2; ++i) { const int idx = tid + 512 * i, jj = idx >> 4, c4 = idx & 15;
        R.v[i] = *(const u32x4*)(GV + (size_t)(row0 + jj) * 512 + h * 128 + 8 * c4); }
    if constexpr (G3) {
#pragma unroll
        for (int dir = 0; dir < 2; ++dir)
#pragma unroll
            for (int i = 0; i < 2; ++i) { const int idx = tid + 512 * i, e = idx >> 3, ch = idx & 7; R.st[dir][i] = *(const u32x4*)(ST + ((size_t)((seq0 + dir) * 32 + c) * 128 + e) * 64 + 8 * ch); }
    }
}
DI void gla_commit(const GlaRegs& R, LAS float* Lf, LAS float* Lb, LAS bf16_t* Vt, int tid) {
    { const int j = tid >> 3, dch = tid & 7; LAS float* pf = Lf + j * 64 + 8 * dch; LAS float* pb = Lb + j * 64 + 8 * dch;
      *(LAS f32x4*)pf = (f32x4){bflo(R.laf.x), bfhi(R.laf.x), bflo(R.laf.y), bfhi(R.laf.y)}; *(LAS f32x4*)(pf + 4) = (f32x4){bflo(R.laf.z), bfhi(R.laf.z), bflo(R.laf.w), bfhi(R.laf.w)};
      *(LAS f32x4*)pb = (f32x4){bflo(R.lab.x), bfhi(R.lab.x), bflo(R.lab.y), bfhi(R.lab.y)}; *(LAS f32x4*)(pb + 4) = (f32x4){bflo(R.lab.z), bfhi(R.lab.z), bflo(R.lab.w), bfhi(R.lab.w)}; }
#pragma unroll
    for (int i = 0; i < 2; ++i) { const int idx = tid + 512 * i, jj = idx >> 4, c4 = idx & 15; *(LAS u32x4*)(Vt + jj * GL_VP + 8 * c4) = R.v[i]; }
}
DI float gla_cumsum2(LAS float* Lf, LAS float* Lb, LAS float* segtot, int tid) {
    const int dir = tid >> 8, d = tid & 63, seg = (tid >> 6) & 3; LAS float* L = (dir ? Lb : Lf) + (16 * seg) * 64 + d;
    float x[16];
#pragma unroll
    for (int i = 0; i < 16; ++i) x[i] = L[i * 64];
    if (!dir) {
#pragma unroll
        for (int i = 1; i < 16; ++i) x[i] += x[i - 1];
    } else {
#pragma unroll
        for (int i = 14; i >= 0; --i) x[i] += x[i + 1];
    }
    segtot[(dir * 4 + seg) * 64 + d] = dir ? x[0] : x[15];
    LDS_BAR();
    const float s0 = segtot[(dir * 4 + 0) * 64 + d], s1 = segtot[(dir * 4 + 1) * 64 + d], s2 = segtot[(dir * 4 + 2) * 64 + d], s3 = segtot[(dir * 4 + 3) * 64 + d];
    const float off = dir ? ((seg < 1 ? s1 : 0.f) + (seg < 2 ? s2 : 0.f) + (seg < 3 ? s3 : 0.f)) : ((seg > 0 ? s0 : 0.f) + (seg > 1 ? s1 : 0.f) + (seg > 2 ? s2 : 0.f));
#pragma unroll
    for (int i = 0; i < 16; ++i) L[i * 64] = x[i] + off;
    return (s0 + s1) + (s2 + s3);
}
#define G1_DECODE(u, b_, h_, c_, r_) const int b_ = (u) / 144, h_ = ((u) / 36) & 3, c_ = (u) % 36, r_ = (c_ < 4) ? M + b_ * LC + 64 * c_ : b_ * T + 64 * (c_ - 4)
template <class CS> DI void gla_g1_unit2(CS& cs, GlaRegs& RC, int uidx, int G, const bf16_t* GK, const bf16_t* GV, const bf16_t* LAF, const bf16_t* LAB, bf16_t* UB, float* DV, LAS unsigned char* lds, int tid, int lane, int wave) {
    LAS float* Lf = (LAS float*)lds; LAS float* Lb = Lf + 4096; LAS float* tot = Lb + 4096; LAS float* segtot = tot + 128;
    LAS bf16_t* Vt = (LAS bf16_t*)(segtot + 512); LAS bf16_t* Kh = Vt + 64 * GL_VP;
    const int j = tid >> 3, dch = tid & 7, g = lane >> 4, l15 = lane & 15;
    G1_DECODE(uidx, b, h, c36, row0); (void)row0;
    const int seq0 = (b * 4 + h) * 2;
    const u32x4 kreg = RC.k;
    gla_commit(RC, Lf, Lb, Vt, tid);
    const int nidx = uidx + 2 * G;
    if (nidx < NB * 4 * 36) { int zz; asm volatile("v_mov_b32 %0, 0" : "=v"(zz));
        G1_DECODE(nidx, nb, nh, nc, nr); (void)nb; (void)nc; gla_issue<false>(RC, nr, nh, 0, 0, nullptr, GK, GV, LAF, LAB, nullptr, tid + zz); }
    CvtRegs CR, CR2; cs.issue(CR);
    LDS_BAR();
    { const float ctot = gla_cumsum2(Lf, Lb, segtot, tid);
      if (((tid >> 6) & 3) == 0) { const int dir = tid >> 8, d = tid & 63; tot[dir * 64 + d] = ctot; DV[(size_t)((seq0 + dir) * 36 + c36) * 64 + d] = __expf(ctot); } }
    cs.issue(CR2, 1);
    LDS_BAR();
    { const float kv[8] = {bflo(kreg.x), bfhi(kreg.x), bflo(kreg.y), bfhi(kreg.y), bflo(kreg.z), bfhi(kreg.z), bflo(kreg.w), bfhi(kreg.w)};
#pragma unroll
      for (int dir = 0; dir < 2; ++dir) { const LAS float* L = (dir ? Lb : Lf) + j * 64 + 8 * dch; const LAS float* tp = tot + dir * 64 + 8 * dch;
        const f32x4 b0 = *(const LAS f32x4*)L, b1 = *(const LAS f32x4*)(L + 4), t0 = *(const LAS f32x4*)tp, t1 = *(const LAS f32x4*)(tp + 4);
        u32x4 w; w.x = pk2(kv[0] * __expf(t0.x - b0.x), kv[1] * __expf(t0.y - b0.y)); w.y = pk2(kv[2] * __expf(t0.z - b0.z), kv[3] * __expf(t0.w - b0.w));
        w.z = pk2(kv[4] * __expf(t1.x - b1.x), kv[5] * __expf(t1.y - b1.y)); w.w = pk2(kv[6] * __expf(t1.z - b1.z), kv[7] * __expf(t1.w - b1.w));
        *(LAS u32x4*)(Kh + (dir * 64 + j) * GL_KS + 8 * dch) = w; } }
    LDS_BAR();
    asm volatile("" : "+v"(RC.k), "+v"(RC.laf), "+v"(RC.lab), "+v"(RC.v[0]), "+v"(RC.v[1]));
    { const int dt = wave & 3, eh = wave >> 2;
#pragma unroll
      for (int dir = 0; dir < 2; ++dir) {
        bf16x8 af[2];
#pragma unroll
        for (int s2 = 0; s2 < 2; ++s2) { const LAS bf16_t* kb = Kh + (dir * 64 + 32 * s2 + 8 * g) * GL_KS + 16 * dt; const u32x2 lo = lds_tr4(kb, GL_KS, l15), hi = lds_tr4(kb + 4 * GL_KS, GL_KS, l15);
            af[s2] = __builtin_bit_cast(bf16x8, (u32x4){lo.x, lo.y, hi.x, hi.y}); }
        bf16_t* ub = UB + (size_t)((seq0 + dir) * 36 + c36) * (128 * 64);
#pragma unroll
        for (int et = 0; et < 4; ++et) {
            f32x4 acc = {0.f, 0.f, 0.f, 0.f};
#pragma unroll
            for (int s2 = 0; s2 < 2; ++s2) { const LAS bf16_t* vb = Vt + (32 * s2 + 8 * g) * GL_VP + 64 * eh + 16 * et; const u32x2 lo = lds_tr4(vb, GL_VP, l15), hi = lds_tr4(vb + 4 * GL_VP, GL_VP, l15);
                acc = __builtin_amdgcn_mfma_f32_16x16x32_bf16(af[s2], __builtin_bit_cast(bf16x8, (u32x4){lo.x, lo.y, hi.x, hi.y}), acc, 0, 0, 0); }
            st4bf(ub + (size_t)(64 * eh + 16 * et + l15) * 64 + 16 * dt + 4 * g, acc);
        }
      } }
    cs.finish(CR); cs.finish(CR2);
    LDS_BAR();
}
template <class CS> DI void gla_g1_phase(CS& cs, int G, int bx, const bf16_t* GK, const bf16_t* GV, const bf16_t* LAF, const bf16_t* LAB, bf16_t* UB, float* DV, LAS unsigned char* lds, int tid, int lane, int wave) {
    constexpr int NU = NB * 4 * 36;
    int uidx = bx; if (uidx >= NU) return;
    GlaRegs Ra, Rb;
    { G1_DECODE(uidx, b0, h0, c0, r0); (void)b0; (void)c0; gla_issue<false>(Ra, r0, h0, 0, 0, nullptr, GK, GV, LAF, LAB, nullptr, tid); }
    if (uidx + G < NU) { G1_DECODE(uidx + G, b1, h1, c1, r1); (void)b1; (void)c1; gla_issue<false>(Rb, r1, h1, 0, 0, nullptr, GK, GV, LAF, LAB, nullptr, tid); }
    for (;;) {
        gla_g1_unit2(cs, Ra, uidx, G, GK, GV, LAF, LAB, UB, DV, lds, tid, lane, wave);
        uidx += G; if (uidx >= NU) break;
        gla_g1_unit2(cs, Rb, uidx, G, GK, GV, LAF, LAB, UB, DV, lds, tid, lane, wave);
        uidx += G; if (uidx >= NU) break;
    }
}
#undef G1_DECODE
template <class CS> DI void gla_g3_phase(CS& cs, int G, int bx, const bf16_t* GQ, const bf16_t* GK, const bf16_t* GV, const bf16_t* LAF, const bf16_t* LAB, const bf16_t* ST, const bf16_t* GR, const float* gla_norm, bf16_t* OG,
                     LAS unsigned char* lds, int tid, int lane, int wave) {
    LAS float* Lf = (LAS float*)lds; LAS float* Lb = Lf + 4096;
    LAS bf16_t* Qt = (LAS bf16_t*)(Lb + 4096);
    LAS bf16_t* Kt = Qt + 2 * 64 * GL_KS;
    LAS bf16_t* Vt = Kt + 2 * 64 * GL_KS;
    LAS bf16_t* St = Vt + 64 * GL_VP;
    LAS float* ssx = (LAS float*)(St + 2 * 128 * GL_KS);
    LAS float* segtot = ssx + 128;
    const int j = tid >> 3, dch = tid & 7, g = lane >> 4, l15 = lane & 15;
    int uidx = bx; if (uidx >= NB * 4 * 32) return;
    f32x4 gnv[4];
#pragma unroll
    for (int et = 0; et < 4; ++et) gnv[et] = *(const f32x4*)(gla_norm + 64 * (wave >> 2) + 16 * et + 4 * g);
    GlaRegs R;
    gla_issue<true>(R, (uidx >> 7) * T + 64 * (uidx & 31), (uidx >> 5) & 3, ((uidx >> 7) * 4 + ((uidx >> 5) & 3)) * 2, uidx & 31, GQ, GK, GV, LAF, LAB, ST, tid);
    for (;;) {
        const int b = uidx >> 7, h = (uidx >> 5) & 3, c = uidx & 31, row0 = b * T + 64 * c;
        const u32x4 qreg = R.q, kreg = R.k;
        gla_commit(R, Lf, Lb, Vt, tid);
#pragma unroll
        for (int dir = 0; dir < 2; ++dir)
#pragma unroll
            for (int i = 0; i < 2; ++i) { const int idx = tid + 512 * i, e = idx >> 3, ch = idx & 7; *(LAS u32x4*)(St + (dir * 128 + e) * GL_KS + 8 * ch) = R.st[dir][i]; }
        const int nidx = uidx + G; const bool has_next = nidx < NB * 4 * 32;
        if (has_next) gla_issue<true>(R, (nidx >> 7) * T + 64 * (nidx & 31), (nidx >> 5) & 3, ((nidx >> 7) * 4 + ((nidx >> 5) & 3)) * 2, nidx & 31, GQ, GK, GV, LAF, LAB, ST, tid);
        LDS_BAR();
        (void)gla_cumsum2(Lf, Lb, segtot, tid);
        LDS_BAR();
        { const float qv[8] = {bflo(qreg.x), bfhi(qreg.x), bflo(qreg.y), bfhi(qreg.y), bflo(qreg.z), bfhi(qreg.z), bflo(qreg.w), bfhi(qreg.w)};
          const float kv[8] = {bflo(kreg.x), bfhi(kreg.x), bflo(kreg.y), bfhi(kreg.y), bflo(kreg.z), bfhi(kreg.z), bflo(kreg.w), bfhi(kreg.w)};
#pragma unroll
          for (int dir = 0; dir < 2; ++dir) { const LAS float* L = (dir ? Lb : Lf) + j * 64 + 8 * dch;
            const f32x4 b0 = *(const LAS f32x4*)L, b1 = *(const LAS f32x4*)(L + 4);
            const float bb[8] = {b0.x, b0.y, b0.z, b0.w, b1.x, b1.y, b1.z, b1.w};
            float qt[8], kt[8];
#pragma unroll
            for (int i = 0; i < 8; ++i) { const float ex = __expf(bb[i]); qt[i] = qv[i] * ex; kt[i] = kv[i] * __builtin_amdgcn_rcpf(ex); }
            u32x4 qw, kw; qw.x = pk2(qt[0], qt[1]); qw.y = pk2(qt[2], qt[3]); qw.z = pk2(qt[4], qt[5]); qw.w = pk2(qt[6], qt[7]);
            kw.x = pk2(kt[0], kt[1]); kw.y = pk2(kt[2], kt[3]); kw.z = pk2(kt[4], kt[5]); kw.w = pk2(kt[6], kt[7]);
            *(LAS u32x4*)(Qt + (dir * 64 + j) * GL_KS + 8 * dch) = qw; *(LAS u32x4*)(Kt + (dir * 64 + j) * GL_KS + 8 * dch) = kw; } }
        LDS_BAR();
        const int it = wave & 3, eh = wave >> 2;
        u32x2 grv[4];
#pragma unroll
        for (int et = 0; et < 4; ++et) grv[et] = *(const u32x2*)(GR + (size_t)(row0 + 16 * it + l15) * 512 + h * 128 + 64 * eh + 16 * et + 4 * g);
        f32x4 o[4];
#pragma unroll
        for (int et = 0; et < 4; ++et) o[et] = (f32x4){0.f, 0.f, 0.f, 0.f};
#pragma unroll
        for (int dir = 0; dir < 2; ++dir) {
            bf16x8 qf[2];
#pragma unroll
            for (int s2 = 0; s2 < 2; ++s2) qf[s2] = *(const LAS bf16x8*)(Qt + (dir * 64 + 16 * it + l15) * GL_KS + 32 * s2 + 8 * g);
#pragma unroll
            for (int et = 0; et < 4; ++et)
#pragma unroll
                for (int s2 = 0; s2 < 2; ++s2) { const bf16x8 a = *(const LAS bf16x8*)(St + (dir * 128 + 64 * eh + 16 * et + l15) * GL_KS + 32 * s2 + 8 * g); o[et] = __builtin_amdgcn_mfma_f32_16x16x32_bf16(a, qf[s2], o[et], 0, 0, 0); }
            f32x4 at[4];
#pragma unroll
            for (int jt = 0; jt < 4; ++jt) { at[jt] = (f32x4){0.f, 0.f, 0.f, 0.f};
#pragma unroll
                for (int s2 = 0; s2 < 2; ++s2) { const bf16x8 kf = *(const LAS bf16x8*)(Kt + (dir * 64 + 16 * jt + l15) * GL_KS + 32 * s2 + 8 * g); at[jt] = __builtin_amdgcn_mfma_f32_16x16x32_bf16(kf, qf[s2], at[jt], 0, 0, 0); }
#pragma unroll
                for (int r = 0; r < 4; ++r) { const int jj = 16 * jt + 4 * g + r, ii = 16 * it + l15; const bool keep = dir ? (jj >= ii) : (jj <= ii); if (!keep) at[jt][r] = 0.f; } }
#pragma unroll
            for (int s2 = 0; s2 < 2; ++s2) {
                u32x4 w; w.x = pk2(at[2 * s2][0], at[2 * s2][1]); w.y = pk2(at[2 * s2][2], at[2 * s2][3]); w.z = pk2(at[2 * s2 + 1][0], at[2 * s2 + 1][1]); w.w = pk2(at[2 * s2 + 1][2], at[2 * s2 + 1][3]);
                const bf16x8 pf = __builtin_bit_cast(bf16x8, w);
#pragma unroll
                for (int et = 0; et < 4; ++et) { const LAS bf16_t* vb = Vt + (32 * s2 + 4 * g) * GL_VP + 64 * eh + 16 * et;
                    const u32x2 vlo = lds_tr4(vb, GL_VP, l15), vhi = lds_tr4(vb + 16 * GL_VP, GL_VP, l15);
                    o[et] = __builtin_amdgcn_mfma_f32_16x16x32_bf16(__builtin_bit_cast(bf16x8, (u32x4){vlo.x, vlo.y, vhi.x, vhi.y}), pf, o[et], 0, 0, 0); }
            }
        }
        float ss = 0.f;
#pragma unroll
        for (int et = 0; et < 4; ++et) ss += (o[et].x * o[et].x + o[et].y * o[et].y) + (o[et].z * o[et].z + o[et].w * o[et].w);
        asm volatile("" : "+v"(R.k), "+v"(R.q), "+v"(R.laf), "+v"(R.lab), "+v"(R.v[0]), "+v"(R.v[1]), "+v"(R.st[0][0]), "+v"(R.st[0][1]), "+v"(R.st[1][0]), "+v"(R.st[1][1]));
        ss = xadd32(xadd16(ss));
        if (g == 0) ssx[eh * 64 + 16 * it + l15] = ss;
        LDS_BAR();
        { const float rstd = rsqrtf((ssx[16 * it + l15] + ssx[64 + 16 * it + l15]) * (1.f / 128.f) + EPS);
          const size_t ro = (size_t)(row0 + 16 * it + l15) * 512 + h * 128, ro2 = (size_t)(row0 + 16 * it + l15) * 1024 + h * 128;
#pragma unroll
          for (int et = 0; et < 4; ++et) { const int e0 = 64 * eh + 16 * et + 4 * g; const f32x4 gn = gnv[et]; const u32x2 gr = grv[et]; (void)ro;
              const f32x4 v = o[et] * (rstd * MIX8_SCALE) * gn * (f32x4){bflo(gr.x), bfhi(gr.x), bflo(gr.y), bfhi(gr.y)}; *(unsigned*)((unsigned char*)OG + ro2 + e0) = pk4_fp8(v.x, v.y, v.z, v.w); } }
        LDS_BAR();
        if (!has_next) break;
        uidx = nidx;
    }
}

struct Args { const float* in[26]; float* out; unsigned char* ws; int ph_lo, ph_hi, li, flags; };
constexpr int NPH = 12;

template <bool FP8, int NB, class Dest>
DI void cvt_item(const float* W, int ldw, int ncols, int k0, int s0, void* WT, int Kd, Dest dest, float scale, int lane) {
    const int g = lane >> 4, c0 = s0 + 4 * (lane & 15);
    if (c0 >= ncols) return;
    const float* src = W + (size_t)(k0 + 16 * g) * ldw + c0;
    int dr[4];
#pragma unroll
    for (int c = 0; c < 4; ++c) dr[c] = dest(c0 + c);
#pragma unroll
    for (int kb = 0; kb < NB * 64; kb += 64) {
        f32x4 v[16];
#pragma unroll
        for (int i = 0; i < 16; ++i) v[i] = *(const f32x4*)(src + (size_t)(kb + i) * ldw);
#pragma unroll
        for (int c = 0; c < 4; ++c) {
            if (dr[c] >= 0) {
            if constexpr (FP8) {
                u32x4 o; o.x = pk4_fp8(v[0][c] * scale, v[1][c] * scale, v[2][c] * scale, v[3][c] * scale); o.y = pk4_fp8(v[4][c] * scale, v[5][c] * scale, v[6][c] * scale, v[7][c] * scale);
                o.z = pk4_fp8(v[8][c] * scale, v[9][c] * scale, v[10][c] * scale, v[11][c] * scale); o.w = pk4_fp8(v[12][c] * scale, v[13][c] * scale, v[14][c] * scale, v[15][c] * scale);
                *(u32x4*)((unsigned char*)WT + (size_t)dr[c] * Kd + k0 + kb + 16 * g) = o;
            } else {
                u32x4 o0, o1; o0.x = pk2(v[0][c], v[1][c]); o0.y = pk2(v[2][c], v[3][c]); o0.z = pk2(v[4][c], v[5][c]); o0.w = pk2(v[6][c], v[7][c]);
                o1.x = pk2(v[8][c], v[9][c]); o1.y = pk2(v[10][c], v[11][c]); o1.z = pk2(v[12][c], v[13][c]); o1.w = pk2(v[14][c], v[15][c]);
                bf16_t* dp = (bf16_t*)WT + (size_t)dr[c] * Kd + k0 + kb + 16 * g; *(u32x4*)dp = o0; *(u32x4*)(dp + 8) = o1;
            }
            }
        }
    }
}
DI void sincos_d(double a, double& s, double& c) {
    const double q = __builtin_rint(a * 0.63661977236758134308), f = a - q * 1.57079632679489661923, f2 = f * f;
    const double sp = f * (1.0 + f2 * (-1.0 / 6 + f2 * (1.0 / 120 + f2 * (-1.0 / 5040 + f2 * (1.0 / 362880 + f2 * (-1.0 / 39916800 + f2 * (1.0 / 6227020800.0)))))));
    const double cp = 1.0 + f2 * (-0.5 + f2 * (1.0 / 24 + f2 * (-1.0 / 720 + f2 * (1.0 / 40320 + f2 * (-1.0 / 3628800 + f2 * (1.0 / 479001600 + f2 * (-1.0 / 87178291200.0)))))));
    const int qi = ((int)q) & 3;
    s = (qi == 0) ? sp : (qi == 1) ? cp : (qi == 2) ? -sp : -cp;
    c = (qi == 0) ? cp : (qi == 1) ? -sp : (qi == 2) ? -cp : sp;
}
DI int dest_win(int s) {
    if (s < 512) { const int head = s >> 6, d = s & 63; return (head >> 2) * 256 + slot_head(head & 3, d); }
    if (s < 640) { const int x = s - 512; return 2 * 256 + slot_head(x >> 6, x & 63); }
    if (s < 768) { const int x = s - 640; return 2 * 256 + slot_head(2 + (x >> 6), x & 63); }
    if (s < 1024) return 8 * 256 + slot_std8(s - 768);
    if (s < 1280) return 3 * 256 + slot_std8(s - 1024);
    if (s < 1792) { const int x = s - 1280; return (4 + (x >> 8)) * 256 + slot_std8(x & 255); }
    if (s < 2304) { const int x = s - 1792; return (9 + (x >> 8)) * 256 + slot_std8(x & 255); }
    if (s < 2336) return -1;
    if (s < 3360) { const int x = s - 2336; return (11 + (x >> 8)) * 256 + slot_std8(x & 255); }
    { const int x = s - 3360; return (15 + (x >> 8)) * 256 + slot_std8(x & 255); }
}
DI int dest_std8(int s) { return (s & ~255) + slot_std8(s & 255); }
DI int dest_win_lo(int s) { return s < 2336 ? dest_win(s) : -1; }
DI int dest_gate(int s) { if (s < 2336) return -1; const int x = s - 2336, c = x & 1023; return (c >> 7) * 256 + slot_std8(128 * (x >> 10) + (c & 127)); }
DI int dest_std16(int s) { const int L = s & 255; return (s & ~255) + 128 * ((L >> 3) & 1) + 32 * (L >> 6) + 16 * ((L >> 2) & 1) + 4 * ((L >> 4) & 3) + (L & 3); }
DI int dest_w1(int s) { const int g = s >> 10, f = s & 1023, t = f >> 7, fl = f & 127; return t * 256 + 128 * g + (fl & 0x60) + (((fl >> 2) & 1) << 4) + (((fl >> 3) & 3) << 2) + (fl & 3); }

constexpr int CVT_I_W1 = 32 * 32 * 8, CVT_I_W2 = 32 * 16 * 8, CVT_NBATCH = 2 * (CVT_I_W1 + CVT_I_W2);
constexpr int NSTREAM_WG = 32, CVT_KQ = 18, CVT_NQS_FULL = NSTREAM_WG * 8 * CVT_KQ;
struct CvtStream {
    const float* w_e1; const float* w_e2; unsigned char* W1; unsigned char* W2; int gw, ngw, seq, lane, nqs;
    DI bool pending() const { return nqs + seq * ngw + gw < CVT_NBATCH; }
    DI void issue(CvtRegs& C, const int ahead = 0) const { const int id = nqs + (seq + ahead) * ngw + gw; if (id >= CVT_NBATCH) return; issue_id(C, id); }
    DI void finish(const CvtRegs& C) { const int id = nqs + seq * ngw + gw; if (id >= CVT_NBATCH) return; ++seq; finish_id(C, id); }
    DI void issue_id(CvtRegs& C, const int id) const {
        const int item = id >> 1, half = id & 1, g = lane >> 4;
        const float* src;  int ldw;
        if (item < CVT_I_W1) { const int e = item >> 8, q = item & 255; ldw = 2048; src = w_e1 + (size_t)e * 1024 * 2048 + (size_t)((q >> 5) * 128 + half * 64 + 16 * g) * 2048 + (q & 31) * 64 + 4 * (lane & 15); }
        else { const int it2 = item - CVT_I_W1, e = it2 >> 7, q = it2 & 127; ldw = 1024; src = w_e2 + (size_t)e * 1024 * 1024 + (size_t)((q >> 4) * 128 + half * 64 + 16 * g) * 1024 + (q & 15) * 64 + 4 * (lane & 15); }
#pragma unroll
        for (int i = 0; i < 16; ++i) C.v[i] = __builtin_nontemporal_load((const f32x4*)(src + (size_t)i * ldw));
    }
    DI void finish_id(const CvtRegs& C, const int id) const {
        const int item = id >> 1, half = id & 1, g = lane >> 4;
        unsigned char* dst; int c0; bool isw1 = item < CVT_I_W1;
        if (isw1) { const int e = item >> 8, q = item & 255; dst = W1 + (size_t)e * 2048 * 1024 + (q >> 5) * 128 + half * 64 + 16 * g; c0 = (q & 31) * 64 + 4 * (lane & 15); }
        else { const int it2 = item - CVT_I_W1, e = it2 >> 7, q = it2 & 127; dst = W2 + (size_t)e * 1024 * 1024 + (q >> 4) * 128 + half * 64 + 16 * g; c0 = (q & 15) * 64 + 4 * (lane & 15); }
#pragma unroll
        for (int c = 0; c < 4; ++c) {
            const int dr = isw1 ? dest_w1(c0 + c) : dest_std16(c0 + c);
            u32x4 o; o.x = pk4_fp8(C.v[0][c] * W8_SCALE, C.v[1][c] * W8_SCALE, C.v[2][c] * W8_SCALE, C.v[3][c] * W8_SCALE); o.y = pk4_fp8(C.v[4][c] * W8_SCALE, C.v[5][c] * W8_SCALE, C.v[6][c] * W8_SCALE, C.v[7][c] * W8_SCALE);
            o.z = pk4_fp8(C.v[8][c] * W8_SCALE, C.v[9][c] * W8_SCALE, C.v[10][c] * W8_SCALE, C.v[11][c] * W8_SCALE); o.w = pk4_fp8(C.v[12][c] * W8_SCALE, C.v[13][c] * W8_SCALE, C.v[14][c] * W8_SCALE, C.v[15][c] * W8_SCALE);
            *(u32x4*)(dst + (size_t)dr * 1024) = o;
        }
    }
};

__global__ void __launch_bounds__(512, 2) fwd_kernel(Args args) {
    extern __shared__ __attribute__((aligned(16))) unsigned char lds_raw[];
    LAS unsigned char* lds = (LAS unsigned char*)lds_raw;
    volatile LAS unsigned* MISC = (volatile LAS unsigned*)(lds + MISC_OFF);
    const int tid = threadIdx.x, lane = tid & 63, wave = __builtin_amdgcn_readfirstlane(tid >> 6);
    const int G = gridDim.x, bx = blockIdx.x;
    const int vcu = (G % 8 == 0) ? (bx % 8) * (G / 8) + bx / 8 : bx;
    const int gw = vcu * 8 + wave, NGW = G * 8;
    unsigned char* ws = args.ws;
    unsigned* ctl = (unsigned*)(ws + O_CTL);
    CvtStream cvs; cvs.w_e1 = args.in[22]; cvs.w_e2 = args.in[24]; cvs.W1 = ws + O_W1; cvs.W2 = ws + O_W2; cvs.gw = gw; cvs.ngw = NGW; cvs.lane = lane; cvs.nqs = (G == 256) ? CVT_NQS_FULL : 0;
    cvs.seq = (args.ph_lo > 3) ? 1 << 20 : 0;
    const float* x = args.in[0]; const float* cvec = args.in[1]; const float* ctx = args.in[2]; const float* c_ctx = args.in[3];
    const float* w_mod = args.in[4]; const float* b_mod = args.in[5]; const float* norm1 = args.in[6]; const float* norm2 = args.in[7];
    const float* w_in = args.in[8]; const float* q_norm = args.in[9]; const float* k_norm = args.in[10]; const float* attn_sink = args.in[11];
    const float* w_alpha_f = args.in[12]; const float* b_alpha_f = args.in[13]; const float* w_alpha_b = args.in[14]; const float* b_alpha_b = args.in[15];
    const float* gla_norm = args.in[16]; const float* w_battn = args.in[17]; const float* w_bgla = args.in[18]; const float* w_out = args.in[19];
    const float* w_router = args.in[20]; const float* b_router = args.in[21]; const float* w_e1 = args.in[22]; const float* b_e1 = args.in[23];
    const float* w_e2 = args.in[24]; const float* b_e2 = args.in[25];
    float* out = args.out;
    float* MOD = (float*)(ws + O_MOD); float* ROPEC = (float*)(ws + O_ROPE); float* ROPES = ROPEC + 1024;
    float* WTS = (float*)(ws + O_WTS); int* LIST = (int*)(ws + O_LIST); float* WL = (float*)(ws + O_WL);
    bf16_t* WIN = (bf16_t*)(ws + O_WIN); bf16_t* WBA = (bf16_t*)(ws + O_WBA); bf16_t* WBG = (bf16_t*)(ws + O_WBG); bf16_t* WOUT = (bf16_t*)(ws + O_WOUT);
    unsigned char* WIN8 = ws + O_WIN + (size_t)11 * 256 * 1024 * 2; unsigned char* HN8 = ws + O_ACT;
    unsigned char* W1 = ws + O_W1; unsigned char* W2 = ws + O_W2;
    bf16_t* HN = (bf16_t*)(ws + O_HN); bf16_t* Qb = (bf16_t*)(ws + O_Q); bf16_t* Kb = (bf16_t*)(ws + O_K); bf16_t* Vb = (bf16_t*)(ws + O_V);
    bf16_t* GQ = (bf16_t*)(ws + O_GQ); bf16_t* GK = (bf16_t*)(ws + O_GK); bf16_t* GV = (bf16_t*)(ws + O_GV);
    bf16_t* LAF = (bf16_t*)(ws + O_LAF); bf16_t* LAB = (bf16_t*)(ws + O_LAB);
    bf16_t* GR = (bf16_t*)(ws + O_GR); bf16_t* GA = (bf16_t*)(ws + O_GA); bf16_t* GG = (bf16_t*)(ws + O_GG);
    bf16_t* AO = (bf16_t*)(ws + O_AO); bf16_t* UB = (bf16_t*)(ws + O_UB); float* DV = (float*)(ws + O_DV); bf16_t* ST = (bf16_t*)(ws + O_ST); bf16_t* OG = (bf16_t*)((unsigned char*)AO + 512);
    bf16_t* X1b = (bf16_t*)(ws + O_X1); bf16_t* Yb = (bf16_t*)(ws + O_Y); unsigned char* H2 = ws + O_H2;
    unsigned char* ACT = ws + O_ACT; unsigned char* YS = ws + O_YS;

    for (int u = tid; u < 64; u += 512) MISC[u] = 0u;
    __syncthreads();
    XcdBarrier bar; bar.bar = ctl + CW_BAR + args.li * XCD_BAR_WORDS; bar.x = 0; bar.st = nullptr;
    bar = xcd_barrier_post(ctl + CW_BAR + args.li * XCD_BAR_WORDS, MISC + 8);
    const int lo = args.ph_lo, hi = args.ph_hi;
#define IN(k) (lo <= (k) && (k) < hi)
#define SEAM(k) do { if (IN(k) && IN((k) + 1)) xcd_barrier(bar); } while (0)

    if (IN(0)) {
        for (int it = bx; it < MOD_ITEMS; it += G) {
            LAS float* scT = (LAS float*)lds;
            LAS float* part = scT + 1024 * 12;
            int zz; asm volatile("v_mov_b32 %0, 0" : "=v"(zz));
            const int lz = lane + zz, r8 = lz >> 3, c4 = lz & 7;
            float cv[18];
#pragma unroll
            for (int q = 0; q < 18; ++q) { const int k = tid + 512 * (q & 1); cv[q] = (q < 16) ? cvec[(q >> 1) * 1024 + k] : c_ctx[k]; }
            f32x4 w[16];
            const float* wp = w_mod + (size_t)(wave * 128 + r8) * 6144 + it * 32 + 4 * c4;
#pragma unroll
            for (int i = 0; i < 16; ++i) w[i] = *(const f32x4*)(wp + (size_t)(i * 8) * 6144);
#pragma unroll
            for (int q = 0; q < 18; ++q) { const int k = tid + 512 * (q & 1); scT[k * 12 + (q >> 1)] = cv[q] * sigmoidf_(cv[q]); }
            LDS_BAR();
            f32x4 ac[9];
#pragma unroll
            for (int r = 0; r < 9; ++r) ac[r] = (f32x4){0.f, 0.f, 0.f, 0.f};
#pragma unroll
            for (int i = 0; i < 16; ++i) {
                const LAS float* sp = scT + (wave * 128 + i * 8 + r8) * 12;
                const f32x4 s0 = *(const LAS f32x4*)sp, s1 = *(const LAS f32x4*)(sp + 4); const float s2 = sp[8];
                ac[0] += w[i] * s0.x; ac[1] += w[i] * s0.y; ac[2] += w[i] * s0.z; ac[3] += w[i] * s0.w;
                ac[4] += w[i] * s1.x; ac[5] += w[i] * s1.y; ac[6] += w[i] * s1.z; ac[7] += w[i] * s1.w; ac[8] += w[i] * s2;
            }
#pragma unroll
            for (int r = 0; r < 9; ++r)
#pragma unroll
                for (int c = 0; c < 4; ++c) { float v = ac[r][c]; v = DPP_ADD(v, 0x128, 0xf); v = xadd16(v); v = xadd32(v); ac[r][c] = v; }
            if (lane < 8) {
#pragma unroll
                for (int r = 0; r < 9; ++r) *(LAS f32x4*)(part + (wave * 9 + r) * 32 + 4 * c4) = ac[r];
            }
            LDS_BAR();
            if (tid < 288) { const int r = tid >> 5, l = tid & 31; float sm = b_mod[it * 32 + l];
#pragma unroll
                for (int w8 = 0; w8 < 8; ++w8) sm += part[(w8 * 9 + r) * 32 + l];
                __hip_atomic_store(MOD + r * 6144 + it * 32 + l, sm, __ATOMIC_RELAXED, __HIP_MEMORY_SCOPE_AGENT); }
            asm volatile("s_waitcnt vmcnt(0)" ::: "memory");
            __syncthreads();
            if (tid == 0) (void)__hip_atomic_fetch_add(ctl + CW_MODF, 1u, __ATOMIC_RELAXED, __HIP_MEMORY_SCOPE_AGENT);
        }
        if (bx == G - 1) {
            for (int idx = tid; idx < 1024; idx += 512) { const int pos = idx >> 4, i = idx & 15; double inv = 1.0; for (int j = 0; j < i; ++j) inv *= 0.56234132519034908039;
                double s, c; sincos_d((double)pos * inv, s, c); ROPEC[idx] = (float)c; ROPES[idx] = (float)s; }
        }
        LAS float* scr = (LAS float*)(lds + wave * 16384);
        constexpr int I_EFF = 128, I_WIN = 69 * 16, I_BA = 16 * 8, I_BG = 16 * 8, I_OUT = 16 * 16;
        constexpr int NITEMS = I_EFF + I_WIN + I_BA + I_BG + I_OUT;
        const int nfree = (G > MOD_ITEMS) ? G - MOD_ITEMS : 0, nbusy = G - nfree, FIT = (3 * nfree * 8 < NITEMS) ? 3 * nfree * 8 : NITEMS;
        const bool isfree = bx >= MOD_ITEMS;
        const int it_lo = isfree ? (bx - MOD_ITEMS) * 8 + wave : FIT + bx * 8 + wave, it_hi = isfree ? FIT : NITEMS, it_st = isfree ? nfree * 8 : nbusy * 8;
        for (int it = it_lo; it < it_hi; it += it_st) {
            int r = it;
            if (r < I_EFF) {
                const int dir = r >> 6, kb = (r >> 2) & 15, p = r & 3; const float* wa = dir ? w_alpha_b : w_alpha_f;
                { const float* lrp = w_in + (size_t)(kb * 64 + lane) * CIN + 2304 + 16 * dir;
#pragma unroll
                  for (int q4 = 0; q4 < 4; ++q4) *(LAS f32x4*)(scr + lane * 16 + 4 * q4) = *(const f32x4*)(lrp + 4 * q4); }
                LDS_WAIT(); asm volatile("" ::: "memory");
                {
                    const int n = p * 64 + lane; float al[16];
#pragma unroll
                    for (int q = 0; q < 16; ++q) al[q] = wa[q * 256 + n];
                    bf16_t* dst = WIN + (size_t)((6 + dir) * 256 + slot_std8(n)) * 1024 + kb * 64;
#pragma unroll 2
                    for (int g8 = 0; g8 < 8; ++g8) {
                        float sv[8];
#pragma unroll
                        for (int j = 0; j < 8; ++j) { const LAS float* lr = scr + (g8 * 8 + j) * 16; float sm = 0.f;
#pragma unroll
                            for (int q4 = 0; q4 < 4; ++q4) { const f32x4 l4 = *(const LAS f32x4*)(lr + 4 * q4); sm += (l4.x * al[4 * q4] + l4.y * al[4 * q4 + 1]) + (l4.z * al[4 * q4 + 2] + l4.w * al[4 * q4 + 3]); }
                            sv[j] = sm; }
                        u32x4 o; o.x = pk2(sv[0], sv[1]); o.y = pk2(sv[2], sv[3]); o.z = pk2(sv[4], sv[5]); o.w = pk2(sv[6], sv[7]);
                        *(u32x4*)(dst + g8 * 8) = o;
                    }
                }
                LDS_WAIT(); asm volatile("" ::: "memory");
                continue; } r -= I_EFF;
            if (r < I_WIN) { const int cb = r % 69, kb = r / 69;
                if (cb <= 36) cvt_item<false, 1>(w_in, CIN, CIN, kb * 64, cb * 64, WIN, 1024, [](int s) { return dest_win_lo(s); }, 1.f, lane);
                if (cb >= 36) cvt_item<true, 1>(w_in, CIN, CIN, kb * 64, cb * 64, WIN8, 1024, [](int s) { return dest_gate(s); }, W8_SCALE, lane);
                continue; } r -= I_WIN;
            if (r < I_BA) { cvt_item<true, 1>(w_battn, 1024, 1024, (r >> 4) * 64, (r & 15) * 64, WBA, 1024, [](int s) { return dest_std8(s); }, W8_SCALE, lane); continue; } r -= I_BA;
            if (r < I_BG) { cvt_item<true, 1>(w_bgla, 1024, 1024, (r >> 4) * 64, (r & 15) * 64, (unsigned char*)WBA + 512, 1024, [](int s) { return dest_std8(s); }, W8_SCALE, lane); continue; } r -= I_BG;
            cvt_item<true, 1>(w_out, 1024, 1024, (r >> 4) * 64, (r & 15) * 64, WOUT, 1024, [](int s) { return dest_std8(s); }, W8_SCALE, lane);
        }
        f32x4 vn[4];
#define P1_LOAD(m_) do { const float* xr_ = ((m_) < M) ? x + (size_t)(m_) * D : ctx + (size_t)((m_) - M) * D; _Pragma("unroll") for (int j = 0; j < 4; ++j) vn[j] = *(const f32x4*)(xr_ + 4 * lane + 256 * j); } while (0)
        if (gw < MT) P1_LOAD(gw);
        if (wave == 0) { unsigned spins = 0;
          for (;;) {
              unsigned f = 0; if (lane == 0) f = __hip_atomic_load(ctl + CW_MODF, __ATOMIC_RELAXED, __HIP_MEMORY_SCOPE_AGENT);
              if ((unsigned)__builtin_amdgcn_readfirstlane(f) >= (unsigned)MOD_ITEMS) break;
              __builtin_amdgcn_s_sleep(8); if (++spins > (1u << 21)) { if (lane == 0) __hip_atomic_store(ctl + CW_TMO, 1u, __ATOMIC_RELAXED, __HIP_MEMORY_SCOPE_AGENT); break; } }
          __builtin_amdgcn_fence(__ATOMIC_ACQUIRE, "agent"); }
        __syncthreads();

        f32x4 g1v[4];
#pragma unroll
        for (int j = 0; j < 4; ++j) g1v[j] = *(const f32x4*)(norm1 + 4 * lane + 256 * j);
        for (int m = gw; m < MT; m += NGW) {
            const float* md = MOD + ((m < M) ? (m >> 11) : 8) * 6144;
            f32x4 shv[4], scv[4];
#pragma unroll
            for (int j = 0; j < 4; ++j) { shv[j] = *(const f32x4*)(md + 4 * lane + 256 * j); scv[j] = *(const f32x4*)(md + 1024 + 4 * lane + 256 * j); }
            asm volatile("" ::: "memory");
            f32x4 v[4]; float ss = 0.f;
#pragma unroll
            for (int j = 0; j < 4; ++j) { v[j] = vn[j]; ss += (v[j].x * v[j].x + v[j].y * v[j].y) + (v[j].z * v[j].z + v[j].w * v[j].w); }
            if (m + NGW < MT) P1_LOAD(m + NGW);
            const float rstd = rsqrtf(wave_sum_dpp(ss) * (1.f / D) + EPS);
#pragma unroll
            for (int j = 0; j < 4; ++j) { const int c = 4 * lane + 256 * j;
                const f32x4 g = g1v[j], sh = shv[j], sc = scv[j];
                const f32x4 h = (v[j] * rstd * g) * (sc + 1.f) + sh;
                st4bf(HN + (size_t)m * D + c, h);
                if (m < M) *(unsigned*)(HN8 + (size_t)m * D + c) = pk4_fp8(h.x, h.y, h.z, h.w); }
        }
#undef P1_LOAD
    }
    SEAM(1);

    if (IN(2)) {
        const bool split = (G == 256);
        if (split && bx >= 256 - NSTREAM_WG) {
            const int sw = (bx - (256 - NSTREAM_WG)) * 8 + wave, SW = NSTREAM_WG * 8;
            CvtRegs CA, CB, CC;
            cvs.issue_id(CA, sw); cvs.issue_id(CB, sw + SW); cvs.issue_id(CC, sw + 2 * SW);
#pragma unroll 1
            for (int k = 0; k < CVT_KQ; k += 3) {
                cvs.finish_id(CA, sw + SW * k);       if (k + 3 < CVT_KQ) cvs.issue_id(CA, sw + SW * (k + 3));
                cvs.finish_id(CB, sw + SW * (k + 1)); if (k + 4 < CVT_KQ) cvs.issue_id(CB, sw + SW * (k + 4));
                cvs.finish_id(CC, sw + SW * (k + 2)); if (k + 5 < CVT_KQ) cvs.issue_id(CC, sw + SW * (k + 5));
            }
        } else {
            const int GW = split ? 256 - NSTREAM_WG : G;
            InProjSched S; S.G = GW; S.c = bx; S.A = (const char*)HN; S.Bt = (const char*)WIN;
            EpiInProj E{Qb, Kb, Vb, GQ, GK, GV, GR, GA, GG, LAF, LAB, q_norm, k_norm, b_alpha_f, b_alpha_b, ROPEC, ROPES};
            pg8::gemm_phase<EpiInProj, InProjSched, true>(lds, 1024, S, E);
            PlainSched S2; S2.G = G; S2.c = bx; S2.nM = 64; S2.nN = 8; S2.K = 1024; S2.eb = 1; S2.A = (const char*)HN8; S2.Bt = (const char*)WIN8; S2.split = split ? 1 : 0;
            EpiGates E2{GA, GG};
            pg8::gemm_phase<EpiGates, PlainSched, true, true>(lds, 1024, S2, E2);
        }
    }
    SEAM(2);

    if (IN(3)) {
        const bool g1first = ((bx >> 3) & 1) != 0;
        if (g1first) { gla_g1_phase(cvs, G, bx, GK, GV, LAF, LAB, UB, DV, lds, tid, lane, wave); LDS_BAR(); }
        for (int uidx = bx; uidx < 256; uidx += G) attn_unit(uidx >> 5, (uidx >> 4) & 1, uidx & 15, Qb, Kb, Vb, AO, attn_sink, lds, tid, lane, wave);
        if (!g1first) { LDS_BAR(); gla_g1_phase(cvs, G, bx, GK, GV, LAF, LAB, UB, DV, lds, tid, lane, wave); }
    }
    SEAM(3);

    if (IN(4)) {
        if (bx < NB) {
            const float* mdr = MOD + bx * 6144 + 3 * 1024; float s4[4] = {0.f, 0.f, 0.f, 0.f};
            for (int i = 0; i < 16; ++i) { const int c = lane + 64 * i; const float sh = mdr[c]; const f32x4 w = *(const f32x4*)(w_router + (size_t)c * 32 + 4 * wave);
                s4[0] += sh * w.x; s4[1] += sh * w.y; s4[2] += sh * w.z; s4[3] += sh * w.w; }
#pragma unroll
            for (int j = 0; j < 4; ++j) { const float tot = wave_sum_dpp(s4[j]); if (lane == 0) ((float*)(ws + O_ROPE + 16384))[bx * 32 + 4 * wave + j] = tot + b_router[4 * wave + j]; }
        }
        for (int gid = bx * 512 + tid; gid < 64 * 128 * 16; gid += G * 512) {
            const int seq = gid >> 11, e = (gid >> 4) & 127, dq = gid & 15, dir = seq & 1;
            f32x4 S = {0.f, 0.f, 0.f, 0.f};
            const bf16_t* ub = UB + ((size_t)seq * 36 * 128 + e) * 64 + 4 * dq; const float* dvp = DV + (size_t)seq * 36 * 64 + 4 * dq;
            bf16_t* stp = ST + ((size_t)seq * 32 * 128 + e) * 64 + 4 * dq;
            u32x2 ua[6], ub2[6]; f32x4 da[6], db[6];
#define G2_LOAD(U_, D_, p0_) do { _Pragma("unroll") for (int i = 0; i < 6; ++i) { const int p = (p0_) + i, cc = dir ? (p < 4 ? 3 - p : 39 - p) : p; \
                U_[i] = *(const u32x2*)(ub + cc * (128 * 64)); D_[i] = *(const f32x4*)(dvp + cc * 64); } } while (0)
#define G2_SCAN(U_, D_, p0_) do { _Pragma("unroll") for (int i = 0; i < 6; ++i) { const int p = (p0_) + i, cc = dir ? (p < 4 ? 3 - p : 39 - p) : p; \
                if (cc >= 4) st4bf(stp + (cc - 4) * (128 * 64), S); \
                S = D_[i] * S + (f32x4){bflo(U_[i].x), bfhi(U_[i].x), bflo(U_[i].y), bfhi(U_[i].y)}; } } while (0)
            G2_LOAD(ua, da, 0);
#pragma unroll 1
            for (int p0 = 0; p0 < 36; p0 += 12) {
                G2_LOAD(ub2, db, p0 + 6);
                CvtRegs CR; if (p0 == 0) cvs.issue(CR);
                G2_SCAN(ua, da, p0);
                if (p0 + 12 < 36) G2_LOAD(ua, da, p0 + 12);
                G2_SCAN(ub2, db, p0 + 6);
                if (p0 == 0) cvs.finish(CR);
            }
#undef G2_LOAD
#undef G2_SCAN
        }
    }
    SEAM(4);

    if (IN(5)) {
        gla_g3_phase(cvs, G, bx, GQ, GK, GV, LAF, LAB, ST, GR, gla_norm, OG, lds, tid, lane, wave);
    }
    SEAM(5);

    if (IN(6)) {
        PlainSched S; S.G = G; S.c = bx; S.nM = 64; S.nN = 4; S.K = 1024; S.eb = 1; S.A = (const char*)AO; S.Bt = (const char*)WBA;
        EpiMerge1 E{GA, GG, (unsigned char*)Yb};
        pg8::gemm_phase<EpiMerge1, PlainSched, true, true>(lds, 1024, S, E);
    }
    SEAM(6);

    if (IN(7)) {
        PlainSched S; S.G = G; S.c = bx; S.nM = 64; S.nN = 4; S.K = 1024; S.eb = 1; S.A = (const char*)Yb; S.Bt = (const char*)WOUT;
        EpiMerge2 E{x, MOD, X1b};
        pg8::gemm_phase<EpiMerge2, PlainSched, true, true>(lds, 1024, S, E);
    }
    SEAM(7);

    if (IN(8)) {
        LAS float* wrt = (LAS float*)lds;
        LAS int* lcnt = (LAS int*)(lds + XTRA_OFF);
        LAS int* lbase = lcnt + 32; LAS int* lexp = lcnt + 64; LAS int* lrank = lexp + 256; LAS float* lwt = (LAS float*)(lrank + 256);
        LAS float* rsd = (LAS float*)(lds + XTRA_OFF + 3584);
        LAS float* lg = (LAS float*)(lds + XTRA_OFF + 4096);
        const float* RB = (const float*)(ws + O_ROPE + 16384);
        for (int rb = bx; rb < M / 64; rb += G) {
            const float* md = MOD + ((rb * 64) >> 11) * 6144;
            int zz; asm volatile("v_mov_b32 %0, 0" : "=v"(zz));
            const int tz = tid + zz, lz = lane + zz;
            CvtRegs CR; cvs.issue(CR);
            if (tid < 32) lcnt[tid] = 0;
#pragma unroll
            for (int cc = 0; cc < 2; ++cc) {
                const int col = tz + 512 * cc; const float gsc = norm2[col] * (1.f + md[4 * 1024 + col]);
#pragma unroll
                for (int q = 0; q < 8; ++q) { const f32x4 w = *(const f32x4*)(w_router + (size_t)col * 32 + 4 * q);
#pragma unroll
                    for (int j = 0; j < 4; ++j) { const int e = 4 * q + j; wrt[e * 1024 + (col ^ ((e & 15) << 2))] = w[j] * gsc; } }
            }
            cvs.finish(CR);
            LDS_BAR();
            cvs.issue(CR);
            {
                f32x4 Gc[4], Sh[4];
#pragma unroll
                for (int j = 0; j < 4; ++j) { const int c = 4 * lz + 256 * j; const f32x4 g = *(const f32x4*)(norm2 + c), sc = *(const f32x4*)(md + 4 * 1024 + c); Sh[j] = *(const f32x4*)(md + 3 * 1024 + c); Gc[j] = g * (sc + 1.f); }
                u32x2 vn[4];
#pragma unroll
                for (int j = 0; j < 4; ++j) vn[j] = *(const u32x2*)(X1b + (size_t)(rb * 64 + wave * 8) * D + 4 * lane + 256 * j);
#pragma unroll 2
                for (int i = 0; i < 8; ++i) {
                    const int rl = wave * 8 + i, m = rb * 64 + rl;
                    f32x4 v[4]; float ss = 0.f;
#pragma unroll
                    for (int j = 0; j < 4; ++j) { v[j] = (f32x4){bflo(vn[j].x), bfhi(vn[j].x), bflo(vn[j].y), bfhi(vn[j].y)}; ss += (v[j].x * v[j].x + v[j].y * v[j].y) + (v[j].z * v[j].z + v[j].w * v[j].w); }
                    if (i < 7) {
#pragma unroll
                        for (int j = 0; j < 4; ++j) vn[j] = *(const u32x2*)(X1b + (size_t)(m + 1) * D + 4 * lane + 256 * j);
                    }
                    const float rstd = rsqrtf(wave_sum_dpp(ss) * (1.f / D) + EPS);
                    if (lane == 0) rsd[rl] = rstd;
#pragma unroll
                    for (int j = 0; j < 4; ++j) { const f32x4 h = (v[j] * rstd) * Gc[j] + Sh[j]; *(unsigned*)(H2 + (size_t)m * D + 4 * lane + 256 * j) = pk4_fp8(h.x, h.y, h.z, h.w); }
                }
            }
            cvs.finish(CR);
            {
                const int rg = wave & 3, kh = wave >> 2, li = lz & 15, kq = lz >> 4;
                const bf16_t* xp = X1b + (size_t)(rb * 64 + rg * 16 + li) * D + kh * 512 + 8 * kq;
                u32x4 xa[16];
#pragma unroll
                for (int sI = 0; sI < 16; ++sI) xa[sI] = *(const u32x4*)(xp + 32 * sI);
                f32x4 a0 = {0.f, 0.f, 0.f, 0.f}, a1 = {0.f, 0.f, 0.f, 0.f};
                const LAS float* w0 = wrt + li * 1024; const LAS float* w1 = w0 + 16 * 1024;
#pragma unroll
                for (int sI = 0; sI < 16; ++sI) {
                    const int grp = kh * 128 + 8 * sI + 2 * kq, g0 = (grp ^ li) * 4, g1 = ((grp + 1) ^ li) * 4;
                    const f32x4 b00 = *(const LAS f32x4*)(w0 + g0), b01 = *(const LAS f32x4*)(w0 + g1), b10 = *(const LAS f32x4*)(w1 + g0), b11 = *(const LAS f32x4*)(w1 + g1);
                    const u32x4 xw = xa[sI];
                    const float xv[8] = {bflo(xw.x), bfhi(xw.x), bflo(xw.y), bfhi(xw.y), bflo(xw.z), bfhi(xw.z), bflo(xw.w), bfhi(xw.w)};
#pragma unroll
                    for (int t = 0; t < 4; ++t) { a0 = __builtin_amdgcn_mfma_f32_16x16x4f32(b00[t], xv[t], a0, 0, 0, 0); a1 = __builtin_amdgcn_mfma_f32_16x16x4f32(b10[t], xv[t], a1, 0, 0, 0); }
#pragma unroll
                    for (int t = 0; t < 4; ++t) { a0 = __builtin_amdgcn_mfma_f32_16x16x4f32(b01[t], xv[4 + t], a0, 0, 0, 0); a1 = __builtin_amdgcn_mfma_f32_16x16x4f32(b11[t], xv[4 + t], a1, 0, 0, 0); }
                }
                cvs.issue(CR);
                LAS float* lrow = lg + (rg * 16 + li) * 32 + 4 * kq;
                if (kh == 1) { *(LAS f32x4*)lrow = a0; *(LAS f32x4*)(lrow + 16) = a1; }
                LDS_BAR();
                if (kh == 0) {
                    const float r = rsd[rg * 16 + li]; const float* rbp = RB + ((rb * 64) >> 11) * 32 + 4 * kq;
                    const f32x4 p0 = *(const LAS f32x4*)lrow, p1 = *(const LAS f32x4*)(lrow + 16), c0 = *(const f32x4*)rbp, c1 = *(const f32x4*)(rbp + 16);
                    *(LAS f32x4*)lrow = (a0 + p0) * r + c0; *(LAS f32x4*)(lrow + 16) = (a1 + p1) * r + c1;
                }
                LDS_BAR();
            }
            if (lane < 8) {
                const int rl = wave * 8 + lane, m = rb * 64 + rl;
                float l[32];
#pragma unroll
                for (int q = 0; q < 8; ++q) { const f32x4 t4 = *(const LAS f32x4*)(lg + rl * 32 + 4 * q); l[4 * q] = t4.x; l[4 * q + 1] = t4.y; l[4 * q + 2] = t4.z; l[4 * q + 3] = t4.w; }
                float tv[4]; int ti[4]; unsigned taken = 0u;
#pragma unroll
                for (int k = 0; k < 4; ++k) {
                    float best = -INFINITY; int bi = 0;
#pragma unroll
                    for (int e = 0; e < 32; ++e) { const bool ok = !((taken >> e) & 1u) && (l[e] > best); best = ok ? l[e] : best; bi = ok ? e : bi; }
                    tv[k] = best; ti[k] = bi; taken |= 1u << bi;
                }
                const float e1 = __expf(tv[1] - tv[0]), e2 = __expf(tv[2] - tv[0]), e3 = __expf(tv[3] - tv[0]); const float inv = 1.f / (1.f + e1 + e2 + e3);
                const float wv[4] = {inv, e1 * inv, e2 * inv, e3 * inv};
#pragma unroll
                for (int k = 0; k < 4; ++k) { WTS[m * 4 + k] = wv[k]; lwt[rl * 4 + k] = wv[k]; lexp[rl * 4 + k] = ti[k]; lrank[rl * 4 + k] = atomicAdd((int*)&lcnt[ti[k]], 1); }
            }
            LDS_BAR();
            if (tid < 32) lbase[tid] = (int)atomicAdd(ctl + CW_CNT + 64 * tid, (unsigned)lcnt[tid]);
            __syncthreads();
            if (tid < 256) { const int ex = lexp[tid], pos = ex * LISTCAP + lbase[ex] + lrank[tid]; LIST[pos] = (rb * 64) * 4 + tid; WL[pos] = lwt[tid]; }
            cvs.finish(CR);
            __syncthreads();
        }
        while (cvs.pending()) { CvtRegs CR2; cvs.issue(CR2); cvs.finish(CR2); }
    }
    SEAM(8);

    if (IN(9) || IN(10)) {
        LAS int* TT = (LAS int*)(lds + XTRA_OFF);
        __syncthreads();
        if (tid < NE) { const int c = (int)__hip_atomic_load(ctl + CW_CNT + 64 * tid, __ATOMIC_RELAXED, __HIP_MEMORY_SCOPE_AGENT); TT[1 + tid] = c; TT[33 + tid] = (c + 255) >> 8; }
        __syncthreads();
        {
            int pre = 0, myent = -1;
            for (int e = 0; e < NE; ++e) { const int n = TT[33 + e]; if (tid >= pre && tid < pre + n) myent = e | ((tid - pre) << 8); pre += n; }
            __syncthreads();
            if (myent >= 0) TT[64 + tid] = myent;
            if (tid == 0) TT[0] = pre;
        }
        __syncthreads();
        if (IN(9)) {
            MoeSched<true, 3> S; S.G = G; S.cv = vcu; S.TT = TT; S.A = (const char*)H2; S.Bt = (const char*)W1; S.b_estride = (size_t)2048 * 1024; S.LIST = LIST;
            EpiMoe1 E{b_e1, ACT};
            pg8::gemm_phase<EpiMoe1, MoeSched<true, 3>, true, true>(lds, 1024, S, E);
        }
        SEAM(9);
        if (IN(10)) {
            MoeSched<false, 2> S; S.G = G; S.cv = vcu; S.TT = TT; S.A = (const char*)ACT; S.Bt = (const char*)W2; S.b_estride = (size_t)1024 * 1024; S.LIST = LIST;
            EpiMoe2 E{b_e2, LIST, WL, YS};
            pg8::gemm_phase<EpiMoe2, MoeSched<false, 2>, true, true>(lds, 1024, S, E);
        }
    }
    SEAM(10);

    if (IN(11)) {
        f32x4 xn[4]; int yn[4][4];
#define P11_LOAD(m_) do { _Pragma("unroll") for (int j = 0; j < 4; ++j) { const int c_ = 4 * lane + 256 * j; { const u32x2 w_ = *(const u32x2*)(X1b + (size_t)(m_) * D + c_); xn[j] = (f32x4){bflo(w_.x), bfhi(w_.x), bflo(w_.y), bfhi(w_.y)}; } \
            _Pragma("unroll") for (int k = 0; k < 4; ++k) yn[j][k] = *(const int*)(YS + (size_t)((m_) * 4 + k) * D + c_); } } while (0)
        if (gw < M) P11_LOAD(gw);
        for (int m = gw; m < M; m += NGW) {
            const float* md = MOD + (m >> 11) * 6144 + 5 * 1024;
            f32x4 gtv[4];
#pragma unroll
            for (int j = 0; j < 4; ++j) gtv[j] = *(const f32x4*)(md + 4 * lane + 256 * j);
            asm volatile("" ::: "memory");
            f32x4 xv[4]; int yv[4][4];
#pragma unroll
            for (int j = 0; j < 4; ++j) { xv[j] = xn[j];
#pragma unroll
                for (int k = 0; k < 4; ++k) yv[j][k] = yn[j][k]; }
            if (m + NGW < M) P11_LOAD(m + NGW);
#pragma unroll
            for (int j = 0; j < 4; ++j) { const int c = 4 * lane + 256 * j;
                f32x4 s = {0.f, 0.f, 0.f, 0.f};
#pragma unroll
                for (int k = 0; k < 4; ++k) { const f32x2 lo = __builtin_amdgcn_cvt_pk_f32_fp8(yv[j][k], false), hi = __builtin_amdgcn_cvt_pk_f32_fp8(yv[j][k], true); s = s + (f32x4){lo.x, lo.y, hi.x, hi.y}; }
                s = s * (1.f / YS8_SCALE);
                const f32x4 g = gtv[j];
                *(f32x4*)(out + (size_t)m * D + c) = xv[j] + g * s; }
        }
#undef P11_LOAD
    }
#undef IN
#undef SEAM
}

extern "C" void kernel_launch(void* const* d_in, const int* in_sizes, int n_in, void* d_out, int out_size, void* d_ws, size_t ws_size, hipStream_t stream) {
    static int grid = 0;
    if (grid == 0) {
        if (n_in != 26 || out_size != M * D || ws_size < WS_END) { fprintf(stderr, "kernel_launch: unexpected shapes (n_in %d, out %d, ws %zu < %zu)\n", n_in, out_size, ws_size, (size_t)WS_END); grid = -1; return; }
        int dev = 0, cus = 0, per_cu = 0;
        if (hipGetDevice(&dev) != hipSuccess || hipDeviceGetAttribute(&cus, hipDeviceAttributeMultiprocessorCount, dev) != hipSuccess) { grid = -1; return; }
        if (hipFuncSetAttribute((const void*)fwd_kernel, hipFuncAttributeMaxDynamicSharedMemorySize, LDS_BYTES) != hipSuccess) { fprintf(stderr, "kernel_launch: hipFuncSetAttribute failed\n"); grid = -1; return; }
        if (hipOccupancyMaxActiveBlocksPerMultiprocessor(&per_cu, (const void*)fwd_kernel, 512, LDS_BYTES) != hipSuccess || per_cu < 1) fprintf(stderr, "kernel_launch: occupancy query reports %d\n", per_cu);
        (void)hipGetLastError();
        grid = cus;
    }
    if (grid < 0) return;
    (void)hipMemsetAsync((char*)d_ws + O_CTL, 0, CTL_ZERO_BYTES, stream);
    Args a{};
    for (int i = 0; i < 26; ++i) a.in[i] = (const float*)d_in[i];
    a.out = (float*)d_out; a.ws = (unsigned char*)d_ws;
    a.ph_lo = 0; a.ph_hi = NPH; hipLaunchKernelGGL(fwd_kernel, dim3(grid), dim3(512), LDS_BYTES, stream, a);
}
```
